# Optimizing an MI355X kernel written in HIP

```python
import jax
import jax.numpy as jnp
from jax import lax
import numpy as np

D_MODEL = 1024
BATCH = 4
SEQ = 4096
DEPTH = 2

GRID_W = 64
CTX_LEN = 256

A_HEADS = 4
A_DK = 128
A_DV = 128
A_CHUNK = 64
LB_TINY = 1e-30
B_HEADS = 8
B_KV_HEADS = 2
B_GROUP = B_HEADS // B_KV_HEADS
B_HD = 64
B_QBLOCK = 128
ROPE_THETA = 10000.0
C_HEADS = 8
C_HD = 64
WIN_R = 8
WIN_C = 16

BRANCH_W = 512
N_BRANCH = 3
FFN_HIDDEN = ((8 * D_MODEL + 3 * 256 - 1) // (3 * 256)) * 256
EPS = 1e-6

SPLITS = (A_HEADS * A_DK, A_HEADS * A_DK, A_HEADS * A_DK, A_HEADS * A_DV, A_HEADS * A_DV,
          B_HEADS * B_HD, B_KV_HEADS * B_HD, B_KV_HEADS * B_HD,
          C_HEADS * C_HD, C_HEADS * C_HD, C_HEADS * C_HD,
          N_BRANCH * D_MODEL)
IN_WIDTH = sum(SPLITS)

kernel_name = 'hybrid_hgrn2_gqa_natten_dit_block'


def rmsnorm(x, w):
    xf = x.astype(jnp.float32)
    y = xf * lax.rsqrt(jnp.mean(xf * xf, axis=-1, keepdims=True) + EPS)
    return (y * w.astype(jnp.float32)).astype(x.dtype)


def project(u, w):
    return jnp.split(u @ w, np.cumsum(SPLITS)[:-1].tolist(), axis=-1)


def to_heads(a, h):
    bn, t, _ = a.shape
    return a.reshape(bn, t, h, -1).transpose(0, 2, 1, 3)


def merge_heads(o):
    bn, h, t, hd = o.shape
    return o.transpose(0, 2, 1, 3).reshape(bn, t, h * hd)


def merge_gqa_heads(o):
    bn, kv, g, t, hd = o.shape
    return o.transpose(0, 3, 1, 2, 4).reshape(bn, t, kv * g * hd)


def hgrn2_forget(z, lb):
    zf = z.astype(jnp.float32)
    lb = lb.astype(jnp.float32)
    log_f = jnp.logaddexp(jnp.log(lb + LB_TINY), jnp.log1p(-lb) + jax.nn.log_sigmoid(zf))
    k = (1.0 - lb) * jax.nn.sigmoid(-zf)
    return log_f, k


def hgrn2_prep(aq, af_f, af_b, ai, lb):
    q = to_heads(aq.astype(jnp.float32), A_HEADS) * (A_DK ** -0.5)
    lf_f, k_f = hgrn2_forget(af_f, lb[0])
    lf_b, k_b = hgrn2_forget(af_b, lb[1])
    v = to_heads(ai.astype(jnp.float32), A_HEADS)
    return (q, to_heads(lf_f, A_HEADS), to_heads(k_f, A_HEADS),
            to_heads(lf_b, A_HEADS), to_heads(k_b, A_HEADS), v)


def gla_chunked(q, k, v, log_f, s0):
    bn, h, t, dk = q.shape
    dv = v.shape[-1]
    n = t // A_CHUNK

    def chunks(a):
        return jnp.moveaxis(a.reshape(bn, h, n, A_CHUNK, a.shape[-1]), 2, 0)

    tri = jnp.tril(jnp.ones((A_CHUNK, A_CHUNK), dtype=bool))

    def step(s, inp):
        qc, kc, vc, gc = inp
        b = jnp.cumsum(gc, axis=2)
        bl = b[:, :, -1:, :]
        o_inter = jnp.einsum('bhtk,bhkv->bhtv', qc * jnp.exp(b), s)
        diff = b[:, :, :, None, :] - b[:, :, None, :, :]
        decay = jnp.where(tri[:, :, None], jnp.exp(jnp.minimum(diff, 0.0)), 0.0)
        scores = jnp.einsum('bhtsk,bhsk->bhts', qc[:, :, :, None, :] * decay, kc)
        o_intra = jnp.einsum('bhts,bhsv->bhtv', scores, vc)
        s_new = jnp.exp(bl[:, :, 0, :])[..., None] * s + jnp.einsum('bhsk,bhsv->bhkv', kc * jnp.exp(bl - b), vc)
        return s_new, o_inter + o_intra

    s_fin, o = lax.scan(step, s0, (chunks(q), chunks(k), chunks(v), chunks(log_f)))
    o = jnp.moveaxis(o, 0, 2).reshape(bn, h, t, dv)
    return o, s_fin


def hgrn2_bidir(q, lf_f, k_f, lf_b, k_b, v, s_f0, s_b0):
    o_f, s_f = gla_chunked(q, k_f, v, lf_f, s_f0)
    flip = lambda a: jnp.flip(a, axis=2)
    o_b, s_b = gla_chunked(flip(q), flip(k_b), flip(v), flip(lf_b), s_b0)
    return o_f + flip(o_b), s_f, s_b


def hgrn2_readout(o, og, gn):
    bn, h, t, dv = o.shape
    g = og.reshape(bn, t, h, dv).astype(jnp.float32)
    y = rmsnorm(o.transpose(0, 2, 1, 3), gn) * jax.nn.silu(g)
    return y.reshape(bn, t, h * dv).astype(og.dtype)


def axial_rope(t):
    pos = jnp.arange(t)
    row = (pos // GRID_W).astype(jnp.float32)
    col = (pos % GRID_W).astype(jnp.float32)
    n = B_HD // 4
    inv = ROPE_THETA ** (-jnp.arange(n, dtype=jnp.float32) / n)
    ang = jnp.concatenate([row[:, None] * inv, col[:, None] * inv], axis=-1)
    return jnp.cos(ang), jnp.sin(ang)


def apply_rope(x, cos, sin):
    bn, t, h, hd = x.shape
    xp = x.astype(jnp.float32).reshape(bn, t, h, hd // 2, 2)
    x1, x2 = xp[..., 0], xp[..., 1]
    cs = cos[None, :, None, :]
    sn = sin[None, :, None, :]
    out = jnp.stack([x1 * cs - x2 * sn, x1 * sn + x2 * cs], axis=-1).reshape(bn, t, h, hd)
    return out.astype(x.dtype)


def gqa_prep(bq, bk, bv, qn, kn, rope):
    bn, t, _ = bq.shape
    q = rmsnorm(bq.reshape(bn, t, B_HEADS, B_HD), qn)
    k = rmsnorm(bk.reshape(bn, t, B_KV_HEADS, B_HD), kn)
    if rope is not None:
        q = apply_rope(q, rope[0], rope[1])
        k = apply_rope(k, rope[0], rope[1])
    q = q.reshape(bn, t, B_KV_HEADS, B_GROUP, B_HD).transpose(0, 2, 3, 1, 4)
    k = k.transpose(0, 2, 1, 3)
    v = bv.reshape(bn, t, B_KV_HEADS, B_HD).transpose(0, 2, 1, 3)
    return q, k, v


def softmax_attend(q, k, v):
    s = jnp.einsum('bngqd,bnkd->bngqk', q, k).astype(jnp.float32) * (q.shape[-1] ** -0.5)
    p = jax.nn.softmax(s, axis=-1).astype(v.dtype)
    return jnp.einsum('bngqk,bnkd->bngqd', p, v)


def gqa_latent(q, k, v):
    bn, kv, g, t, hd = q.shape
    nb = t // B_QBLOCK
    qb = jnp.moveaxis(q.reshape(bn, kv, g, nb, B_QBLOCK, hd), 3, 0)
    ob = lax.map(lambda qi: softmax_attend(qi, k, v), qb)
    return jnp.moveaxis(ob, 0, 3).reshape(bn, kv, g, t, hd)


def nat_prep(cq, ck, cv, qn, kn):
    bn, t, _ = cq.shape
    q = rmsnorm(cq.reshape(bn, t, C_HEADS, C_HD), qn).transpose(0, 2, 1, 3)
    k = rmsnorm(ck.reshape(bn, t, C_HEADS, C_HD), kn).transpose(0, 2, 1, 3)
    v = cv.reshape(bn, t, C_HEADS, C_HD).transpose(0, 2, 1, 3)
    return q, k, v


def neighborhood_latent(q, k, v, kc, vc, bias_tab):
    bn, h, t, hd = q.shape
    rows = t // GRID_W
    kr = min(WIN_R, rows)
    nw = kr * WIN_C
    col = jnp.arange(GRID_W)
    c0 = jnp.clip(col - WIN_C // 2, 0, GRID_W - WIN_C)
    win_cols = c0[:, None] + jnp.arange(WIN_C)
    dc = win_cols - col[:, None] + (WIN_C - 1)
    bias_tab = bias_tab.astype(jnp.float32)
    scale = hd ** -0.5

    def row_block(r):
        r0 = jnp.clip(r - kr // 2, 0, rows - kr)
        win_rows = r0 + jnp.arange(kr)
        idx = (win_rows[None, :, None] * GRID_W + win_cols[:, None, :]).reshape(GRID_W, nw)
        dr = win_rows - r + (WIN_R - 1)
        bias = bias_tab[:, dr[None, :, None], dc[:, None, :]].reshape(h, GRID_W, nw)
        qr = lax.dynamic_slice_in_dim(q, r * GRID_W, GRID_W, axis=2)
        kg = k[:, :, idx, :]
        vg = v[:, :, idx, :]
        s_win = jnp.einsum('bhqd,bhqkd->bhqk', qr, kg).astype(jnp.float32) * scale + bias
        s_ctx = jnp.einsum('bhqd,bhcd->bhqc', qr, kc).astype(jnp.float32) * scale
        p = jax.nn.softmax(jnp.concatenate([s_win, s_ctx], axis=-1), axis=-1).astype(v.dtype)
        return (jnp.einsum('bhqk,bhqkd->bhqd', p[..., :nw], vg)
                + jnp.einsum('bhqc,bhcd->bhqd', p[..., nw:], vc))

    out = lax.map(row_block, jnp.arange(rows))
    return jnp.moveaxis(out, 0, 2).reshape(bn, h, t, hd)


def merge_branches(ya, yb, yc, gates, w_br, w_o):
    bn, t, _ = ya.shape
    y = jnp.stack([ya, yb, yc], axis=2)
    proj = jnp.einsum('btkw,kwd->btkd', y, w_br)
    g = jax.nn.sigmoid(gates.reshape(bn, t, N_BRANCH, -1))
    return jnp.sum(g * proj, axis=2) @ w_o


def swiglu(h, w_gu, w_d):
    a, b = jnp.split(h @ w_gu, 2, axis=-1)
    return (jax.nn.silu(a) * b) @ w_d


def setup_inputs(seed: int = 0) -> dict:
    key = jax.random.key(seed)
    ks = jax.random.split(key, 20)
    nrm = jax.random.normal
    d = D_MODEL
    f32 = jnp.float32
    return {
        'x': nrm(ks[0], (BATCH, SEQ, d), f32),
        'c': nrm(ks[1], (BATCH, d), f32),
        'ctx': nrm(ks[2], (BATCH, CTX_LEN, d), f32),
        'c_ctx': nrm(ks[3], (d,), f32),
        'w_mod': nrm(ks[4], (DEPTH, d, 6 * d), f32) * (0.5 * d ** -0.5),
        'b_mod': nrm(ks[5], (DEPTH, 6 * d), f32) * 0.02,
        'norm_mix': 1.0 + 0.1 * nrm(ks[6], (DEPTH, d), f32),
        'norm_ffn': 1.0 + 0.1 * nrm(ks[7], (DEPTH, d), f32),
        'w_in': nrm(ks[8], (DEPTH, d, IN_WIDTH), f32) * d ** -0.5,
        'lb_raw': nrm(ks[9], (DEPTH, 2, A_HEADS * A_DK), f32),
        'gn_a': 1.0 + 0.1 * nrm(ks[10], (DEPTH, A_DV), f32),
        'qn_b': 1.0 + 0.1 * nrm(ks[11], (DEPTH, B_HD), f32),
        'kn_b': 1.0 + 0.1 * nrm(ks[12], (DEPTH, B_HD), f32),
        'qn_c': 1.0 + 0.1 * nrm(ks[13], (DEPTH, C_HD), f32),
        'kn_c': 1.0 + 0.1 * nrm(ks[14], (DEPTH, C_HD), f32),
        'rel_bias': 0.5 * nrm(ks[15], (DEPTH, C_HEADS, 2 * WIN_R - 1, 2 * WIN_C - 1), f32),
        'w_branch': nrm(ks[16], (DEPTH, N_BRANCH, BRANCH_W, d), f32) * BRANCH_W ** -0.5,
        'w_out': nrm(ks[17], (DEPTH, d, d), f32) * d ** -0.5,
        'w_gate_up': nrm(ks[18], (DEPTH, d, 2 * FFN_HIDDEN), f32) * d ** -0.5,
        'w_down': nrm(ks[19], (DEPTH, FFN_HIDDEN, d), f32) * FFN_HIDDEN ** -0.5,
    }


def reference(x, c, ctx, c_ctx, w_mod, b_mod, norm_mix, norm_ffn, w_in, lb_raw, gn_a,
              qn_b, kn_b, qn_c, kn_c, rel_bias, w_branch, w_out, w_gate_up, w_down):
    bn, t, _ = x.shape
    rope = axial_rope(t)
    lbp = jax.nn.softmax(lb_raw.astype(jnp.float32), axis=0)
    lb_all = jnp.clip(jnp.cumsum(lbp, axis=0) - lbp[:1], 0.0, 1.0 - 1e-6)
    s_zero = jnp.zeros((bn, A_HEADS, A_DK, A_DV), jnp.float32)
    xc = ctx
    for l in range(DEPTH):
        ctx_next = l < DEPTH - 1
        mod = (jax.nn.silu(c) @ w_mod[l] + b_mod[l])[:, None, :]
        mod_c = jax.nn.silu(c_ctx) @ w_mod[l] + b_mod[l]
        sh1, sc1, g1, sh2, sc2, g2 = jnp.split(mod, 6, axis=-1)
        csh1, csc1, cg1, csh2, csc2, cg2 = jnp.split(mod_c, 6, axis=-1)
        u = rmsnorm(x, norm_mix[l]) * (1.0 + sc1) + sh1
        uc = rmsnorm(xc, norm_mix[l]) * (1.0 + csc1) + csh1
        aq, af_f, af_b, ai, ag, bq, bk, bv, cq, ck, cv, gt = project(u, w_in[l])
        caq, caf_f, caf_b, cai, cag, cbq, cbk, cbv, ccq, cck, ccv, cgt = project(uc, w_in[l])

        o_a_ctx, s_f, s_b = hgrn2_bidir(*hgrn2_prep(caq, caf_f, caf_b, cai, lb_all[l]), s_zero, s_zero)
        o_a, _, _ = hgrn2_bidir(*hgrn2_prep(aq, af_f, af_b, ai, lb_all[l]), s_f, s_b)
        ya = hgrn2_readout(o_a, ag, gn_a[l])

        qb, kb, vb = gqa_prep(bq, bk, bv, qn_b[l], kn_b[l], rope)
        qbc, kbc, vbc = gqa_prep(cbq, cbk, cbv, qn_b[l], kn_b[l], None)
        yb = merge_gqa_heads(gqa_latent(qb, jnp.concatenate([kb, kbc], axis=2),
                                        jnp.concatenate([vb, vbc], axis=2)))

        qn_, kn_, vn_ = nat_prep(cq, ck, cv, qn_c[l], kn_c[l])
        qnc, knc, vnc = nat_prep(ccq, cck, ccv, qn_c[l], kn_c[l])
        yc = merge_heads(neighborhood_latent(qn_, kn_, vn_, knc, vnc, rel_bias[l]))

        x = x + g1 * merge_branches(ya, yb, yc, gt, w_branch[l], w_out[l])
        h = rmsnorm(x, norm_ffn[l]) * (1.0 + sc2) + sh2
        x = x + g2 * swiglu(h, w_gate_up[l], w_down[l])

        if ctx_next:
            ya_c = hgrn2_readout(o_a_ctx, cag, gn_a[l])
            yb_c = merge_gqa_heads(softmax_attend(qbc, kbc, vbc))
            yc_c = merge_heads(softmax_attend(qnc[:, :, None], knc, vnc)[:, :, 0])
            xc = xc + cg1 * merge_branches(ya_c, yb_c, yc_c, cgt, w_branch[l], w_out[l])
            hc = rmsnorm(xc, norm_ffn[l]) * (1.0 + csc2) + csh2
            xc = xc + cg2 * swiglu(hc, w_gate_up[l], w_down[l])
    return x
```

```cpp
#include <hip/hip_runtime.h>
#include <hip/hip_cooperative_groups.h>
#include <cstdio>
namespace cg = cooperative_groups;

typedef short bf16x8 __attribute__((ext_vector_type(8)));
typedef short s16x4 __attribute__((ext_vector_type(4)));
typedef float f32x16 __attribute__((ext_vector_type(16)));
typedef float f32x2 __attribute__((ext_vector_type(2)));
typedef __bf16 bf16x2_t __attribute__((ext_vector_type(2)));
typedef unsigned short bf16_t;
#define DI __device__ __forceinline__
#define MFMA(a, b, c) __builtin_amdgcn_mfma_f32_32x32x16_bf16((a), (b), (c), 0, 0, 0)

constexpr int D = 1024, NB = 4, SEQ = 4096, CL = 256, PT = 4352, NT = NB * PT;
constexpr int INW = 7936, INW2 = 8448, PW = 5376, FH = 2816, GU = 5632;
constexpr float EPS = 1e-6f;

constexpr size_t SZ512 = (size_t)NT * 512 * 2;
constexpr size_t SZ128 = (size_t)NT * 128 * 2;
constexpr size_t O_WIN = 0;
constexpr size_t O_WBR = O_WIN + (size_t)INW2 * D * 2;
constexpr size_t O_WOUT = O_WBR + (size_t)3 * D * 512 * 2;
constexpr size_t O_WGU = O_WOUT + (size_t)D * D * 2;
constexpr size_t O_WD = O_WGU + (size_t)GU * D * 2;
constexpr size_t O_UO = O_WD + (size_t)D * FH * 2;
constexpr size_t O_P = O_UO + (size_t)NT * 1024 * 2;
constexpr size_t O_QHF = O_P;
constexpr size_t O_KTF = O_QHF + SZ512;
constexpr size_t O_QHB = O_KTF + SZ512;
constexpr size_t O_KTB = O_QHB + SZ512;
constexpr size_t O_VA = O_KTB + SZ512;
constexpr size_t O_OG = O_VA + SZ512;
constexpr size_t O_BQ = O_OG + SZ512;
constexpr size_t O_CQ = O_BQ + SZ512;
constexpr size_t O_CK = O_CQ + SZ512;
constexpr size_t O_CVT = O_CK + SZ512;
constexpr size_t O_BK = O_CVT + SZ512;
constexpr size_t O_BVT = O_BK + SZ128;
constexpr size_t O_EBL = O_BVT + SZ128;
constexpr size_t O_XC = O_EBL + (size_t)2 * (NT / 32) * 512 * 4;
constexpr size_t O_MOD = O_XC + (size_t)NB * CL * D * 4;
constexpr size_t O_ROPE = O_MOD + (size_t)2 * 5 * 6144 * 4;
constexpr size_t O_CTR = O_ROPE + 64 * 16 * 2 * 4;
constexpr size_t WS_END = O_CTR + (64 + 4 * 4096) * 4;
constexpr size_t O_M = O_QHB;
constexpr size_t O_ACT = O_P;

constexpr int LDS_BYTES = 73728;
constexpr int LSTR = 72;

struct Params {
  const float* x; const float* c; const float* ctx; const float* c_ctx; const float* w_mod; const float* b_mod;
  const float* norm_mix; const float* norm_ffn; const float* w_in; const float* lb_raw; const float* gn_a;
  const float* qn_b; const float* kn_b; const float* qn_c; const float* kn_c; const float* rel_bias;
  const float* w_branch; const float* w_out; const float* w_gate_up; const float* w_down;
  float* out; unsigned char* ws;
};


typedef const unsigned long long __attribute__((address_space(4))) karg_t;
DI unsigned long long karg(int i) { return *(volatile karg_t*)((karg_t*)__builtin_amdgcn_kernarg_segment_ptr() + i); }
DI int tid_() { int t = threadIdx.x; asm volatile("" : "+v"(t)); return t; }
DI unsigned pack2(float a, float b) {
  f32x2 v = {a, b};
  bf16x2_t r = __builtin_convertvector(v, bf16x2_t);
  return __builtin_bit_cast(unsigned, r);
}
DI bf16_t tobf(float a) { return (bf16_t)(pack2(a, 0.f) & 0xffffu); }
DI float bflo(unsigned u) { return __uint_as_float(u << 16); }
DI float bfhi(unsigned u) { return __uint_as_float(u & 0xffff0000u); }
DI float sigmoidf_(float x) { return 1.f / (1.f + __expf(-x)); }
DI float siluf_(float x) { return x / (1.f + __expf(-x)); }
DI float shx(float v, int m) { return __shfl_xor(v, m); }

DI void gemm_tile(const bf16_t* A, int lda, const bf16_t* Bt, int ldb, int K,
                  f32x16 (&acc)[2][2], unsigned char* smem) {
  const int tid = tid_(), lane = tid & 63, w = tid >> 6, wm = w >> 1, wn = w & 1;
  bf16_t* sa = (bf16_t*)smem;
  bf16_t* sb = sa + 2 * 128 * LSTR;
  const int lrow = tid >> 3, lkc = (tid & 7) * 8;
  const bf16_t* ga = A + (size_t)lrow * lda + lkc;
  const bf16_t* gb = Bt + (size_t)lrow * ldb + lkc;
  uint4 pa0, pa1, pa2, pa3, pb0, pb1, pb2, pb3;
  uint4 qa0, qa1, qa2, qa3, qb0, qb1, qb2, qb3;
#define GT_LOAD(S, koff) { \
    S##a0 = *(const uint4*)(ga + (koff)); S##a1 = *(const uint4*)(ga + (size_t)32 * lda + (koff)); \
    S##a2 = *(const uint4*)(ga + (size_t)64 * lda + (koff)); S##a3 = *(const uint4*)(ga + (size_t)96 * lda + (koff)); \
    S##b0 = *(const uint4*)(gb + (koff)); S##b1 = *(const uint4*)(gb + (size_t)32 * ldb + (koff)); \
    S##b2 = *(const uint4*)(gb + (size_t)64 * ldb + (koff)); S##b3 = *(const uint4*)(gb + (size_t)96 * ldb + (koff)); \
    asm volatile("" ::: "memory"); __builtin_amdgcn_sched_barrier(0); }
#define GT_STORE(S, bufi) { \
    bf16_t* da_ = sa + (bufi) * 128 * LSTR + lrow * LSTR + lkc; bf16_t* db_ = sb + (bufi) * 128 * LSTR + lrow * LSTR + lkc; \
    *(uint4*)(da_) = S##a0; *(uint4*)(da_ + 32 * LSTR) = S##a1; *(uint4*)(da_ + 64 * LSTR) = S##a2; *(uint4*)(da_ + 96 * LSTR) = S##a3; \
    *(uint4*)(db_) = S##b0; *(uint4*)(db_ + 32 * LSTR) = S##b1; *(uint4*)(db_ + 64 * LSTR) = S##b2; *(uint4*)(db_ + 96 * LSTR) = S##b3; }
#define GT_FRAGS(F0, F1, G0, G1, KS) \
    F0 = *(const bf16x8*)(as + (KS) * 16); F1 = *(const bf16x8*)(as + 32 * LSTR + (KS) * 16); \
    G0 = *(const bf16x8*)(bs + (KS) * 16); G1 = *(const bf16x8*)(bs + 32 * LSTR + (KS) * 16);
#define GEMM_STEP(A0, A1, B0, B1, PRE, ST0, ST1) \
    PRE \
    acc[0][0] = MFMA(A0, B0, acc[0][0]); acc[0][1] = MFMA(A0, B1, acc[0][1]); \
    ST0; ST1; \
    acc[1][0] = MFMA(A1, B0, acc[1][0]); acc[1][1] = MFMA(A1, B1, acc[1][1]); \
    __builtin_amdgcn_sched_barrier(0);
#define GT_COMPUTE(bufi, S, sbuf) { \
    const bf16_t* as = sa + (bufi) * 128 * LSTR + wm * 64 * LSTR + fo; \
    const bf16_t* bs = sb + (bufi) * 128 * LSTR + wn * 64 * LSTR + fo; \
    bf16_t* da_ = sa + (sbuf) * 128 * LSTR + lrow * LSTR + lkc; bf16_t* db_ = sb + (sbuf) * 128 * LSTR + lrow * LSTR + lkc; \
    bf16x8 a0, a1, b0, b1, c0, c1, d0, d1, e0, e1, f0, f1; \
    GT_FRAGS(a0, a1, b0, b1, 0) GT_FRAGS(c0, c1, d0, d1, 1) \
    GEMM_STEP(a0, a1, b0, b1, GT_FRAGS(e0, e1, f0, f1, 2), *(uint4*)(da_) = S##a0, *(uint4*)(db_) = S##b0) \
    GEMM_STEP(c0, c1, d0, d1, GT_FRAGS(a0, a1, b0, b1, 3), *(uint4*)(da_ + 32 * LSTR) = S##a1, *(uint4*)(db_ + 32 * LSTR) = S##b1) \
    GEMM_STEP(e0, e1, f0, f1, , *(uint4*)(da_ + 64 * LSTR) = S##a2, *(uint4*)(db_ + 64 * LSTR) = S##b2) \
    GEMM_STEP(a0, a1, b0, b1, , *(uint4*)(da_ + 96 * LSTR) = S##a3, *(uint4*)(db_ + 96 * LSTR) = S##b3) }
  const int nk = K >> 6;
  const int fo = (lane & 31) * LSTR + (lane >> 5) * 8;
  GT_LOAD(p, 0)
  GT_LOAD(q, 64)
  GT_STORE(p, 0)
  __syncthreads();
  for (int kt = 0; kt < nk; kt += 2) {
    GT_LOAD(p, min(kt + 2, nk - 1) * 64)
    GT_COMPUTE(0, q, 1)
    __syncthreads();
    GT_LOAD(q, min(kt + 3, nk - 1) * 64)
    GT_COMPUTE(1, p, 0)
    __syncthreads();
  }
}
DI void zero_acc(f32x16 (&acc)[2][2]) {
#pragma unroll
  for (int i = 0; i < 2; ++i)
#pragma unroll
    for (int j = 0; j < 2; ++j)
#pragma unroll
      for (int r = 0; r < 16; ++r) acc[i][j][r] = 0.f;
}

DI void cvt_tile(const float* __restrict__ src, int ldsrc, int k0, int scol0a, int scol0b, bf16_t* __restrict__ dst, int K, int n0,
                 unsigned char* smem) {
  float* t = (float*)smem;
  const int tid = tid_();
  {
    const int kk = tid >> 4, c4 = (tid & 15) * 4;
    const int sc = (c4 < 32) ? (scol0a + c4) : (scol0b + c4 - 32);
#pragma unroll
    for (int i = 0; i < 4; ++i) {
      const int k = kk + i * 16;
      float4 v = *(const float4*)(src + (size_t)(k0 + k) * ldsrc + sc);
      t[k * 65 + c4 + 0] = v.x; t[k * 65 + c4 + 1] = v.y; t[k * 65 + c4 + 2] = v.z; t[k * 65 + c4 + 3] = v.w;
    }
  }
  __syncthreads();
  {
    const int n = tid >> 2, kq = (tid & 3) * 16;
    unsigned o[8];
#pragma unroll
    for (int j = 0; j < 8; ++j) o[j] = pack2(t[(kq + 2 * j) * 65 + n], t[(kq + 2 * j + 1) * 65 + n]);
    bf16_t* d = dst + (size_t)(n0 + n) * K + k0 + kq;
    *(uint4*)d = make_uint4(o[0], o[1], o[2], o[3]);
    *(uint4*)(d + 8) = make_uint4(o[4], o[5], o[6], o[7]);
  }
  __syncthreads();
}
constexpr int CVT_ITEMS = 2112 + 384 + 256 + 1408 + 704;
DI void cvt_item(const Params& p, int l, int it, unsigned char* smem) {
  unsigned char* ws = ((unsigned char*)(__attribute__((address_space(1))) unsigned char*)karg(21));
  if (it < 2112) {
    const int kt = it & 15, nt = it >> 4;
    int ca, cb;
    if (nt < 16) { ca = 32 * nt; cb = 512 + 32 * nt; }
    else if (nt < 32) { ca = 32 * (nt - 16); cb = 1024 + 32 * (nt - 16); }
    else { ca = 64 * (nt - 32) + 1536; cb = ca + 32; }
    cvt_tile(((const float*)(const __attribute__((address_space(1))) float*)karg(8)) + (size_t)l * D * INW, INW, kt * 64, ca, cb, (bf16_t*)(ws + O_WIN), D, nt * 64, smem);
    return;
  }
  it -= 2112;
  if (it < 384) {
    const int kb = it / 128, r = it % 128, kt = r & 7, nt = r >> 3;
    cvt_tile(((const float*)(const __attribute__((address_space(1))) float*)karg(16)) + ((size_t)l * 3 + kb) * 512 * D, D, kt * 64, nt * 64, nt * 64 + 32, (bf16_t*)(ws + O_WBR) + (size_t)kb * D * 512, 512, nt * 64, smem);
    return;
  }
  it -= 384;
  if (it < 256) {
    const int kt = it & 15, nt = it >> 4;
    cvt_tile(((const float*)(const __attribute__((address_space(1))) float*)karg(17)) + (size_t)l * D * D, D, kt * 64, nt * 64, nt * 64 + 32, (bf16_t*)(ws + O_WOUT), D, nt * 64, smem);
    return;
  }
  it -= 256;
  if (it < 1408) {
    const int kt = it & 15, nt = it >> 4;
    const int tile = nt >> 1, wn = nt & 1;
    const int hid = tile * 64 + wn * 32;
    cvt_tile(((const float*)(const __attribute__((address_space(1))) float*)karg(18)) + (size_t)l * D * GU, GU, kt * 64, hid, FH + hid, (bf16_t*)(ws + O_WGU), D, nt * 64, smem);
    return;
  }
  it -= 1408;
  {
    const int kt = it % 44, nt = it / 44;
    cvt_tile(((const float*)(const __attribute__((address_space(1))) float*)karg(19)) + (size_t)l * FH * D, D, kt * 64, nt * 64, nt * 64 + 32, (bf16_t*)(ws + O_WD), FH, nt * 64, smem);
  }
}
DI void mod_item(const Params& p, int it, unsigned char* smem) {
  float* sc = (float*)smem;
  float* red = sc + 5 * 1024;
  const int tid = tid_();
  const int l = it / 192, cb = it % 192;
  for (int i = tid; i < 5 * 1024; i += 256) {
    const int r = i >> 10, k = i & 1023;
    const float v = (r < 4) ? ((const float*)(const __attribute__((address_space(1))) float*)karg(1))[r * 1024 + k] : ((const float*)(const __attribute__((address_space(1))) float*)karg(3))[k];
    sc[i] = siluf_(v);
  }
  __syncthreads();
  const int c = tid & 31, kg = tid >> 5;
  const int col = cb * 32 + c;
  const float* w = ((const float*)(const __attribute__((address_space(1))) float*)karg(4)) + (size_t)l * D * 6144 + col;
  float a0 = 0, a1 = 0, a2 = 0, a3 = 0, a4 = 0;
#pragma unroll 8
  for (int k = kg * 128; k < kg * 128 + 128; ++k) {
    const float wv = w[(size_t)k * 6144];
    a0 += sc[k] * wv; a1 += sc[1024 + k] * wv; a2 += sc[2048 + k] * wv; a3 += sc[3072 + k] * wv; a4 += sc[4096 + k] * wv;
  }
  red[(kg * 5 + 0) * 32 + c] = a0; red[(kg * 5 + 1) * 32 + c] = a1; red[(kg * 5 + 2) * 32 + c] = a2;
  red[(kg * 5 + 3) * 32 + c] = a3; red[(kg * 5 + 4) * 32 + c] = a4;
  __syncthreads();
  if (tid < 160) {
    const int r = tid >> 5, cc = tid & 31;
    float s = 0;
#pragma unroll
    for (int g = 0; g < 8; ++g) s += red[(g * 5 + r) * 32 + cc];
    const int colo = cb * 32 + cc;
    float* modf = (float*)(((unsigned char*)(__attribute__((address_space(1))) unsigned char*)karg(21)) + O_MOD);
    modf[((size_t)l * 5 + r) * 6144 + colo] = s + ((const float*)(const __attribute__((address_space(1))) float*)karg(5))[l * 6144 + colo];
  }
  __syncthreads();
}

DI const float* xrow_ptr(const Params& p, int l, int stage, int row) {
  const int b = row / PT, q = row % PT;
  if (q < CL) {
    const size_t o = ((size_t)b * CL + q) * D;
    return (l == 0 && stage == 0) ? ((const float*)(const __attribute__((address_space(1))) float*)karg(2)) + o : (const float*)(((unsigned char*)(__attribute__((address_space(1))) unsigned char*)karg(21)) + O_XC) + o;
  }
  const size_t o = ((size_t)b * SEQ + (q - CL)) * D;
  return (l == 0 && stage == 0) ? ((const float*)(const __attribute__((address_space(1))) float*)karg(0)) + o : ((float*)(__attribute__((address_space(1))) float*)karg(20)) + o;
}
DI void norm_row(const Params& p, int l, int stage, int row, const float* __restrict__ nw, int shoff, int scoff) {
  const int lane = tid_() & 63;
  const float* xr = xrow_ptr(p, l, stage, row);
  const int b = row / PT, q = row % PT;
  const float* modf = (const float*)(((unsigned char*)(__attribute__((address_space(1))) unsigned char*)karg(21)) + O_MOD) + ((size_t)l * 5 + (q < CL ? 4 : b)) * 6144;
  float4 v[4];
  float ss = 0.f;
#pragma unroll
  for (int i = 0; i < 4; ++i) {
    v[i] = *(const float4*)(xr + i * 256 + lane * 4);
    ss += v[i].x * v[i].x + v[i].y * v[i].y + v[i].z * v[i].z + v[i].w * v[i].w;
  }
#pragma unroll
  for (int m = 1; m < 64; m <<= 1) ss += shx(ss, m);
  const float rs = rsqrtf(ss * (1.f / 1024.f) + EPS);
  bf16_t* dst = (bf16_t*)(((unsigned char*)(__attribute__((address_space(1))) unsigned char*)karg(21)) + O_UO) + (size_t)row * 1024;
#pragma unroll
  for (int i = 0; i < 4; ++i) {
    const int k = i * 256 + lane * 4;
    const float4 wv = *(const float4*)(nw + k);
    const float4 sc = *(const float4*)(modf + scoff + k);
    const float4 sh = *(const float4*)(modf + shoff + k);
    const float y0 = v[i].x * rs * wv.x * (1.f + sc.x) + sh.x;
    const float y1 = v[i].y * rs * wv.y * (1.f + sc.y) + sh.y;
    const float y2 = v[i].z * rs * wv.z * (1.f + sc.z) + sh.z;
    const float y3 = v[i].w * rs * wv.w * (1.f + sc.w) + sh.w;
    *(uint2*)(dst + k) = make_uint2(pack2(y0, y1), pack2(y2, y3));
  }
}

DI void store4T(bf16_t* base, float a, float b, float c, float d) { *(uint2*)base = make_uint2(pack2(a, b), pack2(c, d)); }

DI void inproj_epilogue(const Params& p, int l, f32x16 (&acc)[2][2], int m0w, int n0w) {
  unsigned char* ws = ((unsigned char*)(__attribute__((address_space(1))) unsigned char*)karg(21));
  const int lane = tid_() & 63, ln = lane & 31, h = lane >> 5;
  if (n0w < 2048) {
    const int dir = n0w >> 10, ch = ((n0w & 1023) >> 6) * 32 + ln;
    float lb = 0.f;
    if (l == 1) {
      const float* lbr = ((const float*)(const __attribute__((address_space(1))) float*)karg(9));
      lb = fminf(sigmoidf_(lbr[(2 + dir) * 512 + ch] - lbr[dir * 512 + ch]), 1.f - 1e-6f);
    }
    bf16_t* qd = (bf16_t*)(ws + (dir ? O_QHB : O_QHF));
    bf16_t* kd = (bf16_t*)(ws + (dir ? O_KTB : O_KTF));
    float* ebl = (float*)(ws + O_EBL) + (size_t)dir * (NT / 32) * 512;
#pragma unroll
    for (int i = 0; i < 2; ++i) {
      const int r0 = m0w + i * 32;
      float kk[16], g2[16], gs[4], gp[4];
#pragma unroll
      for (int r = 0; r < 16; ++r) {
        kk[r] = (1.f - lb) * sigmoidf_(-acc[i][1][r]);
        g2[r] = __log2f(fmaxf(1.f - kk[r], 1e-30f));
      }
#pragma unroll
      for (int rg = 0; rg < 4; ++rg) { gs[rg] = (g2[rg * 4] + g2[rg * 4 + 1]) + (g2[rg * 4 + 2] + g2[rg * 4 + 3]); gp[rg] = shx(gs[rg], 32); }
      const float total = ((gs[0] + gp[0]) + (gs[1] + gp[1])) + ((gs[2] + gp[2]) + (gs[3] + gp[3]));
      float pre = 0.f;
#pragma unroll
      for (int rg = 0; rg < 4; ++rg) {
        float run = pre + (h ? gp[rg] : 0.f);
#pragma unroll
        for (int i4 = 0; i4 < 4; ++i4) {
          const int r = rg * 4 + i4;
          run += g2[r];
          const float bj = dir ? (total - run + g2[r]) : run;
          const size_t o = (size_t)(r0 + rg * 8 + h * 4 + i4) * 512 + ch;
          qd[o] = tobf(acc[i][0][r] * 0.08838834764831845f * exp2f(bj));
          kd[o] = tobf(kk[r] * exp2f(fminf(-bj, 115.f)));
        }
        pre += gs[rg] + gp[rg];
      }
      if (h == 0) ebl[(size_t)(r0 >> 5) * 512 + ch] = exp2f(total);
    }
    return;
  }
  if (n0w < 2560) {
    bf16_t* vt = (bf16_t*)(ws + O_VA);
#pragma unroll
    for (int i = 0; i < 2; ++i)
#pragma unroll
      for (int rg = 0; rg < 4; ++rg) {
        const int row = m0w + i * 32 + rg * 8 + h * 4;
        const int b = row / PT, q = row % PT;
#pragma unroll
        for (int j = 0; j < 2; ++j) {
          const int ch = (n0w & 511) + j * 32 + ln;
          store4T(vt + ((size_t)b * 512 + ch) * PT + q, acc[i][j][rg * 4 + 0], acc[i][j][rg * 4 + 1], acc[i][j][rg * 4 + 2], acc[i][j][rg * 4 + 3]);
        }
      }
    return;
  }
  if (n0w < 3072) {
    bf16_t* dst = (bf16_t*)(ws + O_OG);
    const int cg0 = n0w & 511;
#pragma unroll
    for (int j = 0; j < 2; ++j)
#pragma unroll
      for (int i = 0; i < 2; ++i)
#pragma unroll
        for (int r = 0; r < 16; ++r) {
          const int row = m0w + i * 32 + (r >> 2) * 8 + h * 4 + (r & 3);
          dst[(size_t)row * 512 + cg0 + j * 32 + ln] = tobf(acc[i][j][r]);
        }
    return;
  }
  n0w -= 512;
  int kind, head;
  if (n0w < 3072) { kind = 0; head = (n0w - 2560) >> 6; }
  else if (n0w < 3200) { kind = 1; head = (n0w - 3072) >> 6; }
  else if (n0w < 3328) { kind = 2; head = (n0w - 3200) >> 6; }
  else if (n0w < 3840) { kind = 3; head = (n0w - 3328) >> 6; }
  else if (n0w < 4352) { kind = 4; head = (n0w - 3840) >> 6; }
  else { kind = 5; head = (n0w - 4352) >> 6; }
  if (kind == 2 || kind == 5) {
    bf16_t* vt = (bf16_t*)(ws + (kind == 2 ? O_BVT : O_CVT));
    const int nch = (kind == 2) ? 128 : 512;
#pragma unroll
    for (int i = 0; i < 2; ++i)
#pragma unroll
      for (int rg = 0; rg < 4; ++rg) {
        const int row = m0w + i * 32 + rg * 8 + h * 4;
        const int b = row / PT, q = row % PT;
#pragma unroll
        for (int j = 0; j < 2; ++j) {
          const int ch = head * 64 + j * 32 + ln;
          store4T(vt + ((size_t)b * nch + ch) * PT + q, acc[i][j][rg * 4 + 0], acc[i][j][rg * 4 + 1], acc[i][j][rg * 4 + 2], acc[i][j][rg * 4 + 3]);
        }
      }
    return;
  }
  const float* nwp = (kind == 0 ? ((const float*)(const __attribute__((address_space(1))) float*)karg(11)) : kind == 1 ? ((const float*)(const __attribute__((address_space(1))) float*)karg(12)) : kind == 3 ? ((const float*)(const __attribute__((address_space(1))) float*)karg(13)) : ((const float*)(const __attribute__((address_space(1))) float*)karg(14))) + l * 64;
  const float nw0 = nwp[ln], nw1 = nwp[32 + ln];
  const float qscale = (kind == 0 || kind == 3) ? 0.125f * 1.4426950408889634f : 1.f;
  const bool rope = (kind <= 1);
  const float* ropet = (const float*)(ws + O_ROPE);
  bf16_t* dst; int dstride;
  if (kind == 0) { dst = (bf16_t*)(ws + O_BQ); dstride = 512; }
  else if (kind == 1) { dst = (bf16_t*)(ws + O_BK); dstride = 128; }
  else if (kind == 3) { dst = (bf16_t*)(ws + O_CQ); dstride = 512; }
  else { dst = (bf16_t*)(ws + O_CK); dstride = 512; }
#pragma unroll
  for (int i = 0; i < 2; ++i)
#pragma unroll
    for (int r = 0; r < 16; ++r) {
      const int row = m0w + i * 32 + (r >> 2) * 8 + h * 4 + (r & 3);
      float v0 = acc[i][0][r], v1 = acc[i][1][r];
      float ss = v0 * v0 + v1 * v1;
      ss += shx(ss, 1); ss += shx(ss, 2); ss += shx(ss, 4); ss += shx(ss, 8); ss += shx(ss, 16);
      const float rs = rsqrtf(ss * (1.f / 64.f) + EPS);
      v0 = v0 * rs * nw0; v1 = v1 * rs * nw1;
      if (rope) {
        const int q = row % PT;
        const float p0 = shx(v0, 1), p1 = shx(v1, 1);
        if (q >= CL) {
          const int t = q - CL, gr = t >> 6, gc = t & 63;
          const int fj = ln >> 1;
          const float2 cs0 = *(const float2*)(ropet + (gr * 16 + fj) * 2);
          const float2 cs1 = *(const float2*)(ropet + (gc * 16 + fj) * 2);
          if (ln & 1) { v0 = p0 * cs0.y + v0 * cs0.x; v1 = p1 * cs1.y + v1 * cs1.x; }
          else { v0 = v0 * cs0.x - p0 * cs0.y; v1 = v1 * cs1.x - p1 * cs1.y; }
        }
      }
      dst[(size_t)row * dstride + head * 64 + ln] = tobf(v0 * qscale);
      dst[(size_t)row * dstride + head * 64 + 32 + ln] = tobf(v1 * qscale);
    }
}

constexpr int AQS = 136, ATS = 40;
constexpr int A_QH = 0, A_KT = A_QH + 32 * AQS * 2, A_KBT = A_KT + 32 * AQS * 2, A_VT = A_KBT + 128 * ATS * 2, A_EBL = A_VT + 128 * ATS * 2;
DI bf16x8 pack8(const f32x16& x, int o) {
  return __builtin_bit_cast(bf16x8, make_uint4(pack2(x[o + 0], x[o + 1]), pack2(x[o + 2], x[o + 3]), pack2(x[o + 4], x[o + 5]), pack2(x[o + 6], x[o + 7])));
}
template <int DIR> DI int ac_tb(int c) {
  const int s = c * 32;
  return DIR == 0 ? s : (s < CL ? (CL - 32 - s) : (PT + CL - 32 - s));
}
constexpr int A_VT2 = A_EBL + 512, A_EBL2 = A_VT2 + 128 * ATS * 2;
template <int DIR> DI void a_chunk_run(unsigned char* ws, int b, int hd, unsigned char* smem) {
  const int tid = tid_(), lane = tid & 63, w = tid >> 6, ln = lane & 31, hh = lane >> 5;
  const int kc = tid >> 1, half = tid & 1;
  const int sj = tid >> 3, cg = tid & 7;
  const size_t rb = (size_t)b * PT;
  const bf16_t* qg = (const bf16_t*)(ws + (DIR ? O_QHB : O_QHF)) + (rb + sj) * 512 + hd * 128 + cg * 16;
  const bf16_t* kg = (const bf16_t*)(ws + (DIR ? O_KTB : O_KTF)) + (rb + sj) * 512 + hd * 128 + cg * 16;
  const bf16_t* vg = (const bf16_t*)(ws + O_VA) + ((size_t)b * 512 + hd * 128 + kc) * PT + half * 16;
  const float* eg = (const float*)(ws + O_EBL) + (size_t)DIR * (NT / 32) * 512 + hd * 128 + kc;
  bf16_t* og = (bf16_t*)(ws + O_UO) + rb * 1024 + DIR * 512 + hd * 128 + w * 32 + ln;
  bf16_t* Qh = (bf16_t*)(smem + A_QH); bf16_t* Kt = (bf16_t*)(smem + A_KT);
  bf16_t* KtT = (bf16_t*)(smem + A_KBT);
  f32x16 S0, S1, S2, S3;
#pragma unroll
  for (int r = 0; r < 16; ++r) { S0[r] = 0.f; S1[r] = 0.f; S2[r] = 0.f; S3[r] = 0.f; }
  uint4 q0, q1, k0, k1, v0, v1;
  float pe;
#define A_PREFETCH(cc) { const int tb_ = ac_tb<DIR>(cc); \
    q0 = *(const uint4*)(qg + (size_t)tb_ * 512); q1 = *(const uint4*)(qg + (size_t)tb_ * 512 + 8); \
    k0 = *(const uint4*)(kg + (size_t)tb_ * 512); k1 = *(const uint4*)(kg + (size_t)tb_ * 512 + 8); \
    v0 = *(const uint4*)(vg + tb_); v1 = *(const uint4*)(vg + tb_ + 8); \
    pe = eg[(size_t)((rb + tb_) >> 5) * 512]; }
  A_PREFETCH(0)
#pragma unroll 1
  for (int c = 0; c < PT / 32; ++c) {
    bf16_t* Vt = (bf16_t*)(smem + ((c & 1) ? A_VT2 : A_VT));
    float* ebl = (float*)(smem + ((c & 1) ? A_EBL2 : A_EBL));
    *(uint4*)(Qh + sj * AQS + cg * 16) = q0; *(uint4*)(Qh + sj * AQS + cg * 16 + 8) = q1;
    *(uint4*)(Kt + sj * AQS + cg * 16) = k0; *(uint4*)(Kt + sj * AQS + cg * 16 + 8) = k1;
    *(uint4*)(Vt + kc * ATS + half * 16) = v0; *(uint4*)(Vt + kc * ATS + half * 16 + 8) = v1;
    if (half == 0) ebl[kc] = pe;
    __syncthreads();
    A_PREFETCH(min(c + 1, PT / 32 - 1))
    unsigned short kt16[16];
#pragma unroll
    for (int jj = 0; jj < 16; ++jj) kt16[jj] = Kt[(half * 16 + jj) * AQS + kc];
    f32x16 at, o;
#pragma unroll
    for (int r = 0; r < 16; ++r) { at[r] = 0.f; o[r] = 0.f; }
#pragma unroll
    for (int ks = 0; ks < 8; ++ks) {
      const bf16x8 a = *(const bf16x8*)(Kt + ln * AQS + ks * 16 + hh * 8);
      const bf16x8 bq = *(const bf16x8*)(Qh + ln * AQS + ks * 16 + hh * 8);
      at = MFMA(a, bq, at);
    }
#pragma unroll
    for (int r = 0; r < 16; ++r) {
      const int s_ = (r >> 2) * 8 + hh * 4 + (r & 3);
      at[r] = (DIR == 0 ? (s_ <= ln) : (s_ >= ln)) ? at[r] : 0.f;
    }
#define A_INTER(SK, kb) { \
      _Pragma("unroll") for (int st = 0; st < 2; ++st) { \
        const bf16x8 pb = pack8(SK, 8 * st); \
        const s16x4 lo = *(const s16x4*)(Qh + ln * AQS + (kb) * 32 + 16 * st + 4 * hh); \
        const s16x4 hi = *(const s16x4*)(Qh + ln * AQS + (kb) * 32 + 16 * st + 4 * hh + 8); \
        o = MFMA(__builtin_shufflevector(lo, hi, 0, 1, 2, 3, 4, 5, 6, 7), pb, o); } }
    A_INTER(S0, 0) A_INTER(S1, 1) A_INTER(S2, 2) A_INTER(S3, 3)
#pragma unroll
    for (int st = 0; st < 2; ++st) {
      const bf16x8 pa = pack8(at, 8 * st);
      const s16x4 lo = *(const s16x4*)(Vt + (w * 32 + ln) * ATS + 16 * st + 4 * hh);
      const s16x4 hi = *(const s16x4*)(Vt + (w * 32 + ln) * ATS + 16 * st + 4 * hh + 8);
      o = MFMA(pa, __builtin_shufflevector(lo, hi, 0, 1, 2, 3, 4, 5, 6, 7), o);
    }
    {
      unsigned kkp[8];
#pragma unroll
      for (int i = 0; i < 8; ++i) kkp[i] = (unsigned)kt16[2 * i] | ((unsigned)kt16[2 * i + 1] << 16);
      *(uint4*)(KtT + kc * ATS + half * 16) = make_uint4(kkp[0], kkp[1], kkp[2], kkp[3]);
      *(uint4*)(KtT + kc * ATS + half * 16 + 8) = make_uint4(kkp[4], kkp[5], kkp[6], kkp[7]);
    }
    {
      bf16_t* oc = og + (size_t)ac_tb<DIR>(c) * 1024;
#pragma unroll
      for (int r = 0; r < 16; ++r) { const int t = (r >> 2) * 8 + hh * 4 + (r & 3); oc[t * 1024] = tobf(o[r]); }
    }
    __syncthreads();
#define A_STATE(SK, kb) { \
      _Pragma("unroll") for (int st = 0; st < 2; ++st) { \
        const bf16x8 a = *(const bf16x8*)(KtT + ((kb) * 32 + ln) * ATS + st * 16 + hh * 8); \
        const bf16x8 bv = *(const bf16x8*)(Vt + (w * 32 + ln) * ATS + st * 16 + hh * 8); \
        SK = MFMA(a, bv, SK); } \
      _Pragma("unroll") for (int rg = 0; rg < 4; ++rg) { \
        const float4 e = *(const float4*)(ebl + (kb) * 32 + rg * 8 + hh * 4); \
        SK[rg * 4 + 0] *= e.x; SK[rg * 4 + 1] *= e.y; SK[rg * 4 + 2] *= e.z; SK[rg * 4 + 3] *= e.w; } }
    A_STATE(S0, 0) A_STATE(S1, 1) A_STATE(S2, 2) A_STATE(S3, 3)
  }
  __syncthreads();
}
DI void a_chunk_item(unsigned char* ws, int it, unsigned char* smem) {
  const int dir = it & 1, hd = (it >> 1) & 3, b = it >> 3;
  __builtin_amdgcn_s_setprio(2);
  if (dir == 0) a_chunk_run<0>(ws, b, hd, smem); else a_chunk_run<1>(ws, b, hd, smem);
  __builtin_amdgcn_s_setprio(0);
}

struct AttnArgs {
  float m0;
  bf16_t* q;
  const bf16_t* k; int kstride;
  const bf16_t* vt;
  int kbase_row;
  int qrow;
  int ntiles, nwin, win_p0;
  int mode;
  int gr, r0w, cb, krow0;
  const float* bias;
};
DI void attn_run(const AttnArgs& a, unsigned char* smem) {
  const int tid = tid_(), lane = tid & 63, ln = lane & 31, h = lane >> 5;
  bf16_t* sk = (bf16_t*)smem;
  bf16_t* sv = sk + 2 * 64 * LSTR;
  bf16x8 qf[4];
  {
    const bf16_t* qp = a.q + (size_t)(a.qrow + ln) * 512 + h * 8;
#pragma unroll
    for (int ks = 0; ks < 4; ++ks) qf[ks] = *(const bf16x8*)(qp + ks * 16);
  }
  f32x16 o0, o1;
#pragma unroll
  for (int r = 0; r < 16; ++r) { o0[r] = 0.f; o1[r] = 0.f; }
  float lrun = 0.f;
  const int lrow = tid >> 3, lc = (tid & 7) * 8;
  uint4 rk0, rk1, rv0, rv1;
#define TILE_P0(i) ((i) < a.nwin ? a.win_p0 + (i) * 64 : ((i) - a.nwin) * 64)
#define GLOAD(i) { const int p0_ = TILE_P0(i); \
    rk0 = *(const uint4*)(a.k + (size_t)(a.kbase_row + p0_ + lrow) * a.kstride + lc); \
    rk1 = *(const uint4*)(a.k + (size_t)(a.kbase_row + p0_ + lrow + 32) * a.kstride + lc); \
    rv0 = *(const uint4*)(a.vt + (size_t)(lrow) * PT + p0_ + lc); \
    rv1 = *(const uint4*)(a.vt + (size_t)(lrow + 32) * PT + p0_ + lc); }
#define SSTORE(buf_) { \
    *(uint4*)(sk + (buf_) * 64 * LSTR + (lrow) * LSTR + lc) = rk0; \
    *(uint4*)(sk + (buf_) * 64 * LSTR + (lrow + 32) * LSTR + lc) = rk1; \
    *(uint4*)(sv + (buf_) * 64 * LSTR + (lrow) * LSTR + lc) = rv0; \
    *(uint4*)(sv + (buf_) * 64 * LSTR + (lrow + 32) * LSTR + lc) = rv1; }
  GLOAD(0);
  SSTORE(0);
  __syncthreads();
  for (int it = 0; it < a.ntiles; ++it) {
    const int buf = it & 1;
    GLOAD(min(it + 1, a.ntiles - 1));
    asm volatile("" ::: "memory");
    __builtin_amdgcn_sched_barrier(0);
    bool active = true;
    int krow = 0;
    const bool win = (a.mode == 1 && it < a.nwin);
    if (win) { krow = a.krow0 + it; active = (krow >= a.r0w && krow < a.r0w + 8); }
    if (active) {
      const bf16_t* ks_ = sk + buf * 64 * LSTR + ln * LSTR + h * 8;
      f32x16 s0, s1;
#pragma unroll
      for (int r = 0; r < 16; ++r) { s0[r] = -a.m0; s1[r] = -a.m0; }
#pragma unroll
      for (int ks = 0; ks < 4; ++ks) {
        bf16x8 a0 = *(const bf16x8*)(ks_ + ks * 16);
        bf16x8 a1 = *(const bf16x8*)(ks_ + 32 * LSTR + ks * 16);
        s0 = MFMA(a0, qf[ks], s0);
        s1 = MFMA(a1, qf[ks], s1);
      }
      if (win) {
        const int qc = a.cb + ln;
        const int c0 = min(max(qc - 8, 0), 48);
        const float* brow = a.bias + (krow - a.gr + 7) * 31 + 15 - qc;
#pragma unroll
        for (int r = 0; r < 16; ++r) {
          const int kc0 = (r >> 2) * 8 + h * 4 + (r & 3);
          const int kc1 = kc0 + 32;
          s0[r] = (kc0 >= c0 && kc0 < c0 + 16) ? s0[r] + brow[kc0] : -1e30f;
          s1[r] = (kc1 >= c0 && kc1 < c0 + 16) ? s1[r] + brow[kc1] : -1e30f;
        }
      }
#pragma unroll
      for (int r = 0; r < 16; ++r) { s0[r] = exp2f(s0[r]); lrun += s0[r]; }
#pragma unroll
      for (int r = 0; r < 16; ++r) { s1[r] = exp2f(s1[r]); lrun += s1[r]; }
      const bf16_t* vs_ = sv + buf * 64 * LSTR + ln * LSTR + h * 4;
#pragma unroll
      for (int j = 0; j < 4; ++j) {
        bf16x8 pb;
        {
          unsigned u0, u1, u2, u3;
          if (j < 2) {
            const int b8 = 8 * j;
            u0 = pack2(s0[b8 + 0], s0[b8 + 1]); u1 = pack2(s0[b8 + 2], s0[b8 + 3]);
            u2 = pack2(s0[b8 + 4], s0[b8 + 5]); u3 = pack2(s0[b8 + 6], s0[b8 + 7]);
          } else {
            const int b8 = 8 * (j - 2);
            u0 = pack2(s1[b8 + 0], s1[b8 + 1]); u1 = pack2(s1[b8 + 2], s1[b8 + 3]);
            u2 = pack2(s1[b8 + 4], s1[b8 + 5]); u3 = pack2(s1[b8 + 6], s1[b8 + 7]);
          }
          pb = __builtin_bit_cast(bf16x8, make_uint4(u0, u1, u2, u3));
        }
        const s16x4 lo0 = *(const s16x4*)(vs_ + j * 16);
        const s16x4 hi0 = *(const s16x4*)(vs_ + j * 16 + 8);
        const s16x4 lo1 = *(const s16x4*)(vs_ + 32 * LSTR + j * 16);
        const s16x4 hi1 = *(const s16x4*)(vs_ + 32 * LSTR + j * 16 + 8);
        const bf16x8 av0 = __builtin_shufflevector(lo0, hi0, 0, 1, 2, 3, 4, 5, 6, 7);
        const bf16x8 av1 = __builtin_shufflevector(lo1, hi1, 0, 1, 2, 3, 4, 5, 6, 7);
        o0 = MFMA(av0, pb, o0);
        o1 = MFMA(av1, pb, o1);
      }
    }
    SSTORE(buf ^ 1);
    __syncthreads();
  }
  lrun += shx(lrun, 32);
  const float inv = 1.f / lrun;
  bf16_t* op = a.q + (size_t)(a.qrow + ln) * 512;
#pragma unroll
  for (int rg = 0; rg < 4; ++rg) {
    const int d = rg * 8 + h * 4;
    *(uint2*)(op + d) = make_uint2(pack2(o0[rg * 4 + 0] * inv, o0[rg * 4 + 1] * inv), pack2(o0[rg * 4 + 2] * inv, o0[rg * 4 + 3] * inv));
    *(uint2*)(op + 32 + d) = make_uint2(pack2(o1[rg * 4 + 0] * inv, o1[rg * 4 + 1] * inv), pack2(o1[rg * 4 + 2] * inv, o1[rg * 4 + 3] * inv));
  }
}

DI float wave_max(float v) {
#pragma unroll
  for (int m = 32; m >= 1; m >>= 1) v = fmaxf(v, shx(v, m));
  return v;
}
DI float attn_m0(int qi, int ki, int l) {
  const int lane = tid_() & 63;
  const float* qn = ((const float*)(const __attribute__((address_space(1))) float*)karg(qi)) + l * 64;
  const float* kn = ((const float*)(const __attribute__((address_space(1))) float*)karg(ki)) + l * 64;
  return 8.f * 1.4426950408889634f * 1.02f * wave_max(fabsf(qn[lane])) * wave_max(fabsf(kn[lane]));
}
constexpr int N_A = 32, N_B = 1024, N_C = 1024, N_CTX = 128;
DI void mixer_item(const Params& p, int l, int it, unsigned char* smem) {
  const int w = tid_() >> 6;
  unsigned char* ws = ((unsigned char*)(__attribute__((address_space(1))) unsigned char*)karg(21));
  if (it < N_A) { a_chunk_item(ws, it, smem); return; }
  it -= N_A;
  AttnArgs a;
  a.bias = (const float*)(smem + 4 * 64 * LSTR * 2);
  a.mode = 0; a.gr = 0; a.r0w = 0; a.cb = 0; a.krow0 = 0;
  if (it < N_B) {
    const int hd = it & 7, qb = (it >> 3) & 31, b = it >> 8;
    a.q = (bf16_t*)(ws + O_BQ) + hd * 64;
    a.k = (const bf16_t*)(ws + O_BK) + (hd >> 2) * 64; a.kstride = 128;
    a.vt = (const bf16_t*)(ws + O_BVT) + ((size_t)b * 128 + (hd >> 2) * 64) * PT;
    a.kbase_row = b * PT; a.qrow = b * PT + CL + qb * 128 + w * 32;
    a.ntiles = 68; a.nwin = 68; a.win_p0 = 0;
    a.m0 = attn_m0(11, 12, l);
    attn_run(a, smem);
    return;
  }
  it -= N_B;
  if (it < N_C) {
    const int hd = it & 7, rp = (it >> 3) & 31, b = it >> 8;
    const int g0 = 2 * rp, g1 = 2 * rp + 1;
    const int r00 = min(max(g0 - 4, 0), 56), r01 = min(max(g1 - 4, 0), 56);
    float* bt = (float*)(smem + 4 * 64 * LSTR * 2);
    for (int i = tid_(); i < 465; i += 256) bt[i] = 1.4426950408889634f * ((const float*)(const __attribute__((address_space(1))) float*)karg(15))[((size_t)l * 8 + hd) * 465 + i];
    __syncthreads();
    a.q = (bf16_t*)(ws + O_CQ) + hd * 64;
    a.k = (const bf16_t*)(ws + O_CK) + hd * 64; a.kstride = 512;
    a.vt = (const bf16_t*)(ws + O_CVT) + ((size_t)b * 512 + hd * 64) * PT;
    a.kbase_row = b * PT;
    a.gr = g0 + (w >> 1); a.cb = (w & 1) * 32; a.r0w = (w >> 1) ? r01 : r00; a.krow0 = r00;
    a.qrow = b * PT + CL + a.gr * 64 + a.cb;
    a.nwin = r01 + 8 - r00; a.ntiles = a.nwin + 4; a.win_p0 = CL + r00 * 64;
    a.mode = 1;
    {
      const int lane = tid_() & 63;
      float bm = 0.f;
#pragma unroll
      for (int i = 0; i < 8; ++i) { const int ix = lane + 64 * i; if (ix < 465) bm = fmaxf(bm, fabsf(bt[ix])); }
      a.m0 = attn_m0(13, 14, l) + wave_max(bm);
    }
    attn_run(a, smem);
    return;
  }
  it -= N_C;
  {
    const int hd = it & 7, qb = (it >> 3) & 1, b = (it >> 4) & 3, kc = it >> 6;
    if (kc == 0) {
      a.q = (bf16_t*)(ws + O_BQ) + hd * 64;
      a.k = (const bf16_t*)(ws + O_BK) + (hd >> 2) * 64; a.kstride = 128;
      a.vt = (const bf16_t*)(ws + O_BVT) + ((size_t)b * 128 + (hd >> 2) * 64) * PT;
    } else {
      a.q = (bf16_t*)(ws + O_CQ) + hd * 64;
      a.k = (const bf16_t*)(ws + O_CK) + hd * 64; a.kstride = 512;
      a.vt = (const bf16_t*)(ws + O_CVT) + ((size_t)b * 512 + hd * 64) * PT;
    }
    a.kbase_row = b * PT; a.qrow = b * PT + qb * 128 + w * 32;
    a.ntiles = 4; a.nwin = 4; a.win_p0 = 0;
    a.m0 = (kc == 0) ? attn_m0(11, 12, l) : attn_m0(13, 14, l);
    attn_run(a, smem);
  }
}

DI void readout_row(const Params& p, int l, int row) {
  const int lane = tid_() & 63;
  unsigned char* ws = ((unsigned char*)(__attribute__((address_space(1))) unsigned char*)karg(21));
  const bf16_t* uo = (const bf16_t*)(ws + O_UO) + (size_t)row * 1024;
  bf16_t* og = (bf16_t*)(ws + O_OG) + (size_t)row * 512;
  const uint4 f4 = *(const uint4*)(uo + lane * 8);
  const uint4 b4 = *(const uint4*)(uo + 512 + lane * 8);
  const uint4 g4 = *(const uint4*)(og + lane * 8);
  asm volatile("s_waitcnt vmcnt(0)" ::: "memory");
  const unsigned ff[4] = {f4.x, f4.y, f4.z, f4.w}, bb[4] = {b4.x, b4.y, b4.z, b4.w}, gg[4] = {g4.x, g4.y, g4.z, g4.w};
  float o[8];
  float ss = 0.f;
#pragma unroll
  for (int i = 0; i < 4; ++i) {
    o[2 * i] = bflo(ff[i]) + bflo(bb[i]);
    o[2 * i + 1] = bfhi(ff[i]) + bfhi(bb[i]);
    ss += o[2 * i] * o[2 * i] + o[2 * i + 1] * o[2 * i + 1];
  }
  ss += shx(ss, 1); ss += shx(ss, 2); ss += shx(ss, 4); ss += shx(ss, 8);
  const float rs = rsqrtf(ss * (1.f / 128.f) + EPS);
  const float* gn = ((const float*)(const __attribute__((address_space(1))) float*)karg(10)) + l * 128 + (lane & 15) * 8;
  unsigned outp[4];
#pragma unroll
  for (int i = 0; i < 4; ++i) {
    const float g0 = bflo(gg[i]), g1 = bfhi(gg[i]);
    outp[i] = pack2(o[2 * i] * rs * gn[2 * i] * siluf_(g0), o[2 * i + 1] * rs * gn[2 * i + 1] * siluf_(g1));
  }
  *(uint4*)(og + lane * 8) = make_uint4(outp[0], outp[1], outp[2], outp[3]);
  norm_row(p, l, 0, row, ((const float*)(const __attribute__((address_space(1))) float*)karg(6)) + l * 1024, 0, 1024);
}

DI bool xcd_tile(int seq, int bid, int nblk, int MX, int NX, int& mt, int& nt) {
  const int per = nblk >> 3, li = bid >> 3, x = bid & 7;
  const int u = li + seq * per;
  if (u >= MX * NX) return false;
  const int FM = MX >> 3, fullsz = 8 * NX;
  int mgi, r, gm;
  if (u < FM * fullsz) { mgi = u / fullsz; r = u - mgi * fullsz; gm = 8; }
  else { mgi = FM; r = u - FM * fullsz; gm = MX & 7; }
  const int ngi = r / (gm * 8), r2 = r - ngi * gm * 8;
  const int nj = r2 / gm, mi = r2 - nj * gm;
  mt = x * MX + mgi * 8 + mi;
  nt = ngi * 8 + nj;
  return true;
}
DI int mtile_row0(int l, int mt) { return l == 0 ? mt * 128 : ((mt >> 5) * PT + CL + (mt & 31) * 128); }

#ifndef SKIPM
#define SKIPM 0
#endif
#ifdef PROBE_REP
__device__ const unsigned char PSEQ[] = {0, 1, 2, PROBE_R(2) 3, 4, 5, PROBE_R(5) 6, 7, 8, PROBE_R(8) 9, 10, 11, PROBE_R(11) 12, 13, 14, PROBE_R(14) 15, 16, 17, PROBE_R(17) 18};
#else
__device__ const unsigned char PSEQ[] = {0, 1, 2, 3, 4, 5, 6, 7, 8, 9, 10, 11, 12, 13, 14, 15, 16, 17, 18};
#endif
constexpr int NSEQ = sizeof(PSEQ);
#define OPAQUE_S(x) asm volatile("" : "+s"(x))
__global__ void __launch_bounds__(256, 2) fwd_megakernel(Params p) {
  extern __shared__ __attribute__((aligned(16))) unsigned char smem[];
  __shared__ int s_item, s_key;
  cg::grid_group grid = cg::this_grid();
  const int nblk = gridDim.x, bid = blockIdx.x;

  for (int pi = 0; pi < NSEQ; ++pi) {
    const int ph = PSEQ[pi];
    const int tid = tid_(), lane = tid & 63, w = tid >> 6, wm = w >> 1, wn = w & 1;
    unsigned char* ws = ((unsigned char*)(__attribute__((address_space(1))) unsigned char*)karg(21));
    const int l = (ph - 1) / 9, k = (ph == 0) ? -1 : (ph - 1) % 9;
    const int nmt = (l == 0) ? 136 : 128;
    if (k == -1 && !(SKIPM & 1)) {
      int* ctr = (int*)(ws + O_CTR);
      for (int i = bid * 256 + tid; i < 64 + 4 * 4096; i += nblk * 256) ctr[i] = 0;
      if (bid == 1 || nblk == 1) {
        float* ropet = (float*)(ws + O_ROPE);
        for (int i = tid; i < 1024; i += 256) {
          const int pos = i >> 4, j = i & 15;
          const float inv = exp2f(-(float)j * (13.287712379549449f / 16.f));
          const float ang = (float)pos * inv;
          ropet[i * 2] = __cosf(ang); ropet[i * 2 + 1] = __sinf(ang);
        }
      }
      for (int it = bid; it < 384 + CVT_ITEMS; it += nblk) {
        if (it < 384) mod_item(p, it, smem); else cvt_item(p, 0, it - 384, smem);
      }
    } else if (k == 0 && !(SKIPM & 2)) {
      if (l == 1) for (int it = bid; it < CVT_ITEMS; it += nblk) cvt_item(p, 1, it, smem);
      for (int row = bid * 4 + w; row < NT; row += nblk * 4) norm_row(p, l, 0, row, ((const float*)(const __attribute__((address_space(1))) float*)karg(6)) + l * 1024, 0, 1024);
    } else if (k == 1 && !(SKIPM & 4)) {
      for (int sq = 0;; ++sq) {
        int mt, nt;
        if (!xcd_tile(sq, bid, nblk, 17, 42, mt, nt)) break;
        f32x16 acc[2][2];
        zero_acc(acc);
        gemm_tile((const bf16_t*)(ws + O_UO) + (size_t)mt * 128 * 1024, 1024, (const bf16_t*)(ws + O_WIN) + (size_t)nt * 128 * 1024, 1024, 1024, acc, smem);
        inproj_epilogue(p, l, acc, mt * 128 + wm * 64, nt * 128 + wn * 64);
      }
    } else if (k == 2 && !(SKIPM & 8)) {
      int* ctr = (int*)(ws + O_CTR);
      const int nattn = N_B + N_C + (l == 0 ? N_CTX : 0);
      if (tid == 0) {
        const unsigned hw = __builtin_amdgcn_s_getreg(4 | (31 << 11));
        const unsigned xcc = __builtin_amdgcn_s_getreg(20 | (31 << 11));
        const int key = (int)(((xcc & 15u) << 8) | ((hw >> 8) & 255u));
        int* cuflag = ctr + 64 + 2 * 4096 + l * 4096 + key;
        const int r = atomicAdd(ctr + 64 + l * 4096 + key, 1);
        int item = -1;
        if (r == 0) {
          const int it = atomicAdd(ctr + l * 2 + 0, 1);
          if (it < N_A) { item = it; atomicExch(cuflag, 1); } else atomicExch(cuflag, 2);
        } else {
          for (int spin = 0; spin < (1 << 20); ++spin) {
            const int v = atomicAdd(cuflag, 0);
            if (v >= 2) break;
            __builtin_amdgcn_s_sleep(32);
          }
        }
        s_item = item; s_key = key;
      }
      __syncthreads();
      const int myitem = s_item, mykey = s_key;
      __syncthreads();
      if (myitem >= 0) {
        mixer_item(p, l, myitem, smem);
        __syncthreads();
        if (tid == 0) atomicExch(ctr + 64 + 2 * 4096 + l * 4096 + mykey, 3);
      }
      for (int pass = 0; pass < 2; ++pass) {
        const int q = 1 ^ pass;
        const int total = (q == 0) ? N_A : nattn;
        for (;;) {
          if (tid == 0) s_item = atomicAdd(ctr + l * 2 + q, 1);
          __syncthreads();
          const int it = s_item;
          __syncthreads();
          if (it >= total) break;
          mixer_item(p, l, q == 0 ? it : N_A + it, smem);
        }
      }
    } else if (k == 3 && !(SKIPM & 16)) {
      for (int i = bid * 4 + w; i < nmt * 128; i += nblk * 4) {
        const int row = (l == 0) ? i : ((i >> 12) * PT + CL + (i & 4095));
        readout_row(p, l, row);
      }
    } else if (k == 4 && !(SKIPM & 32)) {
      float4* msc = (float4*)(ws + O_CK) + (size_t)bid * 4096 + tid;
      for (int sq = 0;; ++sq) {
        int mt, nt;
        if (!xcd_tile(sq, bid, nblk, nmt >> 3, 8, mt, nt)) break;
        const int m0 = mtile_row0(l, mt), n0 = nt * 128;
#pragma unroll 1
        for (int kb = 0; kb < 3; ++kb) {
          f32x16 acc[2][2];
          zero_acc(acc);
          gemm_tile((const bf16_t*)(ws + O_UO) + (size_t)m0 * 1024, 1024, (const bf16_t*)(ws + O_WIN) + (size_t)(PW + kb * 1024 + n0) * 1024, 1024, 1024, acc, smem);
          uint4* gsc = (uint4*)(ws + O_QHF) + (size_t)bid * 2048 + tid;
#pragma unroll
          for (int i = 0; i < 2; ++i)
#pragma unroll
            for (int j = 0; j < 2; ++j) {
              unsigned g8[8];
#pragma unroll
              for (int r = 0; r < 8; ++r) g8[r] = pack2(sigmoidf_(acc[i][j][2 * r]), sigmoidf_(acc[i][j][2 * r + 1]));
              gsc[((i * 2 + j) * 2 + 0) * 256] = make_uint4(g8[0], g8[1], g8[2], g8[3]);
              gsc[((i * 2 + j) * 2 + 1) * 256] = make_uint4(g8[4], g8[5], g8[6], g8[7]);
            }
          zero_acc(acc);
          const size_t yo = (kb == 0) ? O_OG : (kb == 1 ? O_BQ : O_CQ);
          gemm_tile((const bf16_t*)(ws + yo) + (size_t)m0 * 512, 512, (const bf16_t*)(ws + O_WBR) + ((size_t)kb * 1024 + n0) * 512, 512, 512, acc, smem);
          const int h = lane >> 5, ln = lane & 31;
          int mso = 0, rowb = m0 + wm * 64 + h * 4, colb = n0 + wn * 64 + ln;
          asm volatile("" : "+v"(mso), "+v"(rowb), "+v"(colb));
#pragma unroll
          for (int i = 0; i < 2; ++i)
#pragma unroll
            for (int j = 0; j < 2; ++j) {
              const uint4 ga = gsc[mso + ((i * 2 + j) * 2 + 0) * 256], gb = gsc[mso + ((i * 2 + j) * 2 + 1) * 256];
              const unsigned g8[8] = {ga.x, ga.y, ga.z, ga.w, gb.x, gb.y, gb.z, gb.w};
#pragma unroll
              for (int rg = 0; rg < 4; ++rg) {
                float4 v;
                v.x = bflo(g8[rg * 2]) * acc[i][j][rg * 4 + 0];
                v.y = bfhi(g8[rg * 2]) * acc[i][j][rg * 4 + 1];
                v.z = bflo(g8[rg * 2 + 1]) * acc[i][j][rg * 4 + 2];
                v.w = bfhi(g8[rg * 2 + 1]) * acc[i][j][rg * 4 + 3];
                float4* sp = msc + mso + ((i * 2 + j) * 4 + rg) * 256;
                if (kb > 0) { const float4 o = *sp; v.x += o.x; v.y += o.y; v.z += o.z; v.w += o.w; }
                if (kb < 2) *sp = v;
                else {
                  bf16_t* mo = (bf16_t*)(ws + O_M);
                  const int row = rowb + i * 32 + rg * 8;
                  const int col = colb + j * 32;
                  mo[(size_t)row * 1024 + col] = tobf(v.x);
                  mo[(size_t)(row + 1) * 1024 + col] = tobf(v.y);
                  mo[(size_t)(row + 2) * 1024 + col] = tobf(v.z);
                  mo[(size_t)(row + 3) * 1024 + col] = tobf(v.w);
                }
                __builtin_amdgcn_sched_barrier(0);
              }
            }
        }
      }
    } else if (k == 5 && !(SKIPM & 64)) {
      for (int sq = 0;; ++sq) {
        int mt, nt;
        if (!xcd_tile(sq, bid, nblk, nmt >> 3, 8, mt, nt)) break;
        const int m0 = mtile_row0(l, mt), n0 = nt * 128;
        f32x16 acc[2][2];
        zero_acc(acc);
        gemm_tile((const bf16_t*)(ws + O_M) + (size_t)m0 * 1024, 1024, (const bf16_t*)(ws + O_WOUT) + (size_t)n0 * 1024, 1024, 1024, acc, smem);
        const int h = lane >> 5, ln = lane & 31;
#pragma unroll
        for (int i = 0; i < 2; ++i)
#pragma unroll
          for (int r = 0; r < 16; ++r) {
            const int row = m0 + wm * 64 + i * 32 + (r >> 2) * 8 + h * 4 + (r & 3);
            const int b = row / PT, q = row % PT;
            const float* xin = xrow_ptr(p, l, 0, row);
            float* xo = (q < CL) ? (float*)(ws + O_XC) + ((size_t)b * CL + q) * D : ((float*)(__attribute__((address_space(1))) float*)karg(20)) + ((size_t)b * SEQ + (q - CL)) * D;
            const float* modf = (const float*)(ws + O_MOD) + ((size_t)l * 5 + (q < CL ? 4 : b)) * 6144 + 2048;
#pragma unroll
            for (int j = 0; j < 2; ++j) {
              const int col = n0 + wn * 64 + j * 32 + ln;
              xo[col] = xin[col] + modf[col] * acc[i][j][r];
            }
          }
      }
    } else if (k == 6 && !(SKIPM & 128)) {
      for (int i = bid * 4 + w; i < nmt * 128; i += nblk * 4) {
        const int row = (l == 0) ? i : ((i >> 12) * PT + CL + (i & 4095));
        norm_row(p, l, 1, row, ((const float*)(const __attribute__((address_space(1))) float*)karg(7)) + l * 1024, 3072, 4096);
      }
    } else if (k == 7 && !(SKIPM & 256)) {
      for (int sq = 0;; ++sq) {
        int mt, nt;
        if (!xcd_tile(sq, bid, nblk, nmt >> 3, 44, mt, nt)) break;
        const int m0 = mtile_row0(l, mt);
        f32x16 acc[2][2];
        zero_acc(acc);
        gemm_tile((const bf16_t*)(ws + O_UO) + (size_t)m0 * 1024, 1024, (const bf16_t*)(ws + O_WGU) + (size_t)nt * 128 * 1024, 1024, 1024, acc, smem);
        bf16_t* ao = (bf16_t*)(ws + O_ACT);
        const int h = lane >> 5, ln = lane & 31;
#pragma unroll
        for (int i = 0; i < 2; ++i)
#pragma unroll
          for (int r = 0; r < 16; ++r) {
            const int row = m0 + wm * 64 + i * 32 + (r >> 2) * 8 + h * 4 + (r & 3);
            ao[(size_t)row * FH + nt * 64 + wn * 32 + ln] = tobf(siluf_(acc[i][0][r]) * acc[i][1][r]);
          }
      }
    } else if (!(SKIPM & 512)) {
      for (int sq = 0;; ++sq) {
        int mt, nt;
        if (!xcd_tile(sq, bid, nblk, nmt >> 3, 8, mt, nt)) break;
        const int m0 = mtile_row0(l, mt), n0 = nt * 128;
        f32x16 acc[2][2];
        zero_acc(acc);
        gemm_tile((const bf16_t*)(ws + O_ACT) + (size_t)m0 * FH, FH, (const bf16_t*)(ws + O_WD) + (size_t)n0 * FH, FH, FH, acc, smem);
        const int h = lane >> 5, ln = lane & 31;
#pragma unroll
        for (int i = 0; i < 2; ++i)
#pragma unroll
          for (int r = 0; r < 16; ++r) {
            const int row = m0 + wm * 64 + i * 32 + (r >> 2) * 8 + h * 4 + (r & 3);
            const int b = row / PT, q = row % PT;
            float* xo = (q < CL) ? (float*)(ws + O_XC) + ((size_t)b * CL + q) * D : ((float*)(__attribute__((address_space(1))) float*)karg(20)) + ((size_t)b * SEQ + (q - CL)) * D;
            const float* modf = (const float*)(ws + O_MOD) + ((size_t)l * 5 + (q < CL ? 4 : b)) * 6144 + 5120;
#pragma unroll
            for (int j = 0; j < 2; ++j) {
              const int col = n0 + wn * 64 + j * 32 + ln;
              xo[col] = xo[col] + modf[col] * acc[i][j][r];
            }
          }
      }
    }
    if (pi < NSEQ - 1) grid.sync();
  }
}

extern "C" void kernel_launch(void* const* d_in, const int* in_sizes, int n_in, void* d_out, int out_size, void* d_ws, size_t ws_size,
                              hipStream_t stream) {
  static int grid_blocks = 0;
  if (grid_blocks == 0) {
    if (ws_size < WS_END) { fprintf(stderr, "kernel_launch: workspace too small: %zu < %zu\n", ws_size, (size_t)WS_END); grid_blocks = -1; return; }
    int dev = 0, cus = 0, per_cu = 0;
    hipGetDevice(&dev);
    hipDeviceGetAttribute(&cus, hipDeviceAttributeMultiprocessorCount, dev);
    hipFuncSetAttribute((const void*)fwd_megakernel, hipFuncAttributeMaxDynamicSharedMemorySize, LDS_BYTES);
    hipOccupancyMaxActiveBlocksPerMultiprocessor(&per_cu, (const void*)fwd_megakernel, 256, LDS_BYTES);
    if (per_cu < 1) { fprintf(stderr, "kernel_launch: occupancy query returned %d\n", per_cu); grid_blocks = -1; return; }
    if (per_cu > 2) per_cu = 2;
    grid_blocks = cus * per_cu;
  }
  if (grid_blocks < 0) return;
  Params p{};
  p.x = (const float*)d_in[0]; p.c = (const float*)d_in[1]; p.ctx = (const float*)d_in[2]; p.c_ctx = (const float*)d_in[3];
  p.w_mod = (const float*)d_in[4]; p.b_mod = (const float*)d_in[5]; p.norm_mix = (const float*)d_in[6]; p.norm_ffn = (const float*)d_in[7];
  p.w_in = (const float*)d_in[8]; p.lb_raw = (const float*)d_in[9]; p.gn_a = (const float*)d_in[10]; p.qn_b = (const float*)d_in[11];
  p.kn_b = (const float*)d_in[12]; p.qn_c = (const float*)d_in[13]; p.kn_c = (const float*)d_in[14]; p.rel_bias = (const float*)d_in[15];
  p.w_branch = (const float*)d_in[16]; p.w_out = (const float*)d_in[17]; p.w_gate_up = (const float*)d_in[18]; p.w_down = (const float*)d_in[19];
  p.out = (float*)d_out; p.ws = (unsigned char*)d_ws;
  void* args[] = {&p};
  hipError_t e = hipLaunchCooperativeKernel((const void*)fwd_megakernel, dim3(grid_blocks), dim3(256), args, LDS_BYTES, stream);
  if (e != hipSuccess) fprintf(stderr, "cooperative launch failed: %s (grid %d)\n", hipGetErrorString(e), grid_blocks);
}
```

```cpp
#include <hip/hip_runtime.h>
#include <hip/hip_cooperative_groups.h>
#include <cstdio>
namespace cg = cooperative_groups;

typedef short bf16x8 __attribute__((ext_vector_type(8)));
typedef short s16x4 __attribute__((ext_vector_type(4)));
typedef float f32x16 __attribute__((ext_vector_type(16)));
typedef float f32x2 __attribute__((ext_vector_type(2)));
typedef __bf16 bf16x2_t __attribute__((ext_vector_type(2)));
typedef unsigned short bf16_t;
#define DI __device__ __forceinline__
#define MFMA(a, b, c) __builtin_amdgcn_mfma_f32_32x32x16_bf16((a), (b), (c), 0, 0, 0)

constexpr int D = 1024, NB = 4, SEQ = 4096, CL = 256, PT = 4352, NT = NB * PT;
constexpr int INW = 7936, INW2 = 8448, PW = 5376, FH = 2816, GU = 5632;
constexpr float EPS = 1e-6f;

constexpr size_t SZ512 = (size_t)NT * 512 * 2;
constexpr size_t SZ128 = (size_t)NT * 128 * 2;
constexpr size_t O_WIN = 0;
constexpr size_t O_WBR = O_WIN + (size_t)INW2 * D * 2;
constexpr size_t O_WOUT = O_WBR + (size_t)3 * D * 512 * 2;
constexpr size_t O_WGU = O_WOUT + (size_t)D * D * 2;
constexpr size_t O_WD = O_WGU + (size_t)GU * D * 2;
constexpr size_t O_UO = O_WD + (size_t)D * FH * 2;
constexpr size_t O_P = O_UO + (size_t)NT * 1024 * 2;
constexpr size_t O_QHF = O_P;
constexpr size_t O_KTF = O_QHF + SZ512;
constexpr size_t O_QHB = O_KTF + SZ512;
constexpr size_t O_KTB = O_QHB + SZ512;
constexpr size_t O_VA = O_KTB + SZ512;
constexpr size_t O_OG = O_VA + SZ512;
constexpr size_t O_BQ = O_OG + SZ512;
constexpr size_t O_CQ = O_BQ + SZ512;
constexpr size_t O_CK = O_CQ + SZ512;
constexpr size_t O_CVT = O_CK + SZ512;
constexpr size_t O_BK = O_CVT + SZ512;
constexpr size_t O_BVT = O_BK + SZ128;
constexpr size_t O_EBL = O_BVT + SZ128;
constexpr size_t O_XC = O_EBL + (size_t)2 * (NT / 32) * 512 * 4;
constexpr size_t O_MOD = O_XC + (size_t)NB * CL * D * 4;
constexpr size_t O_ROPE = O_MOD + (size_t)2 * 5 * 6144 * 4;
constexpr size_t O_CTR = O_ROPE + 64 * 16 * 2 * 4;
constexpr size_t WS_END = O_CTR + (64 + 4 * 4096) * 4;
constexpr size_t O_M = O_QHB;
constexpr size_t O_ACT = O_P;

constexpr int LDS_BYTES = 73728;
constexpr int LSTR = 72;

struct Params {
  const float* x; const float* c; const float* ctx; const float* c_ctx; const float* w_mod; const float* b_mod;
  const float* norm_mix; const float* norm_ffn; const float* w_in; const float* lb_raw; const float* gn_a;
  const float* qn_b; const float* kn_b; const float* qn_c; const float* kn_c; const float* rel_bias;
  const float* w_branch; const float* w_out; const float* w_gate_up; const float* w_down;
  float* out; unsigned char* ws;
};


typedef const unsigned long long __attribute__((address_space(4))) karg_t;
DI unsigned long long karg(int i) { return *(volatile karg_t*)((karg_t*)__builtin_amdgcn_kernarg_segment_ptr() + i); }
DI int tid_() { int t = threadIdx.x; asm volatile("" : "+v"(t)); return t; }
DI unsigned pack2(float a, float b) {
  f32x2 v = {a, b};
  bf16x2_t r = __builtin_convertvector(v, bf16x2_t);
  return __builtin_bit_cast(unsigned, r);
}
DI bf16_t tobf(float a) { return (bf16_t)(pack2(a, 0.f) & 0xffffu); }
DI float bflo(unsigned u) { return __uint_as_float(u << 16); }
DI float bfhi(unsigned u) { return __uint_as_float(u & 0xffff0000u); }
DI float sigmoidf_(float x) { return 1.f / (1.f + __expf(-x)); }
DI float siluf_(float x) { return x / (1.f + __expf(-x)); }
DI float shx(float v, int m) { return __shfl_xor(v, m); }

DI void gemm_tile(const bf16_t* A, int lda, const bf16_t* Bt, int ldb, int K,
                  f32x16 (&acc)[2][2], unsigned char* smem) {
  const int tid = tid_(), lane = tid & 63, w = tid >> 6, wm = w >> 1, wn = w & 1;
  bf16_t* sa = (bf16_t*)smem;
  bf16_t* sb = sa + 2 * 128 * LSTR;
  const int lrow = tid >> 3, lkc = (tid & 7) * 8;
  const bf16_t* ga = A + (size_t)lrow * lda + lkc;
  const bf16_t* gb = Bt + (size_t)lrow * ldb + lkc;
  uint4 pa0, pa1, pa2, pa3, pb0, pb1, pb2, pb3;
  uint4 qa0, qa1, qa2, qa3, qb0, qb1, qb2, qb3;
#define GT_LOAD(S, koff) { \
    S##a0 = *(const uint4*)(ga + (koff)); S##a1 = *(const uint4*)(ga + (size_t)32 * lda + (koff)); \
    S##a2 = *(const uint4*)(ga + (size_t)64 * lda + (koff)); S##a3 = *(const uint4*)(ga + (size_t)96 * lda + (koff)); \
    S##b0 = *(const uint4*)(gb + (koff)); S##b1 = *(const uint4*)(gb + (size_t)32 * ldb + (koff)); \
    S##b2 = *(const uint4*)(gb + (size_t)64 * ldb + (koff)); S##b3 = *(const uint4*)(gb + (size_t)96 * ldb + (koff)); \
    asm volatile("" ::: "memory"); __builtin_amdgcn_sched_barrier(0); }
#define GT_STORE(S, bufi) { \
    bf16_t* da_ = sa + (bufi) * 128 * LSTR + lrow * LSTR + lkc; bf16_t* db_ = sb + (bufi) * 128 * LSTR + lrow * LSTR + lkc; \
    *(uint4*)(da_) = S##a0; *(uint4*)(da_ + 32 * LSTR) = S##a1; *(uint4*)(da_ + 64 * LSTR) = S##a2; *(uint4*)(da_ + 96 * LSTR) = S##a3; \
    *(uint4*)(db_) = S##b0; *(uint4*)(db_ + 32 * LSTR) = S##b1; *(uint4*)(db_ + 64 * LSTR) = S##b2; *(uint4*)(db_ + 96 * LSTR) = S##b3; }
#define GT_FRAGS(F0, F1, G0, G1, KS) \
    F0 = *(const bf16x8*)(as + (KS) * 16); F1 = *(const bf16x8*)(as + 32 * LSTR + (KS) * 16); \
    G0 = *(const bf16x8*)(bs + (KS) * 16); G1 = *(const bf16x8*)(bs + 32 * LSTR + (KS) * 16);
#define GEMM_STEP(A0, A1, B0, B1, PRE, ST0, ST1) \
    PRE \
    acc[0][0] = MFMA(A0, B0, acc[0][0]); acc[0][1] = MFMA(A0, B1, acc[0][1]); \
    ST0; ST1; \
    acc[1][0] = MFMA(A1, B0, acc[1][0]); acc[1][1] = MFMA(A1, B1, acc[1][1]); \
    __builtin_amdgcn_sched_barrier(0);
#define GT_COMPUTE(bufi, S, sbuf) { \
    const bf16_t* as = sa + (bufi) * 128 * LSTR + wm * 64 * LSTR + fo; \
    const bf16_t* bs = sb + (bufi) * 128 * LSTR + wn * 64 * LSTR + fo; \
    bf16_t* da_ = sa + (sbuf) * 128 * LSTR + lrow * LSTR + lkc; bf16_t* db_ = sb + (sbuf) * 128 * LSTR + lrow * LSTR + lkc; \
    bf16x8 a0, a1, b0, b1, c0, c1, d0, d1, e0, e1, f0, f1; \
    GT_FRAGS(a0, a1, b0, b1, 0) GT_FRAGS(c0, c1, d0, d1, 1) \
    GEMM_STEP(a0, a1, b0, b1, GT_FRAGS(e0, e1, f0, f1, 2), *(uint4*)(da_) = S##a0, *(uint4*)(db_) = S##b0) \
    GEMM_STEP(c0, c1, d0, d1, GT_FRAGS(a0, a1, b0, b1, 3), *(uint4*)(da_ + 32 * LSTR) = S##a1, *(uint4*)(db_ + 32 * LSTR) = S##b1) \
    GEMM_STEP(e0, e1, f0, f1, , *(uint4*)(da_ + 64 * LSTR) = S##a2, *(uint4*)(db_ + 64 * LSTR) = S##b2) \
    GEMM_STEP(a0, a1, b0, b1, , *(uint4*)(da_ + 96 * LSTR) = S##a3, *(uint4*)(db_ + 96 * LSTR) = S##b3) }
  const int nk = K >> 6;
  const int fo = (lane & 31) * LSTR + (lane >> 5) * 8;
  GT_LOAD(p, 0)
  GT_LOAD(q, 64)
  GT_STORE(p, 0)
  __syncthreads();
  for (int kt = 0; kt < nk; kt += 2) {
    GT_LOAD(p, min(kt + 2, nk - 1) * 64)
    GT_COMPUTE(0, q, 1)
    __syncthreads();
    GT_LOAD(q, min(kt + 3, nk - 1) * 64)
    GT_COMPUTE(1, p, 0)
    __syncthreads();
  }
}
DI void zero_acc(f32x16 (&acc)[2][2]) {
#pragma unroll
  for (int i = 0; i < 2; ++i)
#pragma unroll
    for (int j = 0; j < 2; ++j)
#pragma unroll
      for (int r = 0; r < 16; ++r) acc[i][j][r] = 0.f;
}

DI void cvt_tile(const float* __restrict__ src, int ldsrc, int k0, int scol0a, int scol0b, bf16_t* __restrict__ dst, int K, int n0,
                 unsigned char* smem) {
  float* t = (float*)smem;
  const int tid = tid_();
  {
    const int kk = tid >> 4, c4 = (tid & 15) * 4;
    const int sc = (c4 < 32) ? (scol0a + c4) : (scol0b + c4 - 32);
#pragma unroll
    for (int i = 0; i < 4; ++i) {
      const int k = kk + i * 16;
      float4 v = *(const float4*)(src + (size_t)(k0 + k) * ldsrc + sc);
      t[k * 65 + c4 + 0] = v.x; t[k * 65 + c4 + 1] = v.y; t[k * 65 + c4 + 2] = v.z; t[k * 65 + c4 + 3] = v.w;
    }
  }
  __syncthreads();
  {
    const int n = tid >> 2, kq = (tid & 3) * 16;
    unsigned o[8];
#pragma unroll
    for (int j = 0; j < 8; ++j) o[j] = pack2(t[(kq + 2 * j) * 65 + n], t[(kq + 2 * j + 1) * 65 + n]);
    bf16_t* d = dst + (size_t)(n0 + n) * K + k0 + kq;
    *(uint4*)d = make_uint4(o[0], o[1], o[2], o[3]);
    *(uint4*)(d + 8) = make_uint4(o[4], o[5], o[6], o[7]);
  }
  __syncthreads();
}
constexpr int CVT_ITEMS = 2112 + 384 + 256 + 1408 + 704;
DI void cvt_item(const Params& p, int l, int it, unsigned char* smem) {
  unsigned char* ws = ((unsigned char*)(__attribute__((address_space(1))) unsigned char*)karg(21));
  if (it < 2112) {
    const int kt = it & 15, nt = it >> 4;
    int ca, cb;
    if (nt < 16) { ca = 32 * nt; cb = 512 + 32 * nt; }
    else if (nt < 32) { ca = 32 * (nt - 16); cb = 1024 + 32 * (nt - 16); }
    else { ca = 64 * (nt - 32) + 1536; cb = ca + 32; }
    cvt_tile(((const float*)(const __attribute__((address_space(1))) float*)karg(8)) + (size_t)l * D * INW, INW, kt * 64, ca, cb, (bf16_t*)(ws + O_WIN), D, nt * 64, smem);
    return;
  }
  it -= 2112;
  if (it < 384) {
    const int kb = it / 128, r = it % 128, kt = r & 7, nt = r >> 3;
    cvt_tile(((const float*)(const __attribute__((address_space(1))) float*)karg(16)) + ((size_t)l * 3 + kb) * 512 * D, D, kt * 64, nt * 64, nt * 64 + 32, (bf16_t*)(ws + O_WBR) + (size_t)kb * D * 512, 512, nt * 64, smem);
    return;
  }
  it -= 384;
  if (it < 256) {
    const int kt = it & 15, nt = it >> 4;
    cvt_tile(((const float*)(const __attribute__((address_space(1))) float*)karg(17)) + (size_t)l * D * D, D, kt * 64, nt * 64, nt * 64 + 32, (bf16_t*)(ws + O_WOUT), D, nt * 64, smem);
    return;
  }
  it -= 256;
  if (it < 1408) {
    const int kt = it & 15, nt = it >> 4;
    const int tile = nt >> 1, wn = nt & 1;
    const int hid = tile * 64 + wn * 32;
    cvt_tile(((const float*)(const __attribute__((address_space(1))) float*)karg(18)) + (size_t)l * D * GU, GU, kt * 64, hid, FH + hid, (bf16_t*)(ws + O_WGU), D, nt * 64, smem);
    return;
  }
  it -= 1408;
  {
    const int kt = it % 44, nt = it / 44;
    cvt_tile(((const float*)(const __attribute__((address_space(1))) float*)karg(19)) + (size_t)l * FH * D, D, kt * 64, nt * 64, nt * 64 + 32, (bf16_t*)(ws + O_WD), FH, nt * 64, smem);
  }
}
DI void mod_item(const Params& p, int it, unsigned char* smem) {
  float* sc = (float*)smem;
  float* red = sc + 5 * 1024;
  const int tid = tid_();
  const int l = it / 192, cb = it % 192;
  for (int i = tid; i < 5 * 1024; i += 256) {
    const int r = i >> 10, k = i & 1023;
    const float v = (r < 4) ? ((const float*)(const __attribute__((address_space(1))) float*)karg(1))[r * 1024 + k] : ((const float*)(const __attribute__((address_space(1))) float*)karg(3))[k];
    sc[i] = siluf_(v);
  }
  __syncthreads();
  const int c = tid & 31, kg = tid >> 5;
  const int col = cb * 32 + c;
  const float* w = ((const float*)(const __attribute__((address_space(1))) float*)karg(4)) + (size_t)l * D * 6144 + col;
  float a0 = 0, a1 = 0, a2 = 0, a3 = 0, a4 = 0;
#pragma unroll 8
  for (int k = kg * 128; k < kg * 128 + 128; ++k) {
    const float wv = w[(size_t)k * 6144];
    a0 += sc[k] * wv; a1 += sc[1024 + k] * wv; a2 += sc[2048 + k] * wv; a3 += sc[3072 + k] * wv; a4 += sc[4096 + k] * wv;
  }
  red[(kg * 5 + 0) * 32 + c] = a0; red[(kg * 5 + 1) * 32 + c] = a1; red[(kg * 5 + 2) * 32 + c] = a2;
  red[(kg * 5 + 3) * 32 + c] = a3; red[(kg * 5 + 4) * 32 + c] = a4;
  __syncthreads();
  if (tid < 160) {
    const int r = tid >> 5, cc = tid & 31;
    float s = 0;
#pragma unroll
    for (int g = 0; g < 8; ++g) s += red[(g * 5 + r) * 32 + cc];
    const int colo = cb * 32 + cc;
    float* modf = (float*)(((unsigned char*)(__attribute__((address_space(1))) unsigned char*)karg(21)) + O_MOD);
    modf[((size_t)l * 5 + r) * 6144 + colo] = s + ((const float*)(const __attribute__((address_space(1))) float*)karg(5))[l * 6144 + colo];
  }
  __syncthreads();
}

DI const float* xrow_ptr(const Params& p, int l, int stage, int row) {
  const int b = row / PT, q = row % PT;
  if (q < CL) {
    const size_t o = ((size_t)b * CL + q) * D;
    return (l == 0 && stage == 0) ? ((const float*)(const __attribute__((address_space(1))) float*)karg(2)) + o : (const float*)(((unsigned char*)(__attribute__((address_space(1))) unsigned char*)karg(21)) + O_XC) + o;
  }
  const size_t o = ((size_t)b * SEQ + (q - CL)) * D;
  return (l == 0 && stage == 0) ? ((const float*)(const __attribute__((address_space(1))) float*)karg(0)) + o : ((float*)(__attribute__((address_space(1))) float*)karg(20)) + o;
}
DI void norm_row(const Params& p, int l, int stage, int row, const float* __restrict__ nw, int shoff, int scoff) {
  const int lane = tid_() & 63;
  const float* xr = xrow_ptr(p, l, stage, row);
  const int b = row / PT, q = row % PT;
  const float* modf = (const float*)(((unsigned char*)(__attribute__((address_space(1))) unsigned char*)karg(21)) + O_MOD) + ((size_t)l * 5 + (q < CL ? 4 : b)) * 6144;
  float4 v[4];
  float ss = 0.f;
#pragma unroll
  for (int i = 0; i < 4; ++i) {
    v[i] = *(const float4*)(xr + i * 256 + lane * 4);
    ss += v[i].x * v[i].x + v[i].y * v[i].y + v[i].z * v[i].z + v[i].w * v[i].w;
  }
#pragma unroll
  for (int m = 1; m < 64; m <<= 1) ss += shx(ss, m);
  const float rs = rsqrtf(ss * (1.f / 1024.f) + EPS);
  bf16_t* dst = (bf16_t*)(((unsigned char*)(__attribute__((address_space(1))) unsigned char*)karg(21)) + O_UO) + (size_t)row * 1024;
#pragma unroll
  for (int i = 0; i < 4; ++i) {
    const int k = i * 256 + lane * 4;
    const float4 wv = *(const float4*)(nw + k);
    const float4 sc = *(const float4*)(modf + scoff + k);
    const float4 sh = *(const float4*)(modf + shoff + k);
    const float y0 = v[i].x * rs * wv.x * (1.f + sc.x) + sh.x;
    const float y1 = v[i].y * rs * wv.y * (1.f + sc.y) + sh.y;
    const float y2 = v[i].z * rs * wv.z * (1.f + sc.z) + sh.z;
    const float y3 = v[i].w * rs * wv.w * (1.f + sc.w) + sh.w;
    *(uint2*)(dst + k) = make_uint2(pack2(y0, y1), pack2(y2, y3));
  }
}

DI void store4T(bf16_t* base, float a, float b, float c, float d) { *(uint2*)base = make_uint2(pack2(a, b), pack2(c, d)); }

DI void inproj_epilogue(const Params& p, int l, f32x16 (&acc)[2][2], int m0w, int n0w) {
  unsigned char* ws = ((unsigned char*)(__attribute__((address_space(1))) unsigned char*)karg(21));
  const int lane = tid_() & 63, ln = lane & 31, h = lane >> 5;
  if (n0w < 2048) {
    const int dir = n0w >> 10, ch = ((n0w & 1023) >> 6) * 32 + ln;
    float lb = 0.f;
    if (l == 1) {
      const float* lbr = ((const float*)(const __attribute__((address_space(1))) float*)karg(9));
      lb = fminf(sigmoidf_(lbr[(2 + dir) * 512 + ch] - lbr[dir * 512 + ch]), 1.f - 1e-6f);
    }
    bf16_t* qd = (bf16_t*)(ws + (dir ? O_QHB : O_QHF));
    bf16_t* kd = (bf16_t*)(ws + (dir ? O_KTB : O_KTF));
    float* ebl = (float*)(ws + O_EBL) + (size_t)dir * (NT / 32) * 512;
#pragma unroll
    for (int i = 0; i < 2; ++i) {
      const int r0 = m0w + i * 32;
      float kk[16], g2[16], gs[4], gp[4];
#pragma unroll
      for (int r = 0; r < 16; ++r) {
        kk[r] = (1.f - lb) * sigmoidf_(-acc[i][1][r]);
        g2[r] = __log2f(fmaxf(1.f - kk[r], 1e-30f));
      }
#pragma unroll
      for (int rg = 0; rg < 4; ++rg) { gs[rg] = (g2[rg * 4] + g2[rg * 4 + 1]) + (g2[rg * 4 + 2] + g2[rg * 4 + 3]); gp[rg] = shx(gs[rg], 32); }
      const float total = ((gs[0] + gp[0]) + (gs[1] + gp[1])) + ((gs[2] + gp[2]) + (gs[3] + gp[3]));
      float pre = 0.f;
#pragma unroll
      for (int rg = 0; rg < 4; ++rg) {
        float run = pre + (h ? gp[rg] : 0.f);
#pragma unroll
        for (int i4 = 0; i4 < 4; ++i4) {
          const int r = rg * 4 + i4;
          run += g2[r];
          const float bj = dir ? (total - run + g2[r]) : run;
          const size_t o = (size_t)(r0 + rg * 8 + h * 4 + i4) * 512 + ch;
          qd[o] = tobf(acc[i][0][r] * 0.08838834764831845f * __builtin_amdgcn_exp2f(bj));
          kd[o] = tobf(kk[r] * __builtin_amdgcn_exp2f(fminf(-bj, 115.f)));
        }
        pre += gs[rg] + gp[rg];
      }
      if (h == 0) ebl[(size_t)(r0 >> 5) * 512 + ch] = __builtin_amdgcn_exp2f(total);
    }
    return;
  }
  if (n0w < 2560) {
    bf16_t* vt = (bf16_t*)(ws + O_VA);
#pragma unroll
    for (int i = 0; i < 2; ++i)
#pragma unroll
      for (int rg = 0; rg < 4; ++rg) {
        const int row = m0w + i * 32 + rg * 8 + h * 4;
        const int b = row / PT, q = row % PT;
#pragma unroll
        for (int j = 0; j < 2; ++j) {
          const int ch = (n0w & 511) + j * 32 + ln;
          store4T(vt + ((size_t)b * 512 + ch) * PT + q, acc[i][j][rg * 4 + 0], acc[i][j][rg * 4 + 1], acc[i][j][rg * 4 + 2], acc[i][j][rg * 4 + 3]);
        }
      }
    return;
  }
  if (n0w < 3072) {
    bf16_t* dst = (bf16_t*)(ws + O_OG);
    const int cg0 = n0w & 511;
#pragma unroll
    for (int j = 0; j < 2; ++j)
#pragma unroll
      for (int i = 0; i < 2; ++i)
#pragma unroll
        for (int r = 0; r < 16; ++r) {
          const int row = m0w + i * 32 + (r >> 2) * 8 + h * 4 + (r & 3);
          dst[(size_t)row * 512 + cg0 + j * 32 + ln] = tobf(acc[i][j][r]);
        }
    return;
  }
  n0w -= 512;
  int kind, head;
  if (n0w < 3072) { kind = 0; head = (n0w - 2560) >> 6; }
  else if (n0w < 3200) { kind = 1; head = (n0w - 3072) >> 6; }
  else if (n0w < 3328) { kind = 2; head = (n0w - 3200) >> 6; }
  else if (n0w < 3840) { kind = 3; head = (n0w - 3328) >> 6; }
  else if (n0w < 4352) { kind = 4; head = (n0w - 3840) >> 6; }
  else { kind = 5; head = (n0w - 4352) >> 6; }
  if (kind == 2 || kind == 5) {
    bf16_t* vt = (bf16_t*)(ws + (kind == 2 ? O_BVT : O_CVT));
    const int nch = (kind == 2) ? 128 : 512;
#pragma unroll
    for (int i = 0; i < 2; ++i)
#pragma unroll
      for (int rg = 0; rg < 4; ++rg) {
        const int row = m0w + i * 32 + rg * 8 + h * 4;
        const int b = row / PT, q = row % PT;
#pragma unroll
        for (int j = 0; j < 2; ++j) {
          const int ch = head * 64 + j * 32 + ln;
          store4T(vt + ((size_t)b * nch + ch) * PT + q, acc[i][j][rg * 4 + 0], acc[i][j][rg * 4 + 1], acc[i][j][rg * 4 + 2], acc[i][j][rg * 4 + 3]);
        }
      }
    return;
  }
  const float* nwp = (kind == 0 ? ((const float*)(const __attribute__((address_space(1))) float*)karg(11)) : kind == 1 ? ((const float*)(const __attribute__((address_space(1))) float*)karg(12)) : kind == 3 ? ((const float*)(const __attribute__((address_space(1))) float*)karg(13)) : ((const float*)(const __attribute__((address_space(1))) float*)karg(14))) + l * 64;
  const float nw0 = nwp[ln], nw1 = nwp[32 + ln];
  const float qscale = (kind == 0 || kind == 3) ? 0.125f * 1.4426950408889634f : 1.f;
  const bool rope = (kind <= 1);
  const float* ropet = (const float*)(ws + O_ROPE);
  bf16_t* dst; int dstride;
  if (kind == 0) { dst = (bf16_t*)(ws + O_BQ); dstride = 512; }
  else if (kind == 1) { dst = (bf16_t*)(ws + O_BK); dstride = 128; }
  else if (kind == 3) { dst = (bf16_t*)(ws + O_CQ); dstride = 512; }
  else { dst = (bf16_t*)(ws + O_CK); dstride = 512; }
#pragma unroll
  for (int i = 0; i < 2; ++i)
#pragma unroll
    for (int r = 0; r < 16; ++r) {
      const int row = m0w + i * 32 + (r >> 2) * 8 + h * 4 + (r & 3);
      float v0 = acc[i][0][r], v1 = acc[i][1][r];
      float ss = v0 * v0 + v1 * v1;
      ss += shx(ss, 1); ss += shx(ss, 2); ss += shx(ss, 4); ss += shx(ss, 8); ss += shx(ss, 16);
      const float rs = rsqrtf(ss * (1.f / 64.f) + EPS);
      v0 = v0 * rs * nw0; v1 = v1 * rs * nw1;
      if (rope) {
        const int q = row % PT;
        const float p0 = shx(v0, 1), p1 = shx(v1, 1);
        if (q >= CL) {
          const int t = q - CL, gr = t >> 6, gc = t & 63;
          const int fj = ln >> 1;
          const float2 cs0 = *(const float2*)(ropet + (gr * 16 + fj) * 2);
          const float2 cs1 = *(const float2*)(ropet + (gc * 16 + fj) * 2);
          if (ln & 1) { v0 = p0 * cs0.y + v0 * cs0.x; v1 = p1 * cs1.y + v1 * cs1.x; }
          else { v0 = v0 * cs0.x - p0 * cs0.y; v1 = v1 * cs1.x - p1 * cs1.y; }
        }
      }
      dst[(size_t)row * dstride + head * 64 + ln] = tobf(v0 * qscale);
      dst[(size_t)row * dstride + head * 64 + 32 + ln] = tobf(v1 * qscale);
    }
}

constexpr int AQS = 136, ATS = 40;
constexpr int A_QH = 0, A_KT = A_QH + 32 * AQS * 2, A_KBT = A_KT + 32 * AQS * 2, A_VT = A_KBT + 128 * ATS * 2, A_EBL = A_VT + 128 * ATS * 2;
DI bf16x8 pack8(const f32x16& x, int o) {
  return __builtin_bit_cast(bf16x8, make_uint4(pack2(x[o + 0], x[o + 1]), pack2(x[o + 2], x[o + 3]), pack2(x[o + 4], x[o + 5]), pack2(x[o + 6], x[o + 7])));
}
template <int DIR> DI int ac_tb(int c) {
  const int s = c * 32;
  return DIR == 0 ? s : (s < CL ? (CL - 32 - s) : (PT + CL - 32 - s));
}
constexpr int A_VT2 = A_EBL + 512, A_EBL2 = A_VT2 + 128 * ATS * 2;
template <int DIR> DI void a_chunk_run(unsigned char* ws, int b, int hd, unsigned char* smem) {
  const int tid = tid_(), lane = tid & 63, w = tid >> 6, ln = lane & 31, hh = lane >> 5;
  const int kc = tid >> 1, half = tid & 1;
  const int sj = tid >> 3, cg = tid & 7;
  const size_t rb = (size_t)b * PT;
  const bf16_t* qg = (const bf16_t*)(ws + (DIR ? O_QHB : O_QHF)) + (rb + sj) * 512 + hd * 128 + cg * 16;
  const bf16_t* kg = (const bf16_t*)(ws + (DIR ? O_KTB : O_KTF)) + (rb + sj) * 512 + hd * 128 + cg * 16;
  const bf16_t* vg = (const bf16_t*)(ws + O_VA) + ((size_t)b * 512 + hd * 128 + kc) * PT + half * 16;
  const float* eg = (const float*)(ws + O_EBL) + (size_t)DIR * (NT / 32) * 512 + hd * 128 + kc;
  bf16_t* og = (bf16_t*)(ws + O_UO) + rb * 1024 + DIR * 512 + hd * 128 + w * 32 + ln;
  bf16_t* Qh = (bf16_t*)(smem + A_QH); bf16_t* Kt = (bf16_t*)(smem + A_KT);
  bf16_t* KtT = (bf16_t*)(smem + A_KBT);
  f32x16 S0, S1, S2, S3;
#pragma unroll
  for (int r = 0; r < 16; ++r) { S0[r] = 0.f; S1[r] = 0.f; S2[r] = 0.f; S3[r] = 0.f; }
  uint4 q0, q1, k0, k1, v0, v1;
  float pe;
#define A_PREFETCH(cc) { const int tb_ = ac_tb<DIR>(cc); \
    q0 = *(const uint4*)(qg + (size_t)tb_ * 512); q1 = *(const uint4*)(qg + (size_t)tb_ * 512 + 8); \
    k0 = *(const uint4*)(kg + (size_t)tb_ * 512); k1 = *(const uint4*)(kg + (size_t)tb_ * 512 + 8); \
    v0 = *(const uint4*)(vg + tb_); v1 = *(const uint4*)(vg + tb_ + 8); \
    pe = eg[(size_t)((rb + tb_) >> 5) * 512]; }
  A_PREFETCH(0)
#pragma unroll 1
  for (int c = 0; c < PT / 32; ++c) {
    bf16_t* Vt = (bf16_t*)(smem + ((c & 1) ? A_VT2 : A_VT));
    float* ebl = (float*)(smem + ((c & 1) ? A_EBL2 : A_EBL));
    *(uint4*)(Qh + sj * AQS + cg * 16) = q0; *(uint4*)(Qh + sj * AQS + cg * 16 + 8) = q1;
    *(uint4*)(Kt + sj * AQS + cg * 16) = k0; *(uint4*)(Kt + sj * AQS + cg * 16 + 8) = k1;
    *(uint4*)(Vt + kc * ATS + half * 16) = v0; *(uint4*)(Vt + kc * ATS + half * 16 + 8) = v1;
    if (half == 0) ebl[kc] = pe;
    __syncthreads();
    A_PREFETCH(min(c + 1, PT / 32 - 1))
    unsigned short kt16[16];
#pragma unroll
    for (int jj = 0; jj < 16; ++jj) kt16[jj] = Kt[(half * 16 + jj) * AQS + kc];
    f32x16 at, o;
#pragma unroll
    for (int r = 0; r < 16; ++r) { at[r] = 0.f; o[r] = 0.f; }
#pragma unroll
    for (int ks = 0; ks < 8; ++ks) {
      const bf16x8 a = *(const bf16x8*)(Kt + ln * AQS + ks * 16 + hh * 8);
      const bf16x8 bq = *(const bf16x8*)(Qh + ln * AQS + ks * 16 + hh * 8);
      at = MFMA(a, bq, at);
    }
#pragma unroll
    for (int r = 0; r < 16; ++r) {
      const int s_ = (r >> 2) * 8 + hh * 4 + (r & 3);
      at[r] = (DIR == 0 ? (s_ <= ln) : (s_ >= ln)) ? at[r] : 0.f;
    }
#define A_INTER(SK, kb) { \
      _Pragma("unroll") for (int st = 0; st < 2; ++st) { \
        const bf16x8 pb = pack8(SK, 8 * st); \
        const s16x4 lo = *(const s16x4*)(Qh + ln * AQS + (kb) * 32 + 16 * st + 4 * hh); \
        const s16x4 hi = *(const s16x4*)(Qh + ln * AQS + (kb) * 32 + 16 * st + 4 * hh + 8); \
        o = MFMA(__builtin_shufflevector(lo, hi, 0, 1, 2, 3, 4, 5, 6, 7), pb, o); } }
    A_INTER(S0, 0) A_INTER(S1, 1) A_INTER(S2, 2) A_INTER(S3, 3)
#pragma unroll
    for (int st = 0; st < 2; ++st) {
      const bf16x8 pa = pack8(at, 8 * st);
      const s16x4 lo = *(const s16x4*)(Vt + (w * 32 + ln) * ATS + 16 * st + 4 * hh);
      const s16x4 hi = *(const s16x4*)(Vt + (w * 32 + ln) * ATS + 16 * st + 4 * hh + 8);
      o = MFMA(pa, __builtin_shufflevector(lo, hi, 0, 1, 2, 3, 4, 5, 6, 7), o);
    }
    {
      unsigned kkp[8];
#pragma unroll
      for (int i = 0; i < 8; ++i) kkp[i] = (unsigned)kt16[2 * i] | ((unsigned)kt16[2 * i + 1] << 16);
      *(uint4*)(KtT + kc * ATS + half * 16) = make_uint4(kkp[0], kkp[1], kkp[2], kkp[3]);
      *(uint4*)(KtT + kc * ATS + half * 16 + 8) = make_uint4(kkp[4], kkp[5], kkp[6], kkp[7]);
    }
    {
      bf16_t* oc = og + (size_t)ac_tb<DIR>(c) * 1024;
#pragma unroll
      for (int r = 0; r < 16; ++r) { const int t = (r >> 2) * 8 + hh * 4 + (r & 3); oc[t * 1024] = tobf(o[r]); }
    }
    __syncthreads();
#define A_STATE(SK, kb) { \
      _Pragma("unroll") for (int st = 0; st < 2; ++st) { \
        const bf16x8 a = *(const bf16x8*)(KtT + ((kb) * 32 + ln) * ATS + st * 16 + hh * 8); \
        const bf16x8 bv = *(const bf16x8*)(Vt + (w * 32 + ln) * ATS + st * 16 + hh * 8); \
        SK = MFMA(a, bv, SK); } \
      _Pragma("unroll") for (int rg = 0; rg < 4; ++rg) { \
        const float4 e = *(const float4*)(ebl + (kb) * 32 + rg * 8 + hh * 4); \
        SK[rg * 4 + 0] *= e.x; SK[rg * 4 + 1] *= e.y; SK[rg * 4 + 2] *= e.z; SK[rg * 4 + 3] *= e.w; } }
    A_STATE(S0, 0) A_STATE(S1, 1) A_STATE(S2, 2) A_STATE(S3, 3)
  }
  __syncthreads();
}
DI void a_chunk_item(unsigned char* ws, int it, unsigned char* smem) {
  const int dir = it & 1, hd = (it >> 1) & 3, b = it >> 3;
  __builtin_amdgcn_s_setprio(2);
  if (dir == 0) a_chunk_run<0>(ws, b, hd, smem); else a_chunk_run<1>(ws, b, hd, smem);
  __builtin_amdgcn_s_setprio(0);
}

struct AttnArgs {
  float m0;
  bf16_t* q;
  const bf16_t* k; int kstride;
  const bf16_t* vt;
  int kbase_row;
  int qrow;
  int ntiles, nwin, win_p0;
  int mode;
  int gr, r0w, cb, krow0;
  const float* bias;
};
DI void attn_run(const AttnArgs& a, unsigned char* smem) {
  const int tid = tid_(), lane = tid & 63, ln = lane & 31, h = lane >> 5;
  bf16_t* sk = (bf16_t*)smem;
  bf16_t* sv = sk + 2 * 64 * LSTR;
  bf16x8 qf[4];
  {
    const bf16_t* qp = a.q + (size_t)(a.qrow + ln) * 512 + h * 8;
#pragma unroll
    for (int ks = 0; ks < 4; ++ks) qf[ks] = *(const bf16x8*)(qp + ks * 16);
  }
  f32x16 o0, o1;
#pragma unroll
  for (int r = 0; r < 16; ++r) { o0[r] = 0.f; o1[r] = 0.f; }
  float lrun = 0.f;
  const int lrow = tid >> 3, lc = (tid & 7) * 8;
  uint4 rk0, rk1, rv0, rv1;
#define TILE_P0(i) ((i) < a.nwin ? a.win_p0 + (i) * 64 : ((i) - a.nwin) * 64)
#define GLOAD(i) { const int p0_ = TILE_P0(i); \
    rk0 = *(const uint4*)(a.k + (size_t)(a.kbase_row + p0_ + lrow) * a.kstride + lc); \
    rk1 = *(const uint4*)(a.k + (size_t)(a.kbase_row + p0_ + lrow + 32) * a.kstride + lc); \
    rv0 = *(const uint4*)(a.vt + (size_t)(lrow) * PT + p0_ + lc); \
    rv1 = *(const uint4*)(a.vt + (size_t)(lrow + 32) * PT + p0_ + lc); }
#define SSTORE(buf_) { \
    *(uint4*)(sk + (buf_) * 64 * LSTR + (lrow) * LSTR + lc) = rk0; \
    *(uint4*)(sk + (buf_) * 64 * LSTR + (lrow + 32) * LSTR + lc) = rk1; \
    *(uint4*)(sv + (buf_) * 64 * LSTR + (lrow) * LSTR + lc) = rv0; \
    *(uint4*)(sv + (buf_) * 64 * LSTR + (lrow + 32) * LSTR + lc) = rv1; }
  GLOAD(0);
  SSTORE(0);
  __syncthreads();
  for (int it = 0; it < a.ntiles; ++it) {
    const int buf = it & 1;
    GLOAD(min(it + 1, a.ntiles - 1));
    asm volatile("" ::: "memory");
    __builtin_amdgcn_sched_barrier(0);
    bool active = true;
    int krow = 0;
    const bool win = (a.mode == 1 && it < a.nwin);
    if (win) { krow = a.krow0 + it; active = (krow >= a.r0w && krow < a.r0w + 8); }
    if (active) {
      const bf16_t* ks_ = sk + buf * 64 * LSTR + ln * LSTR + h * 8;
      f32x16 s0, s1;
#pragma unroll
      for (int r = 0; r < 16; ++r) { s0[r] = -a.m0; s1[r] = -a.m0; }
#pragma unroll
      for (int ks = 0; ks < 4; ++ks) {
        bf16x8 a0 = *(const bf16x8*)(ks_ + ks * 16);
        bf16x8 a1 = *(const bf16x8*)(ks_ + 32 * LSTR + ks * 16);
        s0 = MFMA(a0, qf[ks], s0);
        s1 = MFMA(a1, qf[ks], s1);
      }
      if (win) {
        const int qc = a.cb + ln;
        const int c0 = min(max(qc - 8, 0), 48);
        const float* brow = a.bias + (krow - a.gr + 7) * 31 + 15 - qc;
#pragma unroll
        for (int r = 0; r < 16; ++r) {
          const int kc0 = (r >> 2) * 8 + h * 4 + (r & 3);
          const int kc1 = kc0 + 32;
          s0[r] = (kc0 >= c0 && kc0 < c0 + 16) ? s0[r] + brow[kc0] : -1e30f;
          s1[r] = (kc1 >= c0 && kc1 < c0 + 16) ? s1[r] + brow[kc1] : -1e30f;
        }
      }
#pragma unroll
      for (int r = 0; r < 16; ++r) { s0[r] = __builtin_amdgcn_exp2f(s0[r]); lrun += s0[r]; }
#pragma unroll
      for (int r = 0; r < 16; ++r) { s1[r] = __builtin_amdgcn_exp2f(s1[r]); lrun += s1[r]; }
      const bf16_t* vs_ = sv + buf * 64 * LSTR + ln * LSTR + h * 4;
#pragma unroll
      for (int j = 0; j < 4; ++j) {
        bf16x8 pb;
        {
          unsigned u0, u1, u2, u3;
          if (j < 2) {
            const int b8 = 8 * j;
            u0 = pack2(s0[b8 + 0], s0[b8 + 1]); u1 = pack2(s0[b8 + 2], s0[b8 + 3]);
            u2 = pack2(s0[b8 + 4], s0[b8 + 5]); u3 = pack2(s0[b8 + 6], s0[b8 + 7]);
          } else {
            const int b8 = 8 * (j - 2);
            u0 = pack2(s1[b8 + 0], s1[b8 + 1]); u1 = pack2(s1[b8 + 2], s1[b8 + 3]);
            u2 = pack2(s1[b8 + 4], s1[b8 + 5]); u3 = pack2(s1[b8 + 6], s1[b8 + 7]);
          }
          pb = __builtin_bit_cast(bf16x8, make_uint4(u0, u1, u2, u3));
        }
        const s16x4 lo0 = *(const s16x4*)(vs_ + j * 16);
        const s16x4 hi0 = *(const s16x4*)(vs_ + j * 16 + 8);
        const s16x4 lo1 = *(const s16x4*)(vs_ + 32 * LSTR + j * 16);
        const s16x4 hi1 = *(const s16x4*)(vs_ + 32 * LSTR + j * 16 + 8);
        const bf16x8 av0 = __builtin_shufflevector(lo0, hi0, 0, 1, 2, 3, 4, 5, 6, 7);
        const bf16x8 av1 = __builtin_shufflevector(lo1, hi1, 0, 1, 2, 3, 4, 5, 6, 7);
        o0 = MFMA(av0, pb, o0);
        o1 = MFMA(av1, pb, o1);
      }
    }
    SSTORE(buf ^ 1);
    __syncthreads();
  }
  lrun += shx(lrun, 32);
  const float inv = 1.f / lrun;
  bf16_t* op = a.q + (size_t)(a.qrow + ln) * 512;
#pragma unroll
  for (int rg = 0; rg < 4; ++rg) {
    const int d = rg * 8 + h * 4;
    *(uint2*)(op + d) = make_uint2(pack2(o0[rg * 4 + 0] * inv, o0[rg * 4 + 1] * inv), pack2(o0[rg * 4 + 2] * inv, o0[rg * 4 + 3] * inv));
    *(uint2*)(op + 32 + d) = make_uint2(pack2(o1[rg * 4 + 0] * inv, o1[rg * 4 + 1] * inv), pack2(o1[rg * 4 + 2] * inv, o1[rg * 4 + 3] * inv));
  }
}

DI float wave_max(float v) {
#pragma unroll
  for (int m = 32; m >= 1; m >>= 1) v = fmaxf(v, shx(v, m));
  return v;
}
DI float attn_m0(int qi, int ki, int l) {
  const int lane = tid_() & 63;
  const float* qn = ((const float*)(const __attribute__((address_space(1))) float*)karg(qi)) + l * 64;
  const float* kn = ((const float*)(const __attribute__((address_space(1))) float*)karg(ki)) + l * 64;
  return 8.f * 1.4426950408889634f * 1.02f * wave_max(fabsf(qn[lane])) * wave_max(fabsf(kn[lane]));
}
constexpr int N_A = 32, N_B = 1024, N_C = 1024, N_CTX = 128;
DI void mixer_item(const Params& p, int l, int it, unsigned char* smem) {
  const int w = tid_() >> 6;
  unsigned char* ws = ((unsigned char*)(__attribute__((address_space(1))) unsigned char*)karg(21));
  if (it < N_A) { a_chunk_item(ws, it, smem); return; }
  it -= N_A;
  AttnArgs a;
  a.bias = (const float*)(smem + 4 * 64 * LSTR * 2);
  a.mode = 0; a.gr = 0; a.r0w = 0; a.cb = 0; a.krow0 = 0;
  if (it < N_B) {
    const int hd = it & 7, qb = (it >> 3) & 31, b = it >> 8;
    a.q = (bf16_t*)(ws + O_BQ) + hd * 64;
    a.k = (const bf16_t*)(ws + O_BK) + (hd >> 2) * 64; a.kstride = 128;
    a.vt = (const bf16_t*)(ws + O_BVT) + ((size_t)b * 128 + (hd >> 2) * 64) * PT;
    a.kbase_row = b * PT; a.qrow = b * PT + CL + qb * 128 + w * 32;
    a.ntiles = 68; a.nwin = 68; a.win_p0 = 0;
    a.m0 = attn_m0(11, 12, l);
    attn_run(a, smem);
    return;
  }
  it -= N_B;
  if (it < N_C) {
    const int hd = it & 7, rp = (it >> 3) & 31, b = it >> 8;
    const int g0 = 2 * rp, g1 = 2 * rp + 1;
    const int r00 = min(max(g0 - 4, 0), 56), r01 = min(max(g1 - 4, 0), 56);
    float* bt = (float*)(smem + 4 * 64 * LSTR * 2);
    for (int i = tid_(); i < 465; i += 256) bt[i] = 1.4426950408889634f * ((const float*)(const __attribute__((address_space(1))) float*)karg(15))[((size_t)l * 8 + hd) * 465 + i];
    __syncthreads();
    a.q = (bf16_t*)(ws + O_CQ) + hd * 64;
    a.k = (const bf16_t*)(ws + O_CK) + hd * 64; a.kstride = 512;
    a.vt = (const bf16_t*)(ws + O_CVT) + ((size_t)b * 512 + hd * 64) * PT;
    a.kbase_row = b * PT;
    a.gr = g0 + (w >> 1); a.cb = (w & 1) * 32; a.r0w = (w >> 1) ? r01 : r00; a.krow0 = r00;
    a.qrow = b * PT + CL + a.gr * 64 + a.cb;
    a.nwin = r01 + 8 - r00; a.ntiles = a.nwin + 4; a.win_p0 = CL + r00 * 64;
    a.mode = 1;
    {
      const int lane = tid_() & 63;
      float bm = 0.f;
#pragma unroll
      for (int i = 0; i < 8; ++i) { const int ix = lane + 64 * i; if (ix < 465) bm = fmaxf(bm, fabsf(bt[ix])); }
      a.m0 = attn_m0(13, 14, l) + wave_max(bm);
    }
    attn_run(a, smem);
    return;
  }
  it -= N_C;
  {
    const int hd = it & 7, qb = (it >> 3) & 1, b = (it >> 4) & 3, kc = it >> 6;
    if (kc == 0) {
      a.q = (bf16_t*)(ws + O_BQ) + hd * 64;
      a.k = (const bf16_t*)(ws + O_BK) + (hd >> 2) * 64; a.kstride = 128;
      a.vt = (const bf16_t*)(ws + O_BVT) + ((size_t)b * 128 + (hd >> 2) * 64) * PT;
    } else {
      a.q = (bf16_t*)(ws + O_CQ) + hd * 64;
      a.k = (const bf16_t*)(ws + O_CK) + hd * 64; a.kstride = 512;
      a.vt = (const bf16_t*)(ws + O_CVT) + ((size_t)b * 512 + hd * 64) * PT;
    }
    a.kbase_row = b * PT; a.qrow = b * PT + qb * 128 + w * 32;
    a.ntiles = 4; a.nwin = 4; a.win_p0 = 0;
    a.m0 = (kc == 0) ? attn_m0(11, 12, l) : attn_m0(13, 14, l);
    attn_run(a, smem);
  }
}

DI void readout_row(const Params& p, int l, int row) {
  const int lane = tid_() & 63;
  unsigned char* ws = ((unsigned char*)(__attribute__((address_space(1))) unsigned char*)karg(21));
  const bf16_t* uo = (const bf16_t*)(ws + O_UO) + (size_t)row * 1024;
  bf16_t* og = (bf16_t*)(ws + O_OG) + (size_t)row * 512;
  const uint4 f4 = *(const uint4*)(uo + lane * 8);
  const uint4 b4 = *(const uint4*)(uo + 512 + lane * 8);
  const uint4 g4 = *(const uint4*)(og + lane * 8);
  asm volatile("s_waitcnt vmcnt(0)" ::: "memory");
  const unsigned ff[4] = {f4.x, f4.y, f4.z, f4.w}, bb[4] = {b4.x, b4.y, b4.z, b4.w}, gg[4] = {g4.x, g4.y, g4.z, g4.w};
  float o[8];
  float ss = 0.f;
#pragma unroll
  for (int i = 0; i < 4; ++i) {
    o[2 * i] = bflo(ff[i]) + bflo(bb[i]);
    o[2 * i + 1] = bfhi(ff[i]) + bfhi(bb[i]);
    ss += o[2 * i] * o[2 * i] + o[2 * i + 1] * o[2 * i + 1];
  }
  ss += shx(ss, 1); ss += shx(ss, 2); ss += shx(ss, 4); ss += shx(ss, 8);
  const float rs = rsqrtf(ss * (1.f / 128.f) + EPS);
  const float* gn = ((const float*)(const __attribute__((address_space(1))) float*)karg(10)) + l * 128 + (lane & 15) * 8;
  unsigned outp[4];
#pragma unroll
  for (int i = 0; i < 4; ++i) {
    const float g0 = bflo(gg[i]), g1 = bfhi(gg[i]);
    outp[i] = pack2(o[2 * i] * rs * gn[2 * i] * siluf_(g0), o[2 * i + 1] * rs * gn[2 * i + 1] * siluf_(g1));
  }
  *(uint4*)(og + lane * 8) = make_uint4(outp[0], outp[1], outp[2], outp[3]);
  norm_row(p, l, 0, row, ((const float*)(const __attribute__((address_space(1))) float*)karg(6)) + l * 1024, 0, 1024);
}

DI bool xcd_tile(int seq, int bid, int nblk, int MX, int NX, int& mt, int& nt) {
  const int per = nblk >> 3, li = bid >> 3, x = bid & 7;
  const int u = li + seq * per;
  if (u >= MX * NX) return false;
  const int FM = MX >> 3, fullsz = 8 * NX;
  int mgi, r, gm;
  if (u < FM * fullsz) { mgi = u / fullsz; r = u - mgi * fullsz; gm = 8; }
  else { mgi = FM; r = u - FM * fullsz; gm = MX & 7; }
  const int ngi = r / (gm * 8), r2 = r - ngi * gm * 8;
  const int nj = r2 / gm, mi = r2 - nj * gm;
  mt = x * MX + mgi * 8 + mi;
  nt = ngi * 8 + nj;
  return true;
}
DI int mtile_row0(int l, int mt) { return l == 0 ? mt * 128 : ((mt >> 5) * PT + CL + (mt & 31) * 128); }

#ifndef SKIPM
#define SKIPM 0
#endif
#ifdef PROBE_REP
__device__ const unsigned char PSEQ[] = {0, 1, 2, PROBE_R(2) 3, 4, 5, PROBE_R(5) 6, 7, 8, PROBE_R(8) 9, 10, 11, PROBE_R(11) 12, 13, 14, PROBE_R(14) 15, 16, 17, PROBE_R(17) 18};
#else
__device__ const unsigned char PSEQ[] = {0, 1, 2, 3, 4, 5, 6, 7, 8, 9, 10, 11, 12, 13, 14, 15, 16, 17, 18};
#endif
constexpr int NSEQ = sizeof(PSEQ);
#define OPAQUE_S(x) asm volatile("" : "+s"(x))
__global__ void __launch_bounds__(256, 2) fwd_megakernel(Params p) {
  extern __shared__ __attribute__((aligned(16))) unsigned char smem[];
  __shared__ int s_item, s_key;
  cg::grid_group grid = cg::this_grid();
  const int nblk = gridDim.x, bid = blockIdx.x;

  for (int pi = 0; pi < NSEQ; ++pi) {
    const int ph = PSEQ[pi];
    const int tid = tid_(), lane = tid & 63, w = tid >> 6, wm = w >> 1, wn = w & 1;
    unsigned char* ws = ((unsigned char*)(__attribute__((address_space(1))) unsigned char*)karg(21));
    const int l = (ph - 1) / 9, k = (ph == 0) ? -1 : (ph - 1) % 9;
    const int nmt = (l == 0) ? 136 : 128;
    if (k == -1 && !(SKIPM & 1)) {
      int* ctr = (int*)(ws + O_CTR);
      for (int i = bid * 256 + tid; i < 64 + 4 * 4096; i += nblk * 256) ctr[i] = 0;
      if (bid == 1 || nblk == 1) {
        float* ropet = (float*)(ws + O_ROPE);
        for (int i = tid; i < 1024; i += 256) {
          const int pos = i >> 4, j = i & 15;
          const float inv = exp2f(-(float)j * (13.287712379549449f / 16.f));
          const float ang = (float)pos * inv;
          ropet[i * 2] = __cosf(ang); ropet[i * 2 + 1] = __sinf(ang);
        }
      }
      for (int it = bid; it < 384 + CVT_ITEMS; it += nblk) {
        if (it < 384) mod_item(p, it, smem); else cvt_item(p, 0, it - 384, smem);
      }
    } else if (k == 0 && !(SKIPM & 2)) {
      if (l == 1) for (int it = bid; it < CVT_ITEMS; it += nblk) cvt_item(p, 1, it, smem);
      for (int row = bid * 4 + w; row < NT; row += nblk * 4) norm_row(p, l, 0, row, ((const float*)(const __attribute__((address_space(1))) float*)karg(6)) + l * 1024, 0, 1024);
    } else if (k == 1 && !(SKIPM & 4)) {
      for (int sq = 0;; ++sq) {
        int mt, nt;
        if (!xcd_tile(sq, bid, nblk, 17, 42, mt, nt)) break;
        f32x16 acc[2][2];
        zero_acc(acc);
        gemm_tile((const bf16_t*)(ws + O_UO) + (size_t)mt * 128 * 1024, 1024, (const bf16_t*)(ws + O_WIN) + (size_t)nt * 128 * 1024, 1024, 1024, acc, smem);
        inproj_epilogue(p, l, acc, mt * 128 + wm * 64, nt * 128 + wn * 64);
      }
    } else if (k == 2 && !(SKIPM & 8)) {
      int* ctr = (int*)(ws + O_CTR);
      const int nattn = N_B + N_C + (l == 0 ? N_CTX : 0);
      if (tid == 0) {
        const unsigned hw = __builtin_amdgcn_s_getreg(4 | (31 << 11));
        const unsigned xcc = __builtin_amdgcn_s_getreg(20 | (31 << 11));
        const int key = (int)(((xcc & 15u) << 8) | ((hw >> 8) & 255u));
        int* cuflag = ctr + 64 + 2 * 4096 + l * 4096 + key;
        const int r = atomicAdd(ctr + 64 + l * 4096 + key, 1);
        int item = -1;
        if (r == 0) {
          const int it = atomicAdd(ctr + l * 2 + 0, 1);
          if (it < N_A) { item = it; atomicExch(cuflag, 1); } else atomicExch(cuflag, 2);
        } else {
          for (int spin = 0; spin < (1 << 20); ++spin) {
            const int v = atomicAdd(cuflag, 0);
            if (v >= 2) break;
            __builtin_amdgcn_s_sleep(32);
          }
        }
        s_item = item; s_key = key;
      }
      __syncthreads();
      const int myitem = s_item, mykey = s_key;
      __syncthreads();
      if (myitem >= 0) {
        mixer_item(p, l, myitem, smem);
        __syncthreads();
        if (tid == 0) atomicExch(ctr + 64 + 2 * 4096 + l * 4096 + mykey, 3);
      }
      for (int pass = 0; pass < 2; ++pass) {
        const int q = 1 ^ pass;
        const int total = (q == 0) ? N_A : nattn;
        for (;;) {
          if (tid == 0) s_item = atomicAdd(ctr + l * 2 + q, 1);
          __syncthreads();
          const int it = s_item;
          __syncthreads();
          if (it >= total) break;
          mixer_item(p, l, q == 0 ? it : N_A + it, smem);
        }
      }
    } else if (k == 3 && !(SKIPM & 16)) {
      for (int i = bid * 4 + w; i < nmt * 128; i += nblk * 4) {
        const int row = (l == 0) ? i : ((i >> 12) * PT + CL + (i & 4095));
        readout_row(p, l, row);
      }
    } else if (k == 4 && !(SKIPM & 32)) {
      float4* msc = (float4*)(ws + O_CK) + (size_t)bid * 4096 + tid;
      for (int sq = 0;; ++sq) {
        int mt, nt;
        if (!xcd_tile(sq, bid, nblk, nmt >> 3, 8, mt, nt)) break;
        const int m0 = mtile_row0(l, mt), n0 = nt * 128;
#pragma unroll 1
        for (int kb = 0; kb < 3; ++kb) {
          f32x16 acc[2][2];
          zero_acc(acc);
          gemm_tile((const bf16_t*)(ws + O_UO) + (size_t)m0 * 1024, 1024, (const bf16_t*)(ws + O_WIN) + (size_t)(PW + kb * 1024 + n0) * 1024, 1024, 1024, acc, smem);
          uint4* gsc = (uint4*)(ws + O_QHF) + (size_t)bid * 2048 + tid;
#pragma unroll
          for (int i = 0; i < 2; ++i)
#pragma unroll
            for (int j = 0; j < 2; ++j) {
              unsigned g8[8];
#pragma unroll
              for (int r = 0; r < 8; ++r) g8[r] = pack2(sigmoidf_(acc[i][j][2 * r]), sigmoidf_(acc[i][j][2 * r + 1]));
              gsc[((i * 2 + j) * 2 + 0) * 256] = make_uint4(g8[0], g8[1], g8[2], g8[3]);
              gsc[((i * 2 + j) * 2 + 1) * 256] = make_uint4(g8[4], g8[5], g8[6], g8[7]);
            }
          zero_acc(acc);
          const size_t yo = (kb == 0) ? O_OG : (kb == 1 ? O_BQ : O_CQ);
          gemm_tile((const bf16_t*)(ws + yo) + (size_t)m0 * 512, 512, (const bf16_t*)(ws + O_WBR) + ((size_t)kb * 1024 + n0) * 512, 512, 512, acc, smem);
          const int h = lane >> 5, ln = lane & 31;
          int mso = 0, rowb = m0 + wm * 64 + h * 4, colb = n0 + wn * 64 + ln;
          asm volatile("" : "+v"(mso), "+v"(rowb), "+v"(colb));
#pragma unroll
          for (int i = 0; i < 2; ++i)
#pragma unroll
            for (int j = 0; j < 2; ++j) {
              const uint4 ga = gsc[mso + ((i * 2 + j) * 2 + 0) * 256], gb = gsc[mso + ((i * 2 + j) * 2 + 1) * 256];
              const unsigned g8[8] = {ga.x, ga.y, ga.z, ga.w, gb.x, gb.y, gb.z, gb.w};
#pragma unroll
              for (int rg = 0; rg < 4; ++rg) {
                float4 v;
                v.x = bflo(g8[rg * 2]) * acc[i][j][rg * 4 + 0];
                v.y = bfhi(g8[rg * 2]) * acc[i][j][rg * 4 + 1];
                v.z = bflo(g8[rg * 2 + 1]) * acc[i][j][rg * 4 + 2];
                v.w = bfhi(g8[rg * 2 + 1]) * acc[i][j][rg * 4 + 3];
                float4* sp = msc + mso + ((i * 2 + j) * 4 + rg) * 256;
                if (kb > 0) { const float4 o = *sp; v.x += o.x; v.y += o.y; v.z += o.z; v.w += o.w; }
                if (kb < 2) *sp = v;
                else {
                  bf16_t* mo = (bf16_t*)(ws + O_M);
                  const int row = rowb + i * 32 + rg * 8;
                  const int col = colb + j * 32;
                  mo[(size_t)row * 1024 + col] = tobf(v.x);
                  mo[(size_t)(row + 1) * 1024 + col] = tobf(v.y);
                  mo[(size_t)(row + 2) * 1024 + col] = tobf(v.z);
                  mo[(size_t)(row + 3) * 1024 + col] = tobf(v.w);
                }
                __builtin_amdgcn_sched_barrier(0);
              }
            }
        }
      }
    } else if (k == 5 && !(SKIPM & 64)) {
      for (int sq = 0;; ++sq) {
        int mt, nt;
        if (!xcd_tile(sq, bid, nblk, nmt >> 3, 8, mt, nt)) break;
        const int m0 = mtile_row0(l, mt), n0 = nt * 128;
        f32x16 acc[2][2];
        zero_acc(acc);
        gemm_tile((const bf16_t*)(ws + O_M) + (size_t)m0 * 1024, 1024, (const bf16_t*)(ws + O_WOUT) + (size_t)n0 * 1024, 1024, 1024, acc, smem);
        const int h = lane >> 5, ln = lane & 31;
#pragma unroll
        for (int i = 0; i < 2; ++i)
#pragma unroll
          for (int r = 0; r < 16; ++r) {
            const int row = m0 + wm * 64 + i * 32 + (r >> 2) * 8 + h * 4 + (r & 3);
            const int b = row / PT, q = row % PT;
            const float* xin = xrow_ptr(p, l, 0, row);
            float* xo = (q < CL) ? (float*)(ws + O_XC) + ((size_t)b * CL + q) * D : ((float*)(__attribute__((address_space(1))) float*)karg(20)) + ((size_t)b * SEQ + (q - CL)) * D;
            const float* modf = (const float*)(ws + O_MOD) + ((size_t)l * 5 + (q < CL ? 4 : b)) * 6144 + 2048;
#pragma unroll
            for (int j = 0; j < 2; ++j) {
              const int col = n0 + wn * 64 + j * 32 + ln;
              xo[col] = xin[col] + modf[col] * acc[i][j][r];
            }
          }
      }
    } else if (k == 6 && !(SKIPM & 128)) {
      for (int i = bid * 4 + w; i < nmt * 128; i += nblk * 4) {
        const int row = (l == 0) ? i : ((i >> 12) * PT + CL + (i & 4095));
        norm_row(p, l, 1, row, ((const float*)(const __attribute__((address_space(1))) float*)karg(7)) + l * 1024, 3072, 4096);
      }
    } else if (k == 7 && !(SKIPM & 256)) {
      for (int sq = 0;; ++sq) {
        int mt, nt;
        if (!xcd_tile(sq, bid, nblk, nmt >> 3, 44, mt, nt)) break;
        const int m0 = mtile_row0(l, mt);
        f32x16 acc[2][2];
        zero_acc(acc);
        gemm_tile((const bf16_t*)(ws + O_UO) + (size_t)m0 * 1024, 1024, (const bf16_t*)(ws + O_WGU) + (size_t)nt * 128 * 1024, 1024, 1024, acc, smem);
        bf16_t* ao = (bf16_t*)(ws + O_ACT);
        const int h = lane >> 5, ln = lane & 31;
#pragma unroll
        for (int i = 0; i < 2; ++i)
#pragma unroll
          for (int r = 0; r < 16; ++r) {
            const int row = m0 + wm * 64 + i * 32 + (r >> 2) * 8 + h * 4 + (r & 3);
            ao[(size_t)row * FH + nt * 64 + wn * 32 + ln] = tobf(siluf_(acc[i][0][r]) * acc[i][1][r]);
          }
      }
    } else if (!(SKIPM & 512)) {
      for (int sq = 0;; ++sq) {
        int mt, nt;
        if (!xcd_tile(sq, bid, nblk, nmt >> 3, 8, mt, nt)) break;
        const int m0 = mtile_row0(l, mt), n0 = nt * 128;
        f32x16 acc[2][2];
        zero_acc(acc);
        gemm_tile((const bf16_t*)(ws + O_ACT) + (size_t)m0 * FH, FH, (const bf16_t*)(ws + O_WD) + (size_t)n0 * FH, FH, FH, acc, smem);
        const int h = lane >> 5, ln = lane & 31;
#pragma unroll
        for (int i = 0; i < 2; ++i)
#pragma unroll
          for (int r = 0; r < 16; ++r) {
            const int row = m0 + wm * 64 + i * 32 + (r >> 2) * 8 + h * 4 + (r & 3);
            const int b = row / PT, q = row % PT;
            float* xo = (q < CL) ? (float*)(ws + O_XC) + ((size_t)b * CL + q) * D : ((float*)(__attribute__((address_space(1))) float*)karg(20)) + ((size_t)b * SEQ + (q - CL)) * D;
            const float* modf = (const float*)(ws + O_MOD) + ((size_t)l * 5 + (q < CL ? 4 : b)) * 6144 + 5120;
#pragma unroll
            for (int j = 0; j < 2; ++j) {
              const int col = n0 + wn * 64 + j * 32 + ln;
              xo[col] = xo[col] + modf[col] * acc[i][j][r];
            }
          }
      }
    }
    if (pi < NSEQ - 1) grid.sync();
  }
}

extern "C" void kernel_launch(void* const* d_in, const int* in_sizes, int n_in, void* d_out, int out_size, void* d_ws, size_t ws_size,
                              hipStream_t stream) {
  static int grid_blocks = 0;
  if (grid_blocks == 0) {
    if (ws_size < WS_END) { fprintf(stderr, "kernel_launch: workspace too small: %zu < %zu\n", ws_size, (size_t)WS_END); grid_blocks = -1; return; }
    int dev = 0, cus = 0, per_cu = 0;
    hipGetDevice(&dev);
    hipDeviceGetAttribute(&cus, hipDeviceAttributeMultiprocessorCount, dev);
    hipFuncSetAttribute((const void*)fwd_megakernel, hipFuncAttributeMaxDynamicSharedMemorySize, LDS_BYTES);
    hipOccupancyMaxActiveBlocksPerMultiprocessor(&per_cu, (const void*)fwd_megakernel, 256, LDS_BYTES);
    if (per_cu < 1) { fprintf(stderr, "kernel_launch: occupancy query returned %d\n", per_cu); grid_blocks = -1; return; }
    if (per_cu > 2) per_cu = 2;
    grid_blocks = cus * per_cu;
  }
  if (grid_blocks < 0) return;
  Params p{};
  p.x = (const float*)d_in[0]; p.c = (const float*)d_in[1]; p.ctx = (const float*)d_in[2]; p.c_ctx = (const float*)d_in[3];
  p.w_mod = (const float*)d_in[4]; p.b_mod = (const float*)d_in[5]; p.norm_mix = (const float*)d_in[6]; p.norm_ffn = (const float*)d_in[7];
  p.w_in = (const float*)d_in[8]; p.lb_raw = (const float*)d_in[9]; p.gn_a = (const float*)d_in[10]; p.qn_b = (const float*)d_in[11];
  p.kn_b = (const float*)d_in[12]; p.qn_c = (const float*)d_in[13]; p.kn_c = (const float*)d_in[14]; p.rel_bias = (const float*)d_in[15];
  p.w_branch = (const float*)d_in[16]; p.w_out = (const float*)d_in[17]; p.w_gate_up = (const float*)d_in[18]; p.w_down = (const float*)d_in[19];
  p.out = (float*)d_out; p.ws = (unsigned char*)d_ws;
  void* args[] = {&p};
  hipError_t e = hipLaunchCooperativeKernel((const void*)fwd_megakernel, dim3(grid_blocks), dim3(256), args, LDS_BYTES, stream);
  if (e != hipSuccess) fprintf(stderr, "cooperative launch failed: %s (grid %d)\n", hipGetErrorString(e), grid_blocks);
}
```

```cpp
#include <hip/hip_runtime.h>
#include <hip/hip_cooperative_groups.h>
#include <cstdio>
namespace cg = cooperative_groups;

typedef short bf16x8 __attribute__((ext_vector_type(8)));
typedef short s16x4 __attribute__((ext_vector_type(4)));
typedef float f32x16 __attribute__((ext_vector_type(16)));
typedef float f32x2 __attribute__((ext_vector_type(2)));
typedef __bf16 bf16x2_t __attribute__((ext_vector_type(2)));
typedef unsigned short bf16_t;
#define DI __device__ __forceinline__
#define MFMA(a, b, c) __builtin_amdgcn_mfma_f32_32x32x16_bf16((a), (b), (c), 0, 0, 0)

constexpr int D = 1024, NB = 4, SEQ = 4096, CL = 256, PT = 4352, NT = NB * PT;
constexpr int INW = 7936, INW2 = 8448, PW = 5376, FH = 2816, GU = 5632;
constexpr float EPS = 1e-6f;

constexpr size_t SZ512 = (size_t)NT * 512 * 2;
constexpr size_t SZ128 = (size_t)NT * 128 * 2;
constexpr size_t O_WIN = 0;
constexpr size_t O_WBR = O_WIN + (size_t)INW2 * D * 2;
constexpr size_t O_WOUT = O_WBR + (size_t)3 * D * 512 * 2;
constexpr size_t O_WGU = O_WOUT + (size_t)D * D * 2;
constexpr size_t O_WD = O_WGU + (size_t)GU * D * 2;
constexpr size_t O_UO = O_WD + (size_t)D * FH * 2;
constexpr size_t O_P = O_UO + (size_t)NT * 1024 * 2;
constexpr size_t O_QHF = O_P;
constexpr size_t O_KTF = O_QHF + SZ512;
constexpr size_t O_QHB = O_KTF + SZ512;
constexpr size_t O_KTB = O_QHB + SZ512;
constexpr size_t O_VA = O_KTB + SZ512;
constexpr size_t O_OG = O_VA + SZ512;
constexpr size_t O_BQ = O_OG + SZ512;
constexpr size_t O_CQ = O_BQ + SZ512;
constexpr size_t O_CK = O_CQ + SZ512;
constexpr size_t O_CVT = O_CK + SZ512;
constexpr size_t O_BK = O_CVT + SZ512;
constexpr size_t O_BVT = O_BK + SZ128;
constexpr size_t O_EBL = O_BVT + SZ128;
constexpr size_t O_XC = O_EBL + (size_t)2 * (NT / 32) * 512 * 4;
constexpr size_t O_MOD = O_XC + (size_t)NB * CL * D * 4;
constexpr size_t O_ROPE = O_MOD + (size_t)2 * 5 * 6144 * 4;
constexpr size_t O_CTR = O_ROPE + 64 * 16 * 2 * 4;
constexpr size_t WS_END = O_CTR + (64 + 4 * 4096) * 4;
constexpr size_t O_M = O_QHB;
constexpr size_t O_ACT = O_P;

constexpr int LDS_BYTES = 73728;
constexpr int LSTR = 72;

struct Params {
  const float* x; const float* c; const float* ctx; const float* c_ctx; const float* w_mod; const float* b_mod;
  const float* norm_mix; const float* norm_ffn; const float* w_in; const float* lb_raw; const float* gn_a;
  const float* qn_b; const float* kn_b; const float* qn_c; const float* kn_c; const float* rel_bias;
  const float* w_branch; const float* w_out; const float* w_gate_up; const float* w_down;
  float* out; unsigned char* ws;
};


typedef const unsigned long long __attribute__((address_space(4))) karg_t;
DI unsigned long long karg(int i) { return *(volatile karg_t*)((karg_t*)__builtin_amdgcn_kernarg_segment_ptr() + i); }
DI int tid_() { int t = threadIdx.x; asm volatile("" : "+v"(t)); return t; }
DI unsigned pack2(float a, float b) {
  f32x2 v = {a, b};
  bf16x2_t r = __builtin_convertvector(v, bf16x2_t);
  return __builtin_bit_cast(unsigned, r);
}
DI bf16_t tobf(float a) { return (bf16_t)(pack2(a, 0.f) & 0xffffu); }
DI float bflo(unsigned u) { return __uint_as_float(u << 16); }
DI float bfhi(unsigned u) { return __uint_as_float(u & 0xffff0000u); }
DI float sigmoidf_(float x) { return __builtin_amdgcn_rcpf(1.f + __builtin_amdgcn_exp2f(-1.4426950408889634f * x)); }
DI float siluf_(float x) { return x * __builtin_amdgcn_rcpf(1.f + __builtin_amdgcn_exp2f(-1.4426950408889634f * x)); }
DI float shx(float v, int m) { return __shfl_xor(v, m); }

DI void gemm_tile(const bf16_t* A, int lda, const bf16_t* Bt, int ldb, int K,
                  f32x16 (&acc)[2][2], unsigned char* smem) {
  const int tid = tid_(), lane = tid & 63, w = tid >> 6, wm = w >> 1, wn = w & 1;
  bf16_t* sa = (bf16_t*)smem;
  bf16_t* sb = sa + 2 * 128 * LSTR;
  const int lrow = tid >> 3, lkc = (tid & 7) * 8;
  const bf16_t* ga = A + (size_t)lrow * lda + lkc;
  const bf16_t* gb = Bt + (size_t)lrow * ldb + lkc;
  uint4 pa0, pa1, pa2, pa3, pb0, pb1, pb2, pb3;
  uint4 qa0, qa1, qa2, qa3, qb0, qb1, qb2, qb3;
#define GT_LOAD(S, koff) { \
    S##a0 = *(const uint4*)(ga + (koff)); S##a1 = *(const uint4*)(ga + (size_t)32 * lda + (koff)); \
    S##a2 = *(const uint4*)(ga + (size_t)64 * lda + (koff)); S##a3 = *(const uint4*)(ga + (size_t)96 * lda + (koff)); \
    S##b0 = *(const uint4*)(gb + (koff)); S##b1 = *(const uint4*)(gb + (size_t)32 * ldb + (koff)); \
    S##b2 = *(const uint4*)(gb + (size_t)64 * ldb + (koff)); S##b3 = *(const uint4*)(gb + (size_t)96 * ldb + (koff)); \
    asm volatile("" ::: "memory"); __builtin_amdgcn_sched_barrier(0); }
#define GT_STORE(S, bufi) { \
    bf16_t* da_ = sa + (bufi) * 128 * LSTR + lrow * LSTR + lkc; bf16_t* db_ = sb + (bufi) * 128 * LSTR + lrow * LSTR + lkc; \
    *(uint4*)(da_) = S##a0; *(uint4*)(da_ + 32 * LSTR) = S##a1; *(uint4*)(da_ + 64 * LSTR) = S##a2; *(uint4*)(da_ + 96 * LSTR) = S##a3; \
    *(uint4*)(db_) = S##b0; *(uint4*)(db_ + 32 * LSTR) = S##b1; *(uint4*)(db_ + 64 * LSTR) = S##b2; *(uint4*)(db_ + 96 * LSTR) = S##b3; }
#define GT_FRAGS(F0, F1, G0, G1, KS) \
    F0 = *(const bf16x8*)(as + (KS) * 16); F1 = *(const bf16x8*)(as + 32 * LSTR + (KS) * 16); \
    G0 = *(const bf16x8*)(bs + (KS) * 16); G1 = *(const bf16x8*)(bs + 32 * LSTR + (KS) * 16);
#define GEMM_STEP(A0, A1, B0, B1, PRE, ST0, ST1) \
    PRE \
    acc[0][0] = MFMA(A0, B0, acc[0][0]); acc[0][1] = MFMA(A0, B1, acc[0][1]); \
    ST0; ST1; \
    acc[1][0] = MFMA(A1, B0, acc[1][0]); acc[1][1] = MFMA(A1, B1, acc[1][1]); \
    __builtin_amdgcn_sched_barrier(0);
#define GT_COMPUTE(bufi, S, sbuf) { \
    const bf16_t* as = sa + (bufi) * 128 * LSTR + wm * 64 * LSTR + fo; \
    const bf16_t* bs = sb + (bufi) * 128 * LSTR + wn * 64 * LSTR + fo; \
    bf16_t* da_ = sa + (sbuf) * 128 * LSTR + lrow * LSTR + lkc; bf16_t* db_ = sb + (sbuf) * 128 * LSTR + lrow * LSTR + lkc; \
    bf16x8 a0, a1, b0, b1, c0, c1, d0, d1, e0, e1, f0, f1; \
    GT_FRAGS(a0, a1, b0, b1, 0) GT_FRAGS(c0, c1, d0, d1, 1) \
    GEMM_STEP(a0, a1, b0, b1, GT_FRAGS(e0, e1, f0, f1, 2), *(uint4*)(da_) = S##a0, *(uint4*)(db_) = S##b0) \
    GEMM_STEP(c0, c1, d0, d1, GT_FRAGS(a0, a1, b0, b1, 3), *(uint4*)(da_ + 32 * LSTR) = S##a1, *(uint4*)(db_ + 32 * LSTR) = S##b1) \
    GEMM_STEP(e0, e1, f0, f1, , *(uint4*)(da_ + 64 * LSTR) = S##a2, *(uint4*)(db_ + 64 * LSTR) = S##b2) \
    GEMM_STEP(a0, a1, b0, b1, , *(uint4*)(da_ + 96 * LSTR) = S##a3, *(uint4*)(db_ + 96 * LSTR) = S##b3) }
  const int nk = K >> 6;
  const int fo = (lane & 31) * LSTR + (lane >> 5) * 8;
  GT_LOAD(p, 0)
  GT_LOAD(q, 64)
  GT_STORE(p, 0)
  __syncthreads();
  for (int kt = 0; kt < nk; kt += 2) {
    GT_LOAD(p, min(kt + 2, nk - 1) * 64)
    GT_COMPUTE(0, q, 1)
    __syncthreads();
    GT_LOAD(q, min(kt + 3, nk - 1) * 64)
    GT_COMPUTE(1, p, 0)
    __syncthreads();
  }
}
DI void zero_acc(f32x16 (&acc)[2][2]) {
#pragma unroll
  for (int i = 0; i < 2; ++i)
#pragma unroll
    for (int j = 0; j < 2; ++j)
#pragma unroll
      for (int r = 0; r < 16; ++r) acc[i][j][r] = 0.f;
}

DI void cvt_tile(const float* __restrict__ src, int ldsrc, int k0, int scol0a, int scol0b, bf16_t* __restrict__ dst, int K, int n0,
                 unsigned char* smem) {
  float* t = (float*)smem;
  const int tid = tid_();
  {
    const int kk = tid >> 4, c4 = (tid & 15) * 4;
    const int sc = (c4 < 32) ? (scol0a + c4) : (scol0b + c4 - 32);
#pragma unroll
    for (int i = 0; i < 4; ++i) {
      const int k = kk + i * 16;
      float4 v = *(const float4*)(src + (size_t)(k0 + k) * ldsrc + sc);
      t[k * 65 + c4 + 0] = v.x; t[k * 65 + c4 + 1] = v.y; t[k * 65 + c4 + 2] = v.z; t[k * 65 + c4 + 3] = v.w;
    }
  }
  __syncthreads();
  {
    const int n = tid >> 2, kq = (tid & 3) * 16;
    unsigned o[8];
#pragma unroll
    for (int j = 0; j < 8; ++j) o[j] = pack2(t[(kq + 2 * j) * 65 + n], t[(kq + 2 * j + 1) * 65 + n]);
    bf16_t* d = dst + (size_t)(n0 + n) * K + k0 + kq;
    *(uint4*)d = make_uint4(o[0], o[1], o[2], o[3]);
    *(uint4*)(d + 8) = make_uint4(o[4], o[5], o[6], o[7]);
  }
  __syncthreads();
}
constexpr int CVT_ITEMS = 2112 + 384 + 256 + 1408 + 704;
DI void cvt_item(const Params& p, int l, int it, unsigned char* smem) {
  unsigned char* ws = ((unsigned char*)(__attribute__((address_space(1))) unsigned char*)karg(21));
  if (it < 2112) {
    const int kt = it & 15, nt = it >> 4;
    int ca, cb;
    if (nt < 16) { ca = 32 * nt; cb = 512 + 32 * nt; }
    else if (nt < 32) { ca = 32 * (nt - 16); cb = 1024 + 32 * (nt - 16); }
    else { ca = 64 * (nt - 32) + 1536; cb = ca + 32; }
    cvt_tile(((const float*)(const __attribute__((address_space(1))) float*)karg(8)) + (size_t)l * D * INW, INW, kt * 64, ca, cb, (bf16_t*)(ws + O_WIN), D, nt * 64, smem);
    return;
  }
  it -= 2112;
  if (it < 384) {
    const int kb = it / 128, r = it % 128, kt = r & 7, nt = r >> 3;
    cvt_tile(((const float*)(const __attribute__((address_space(1))) float*)karg(16)) + ((size_t)l * 3 + kb) * 512 * D, D, kt * 64, nt * 64, nt * 64 + 32, (bf16_t*)(ws + O_WBR) + (size_t)kb * D * 512, 512, nt * 64, smem);
    return;
  }
  it -= 384;
  if (it < 256) {
    const int kt = it & 15, nt = it >> 4;
    cvt_tile(((const float*)(const __attribute__((address_space(1))) float*)karg(17)) + (size_t)l * D * D, D, kt * 64, nt * 64, nt * 64 + 32, (bf16_t*)(ws + O_WOUT), D, nt * 64, smem);
    return;
  }
  it -= 256;
  if (it < 1408) {
    const int kt = it & 15, nt = it >> 4;
    const int tile = nt >> 1, wn = nt & 1;
    const int hid = tile * 64 + wn * 32;
    cvt_tile(((const float*)(const __attribute__((address_space(1))) float*)karg(18)) + (size_t)l * D * GU, GU, kt * 64, hid, FH + hid, (bf16_t*)(ws + O_WGU), D, nt * 64, smem);
    return;
  }
  it -= 1408;
  {
    const int kt = it % 44, nt = it / 44;
    cvt_tile(((const float*)(const __attribute__((address_space(1))) float*)karg(19)) + (size_t)l * FH * D, D, kt * 64, nt * 64, nt * 64 + 32, (bf16_t*)(ws + O_WD), FH, nt * 64, smem);
  }
}
DI void mod_item(const Params& p, int it, unsigned char* smem) {
  float* sc = (float*)smem;
  float* red = sc + 5 * 1024;
  const int tid = tid_();
  const int l = it / 192, cb = it % 192;
  for (int i = tid; i < 5 * 1024; i += 256) {
    const int r = i >> 10, k = i & 1023;
    const float v = (r < 4) ? ((const float*)(const __attribute__((address_space(1))) float*)karg(1))[r * 1024 + k] : ((const float*)(const __attribute__((address_space(1))) float*)karg(3))[k];
    sc[i] = siluf_(v);
  }
  __syncthreads();
  const int c = tid & 31, kg = tid >> 5;
  const int col = cb * 32 + c;
  const float* w = ((const float*)(const __attribute__((address_space(1))) float*)karg(4)) + (size_t)l * D * 6144 + col;
  float a0 = 0, a1 = 0, a2 = 0, a3 = 0, a4 = 0;
#pragma unroll 8
  for (int k = kg * 128; k < kg * 128 + 128; ++k) {
    const float wv = w[(size_t)k * 6144];
    a0 += sc[k] * wv; a1 += sc[1024 + k] * wv; a2 += sc[2048 + k] * wv; a3 += sc[3072 + k] * wv; a4 += sc[4096 + k] * wv;
  }
  red[(kg * 5 + 0) * 32 + c] = a0; red[(kg * 5 + 1) * 32 + c] = a1; red[(kg * 5 + 2) * 32 + c] = a2;
  red[(kg * 5 + 3) * 32 + c] = a3; red[(kg * 5 + 4) * 32 + c] = a4;
  __syncthreads();
  if (tid < 160) {
    const int r = tid >> 5, cc = tid & 31;
    float s = 0;
#pragma unroll
    for (int g = 0; g < 8; ++g) s += red[(g * 5 + r) * 32 + cc];
    const int colo = cb * 32 + cc;
    float* modf = (float*)(((unsigned char*)(__attribute__((address_space(1))) unsigned char*)karg(21)) + O_MOD);
    modf[((size_t)l * 5 + r) * 6144 + colo] = s + ((const float*)(const __attribute__((address_space(1))) float*)karg(5))[l * 6144 + colo];
  }
  __syncthreads();
}

DI const float* xrow_ptr(const Params& p, int l, int stage, int row) {
  const int b = row / PT, q = row % PT;
  if (q < CL) {
    const size_t o = ((size_t)b * CL + q) * D;
    return (l == 0 && stage == 0) ? ((const float*)(const __attribute__((address_space(1))) float*)karg(2)) + o : (const float*)(((unsigned char*)(__attribute__((address_space(1))) unsigned char*)karg(21)) + O_XC) + o;
  }
  const size_t o = ((size_t)b * SEQ + (q - CL)) * D;
  return (l == 0 && stage == 0) ? ((const float*)(const __attribute__((address_space(1))) float*)karg(0)) + o : ((float*)(__attribute__((address_space(1))) float*)karg(20)) + o;
}
DI void norm_row(const Params& p, int l, int stage, int row, const float* __restrict__ nw, int shoff, int scoff) {
  const int lane = tid_() & 63;
  const float* xr = xrow_ptr(p, l, stage, row);
  const int b = row / PT, q = row % PT;
  const float* modf = (const float*)(((unsigned char*)(__attribute__((address_space(1))) unsigned char*)karg(21)) + O_MOD) + ((size_t)l * 5 + (q < CL ? 4 : b)) * 6144;
  float4 v[4];
  float ss = 0.f;
#pragma unroll
  for (int i = 0; i < 4; ++i) {
    v[i] = *(const float4*)(xr + i * 256 + lane * 4);
    ss += v[i].x * v[i].x + v[i].y * v[i].y + v[i].z * v[i].z + v[i].w * v[i].w;
  }
#pragma unroll
  for (int m = 1; m < 64; m <<= 1) ss += shx(ss, m);
  const float rs = rsqrtf(ss * (1.f / 1024.f) + EPS);
  bf16_t* dst = (bf16_t*)(((unsigned char*)(__attribute__((address_space(1))) unsigned char*)karg(21)) + O_UO) + (size_t)row * 1024;
#pragma unroll
  for (int i = 0; i < 4; ++i) {
    const int k = i * 256 + lane * 4;
    const float4 wv = *(const float4*)(nw + k);
    const float4 sc = *(const float4*)(modf + scoff + k);
    const float4 sh = *(const float4*)(modf + shoff + k);
    const float y0 = v[i].x * rs * wv.x * (1.f + sc.x) + sh.x;
    const float y1 = v[i].y * rs * wv.y * (1.f + sc.y) + sh.y;
    const float y2 = v[i].z * rs * wv.z * (1.f + sc.z) + sh.z;
    const float y3 = v[i].w * rs * wv.w * (1.f + sc.w) + sh.w;
    *(uint2*)(dst + k) = make_uint2(pack2(y0, y1), pack2(y2, y3));
  }
}

DI void store4T(bf16_t* base, float a, float b, float c, float d) { *(uint2*)base = make_uint2(pack2(a, b), pack2(c, d)); }

DI void inproj_epilogue(const Params& p, int l, f32x16 (&acc)[2][2], int m0w, int n0w) {
  unsigned char* ws = ((unsigned char*)(__attribute__((address_space(1))) unsigned char*)karg(21));
  const int lane = tid_() & 63, ln = lane & 31, h = lane >> 5;
  if (n0w < 2048) {
    const int dir = n0w >> 10, ch = ((n0w & 1023) >> 6) * 32 + ln;
    float lb = 0.f;
    if (l == 1) {
      const float* lbr = ((const float*)(const __attribute__((address_space(1))) float*)karg(9));
      lb = fminf(sigmoidf_(lbr[(2 + dir) * 512 + ch] - lbr[dir * 512 + ch]), 1.f - 1e-6f);
    }
    bf16_t* qd = (bf16_t*)(ws + (dir ? O_QHB : O_QHF));
    bf16_t* kd = (bf16_t*)(ws + (dir ? O_KTB : O_KTF));
    float* ebl = (float*)(ws + O_EBL) + (size_t)dir * (NT / 32) * 512;
#pragma unroll
    for (int i = 0; i < 2; ++i) {
      const int r0 = m0w + i * 32;
      float kk[16], g2[16], gs[4], gp[4];
#pragma unroll
      for (int r = 0; r < 16; ++r) {
        kk[r] = (1.f - lb) * sigmoidf_(-acc[i][1][r]);
        g2[r] = __log2f(fmaxf(1.f - kk[r], 1e-30f));
      }
#pragma unroll
      for (int rg = 0; rg < 4; ++rg) { gs[rg] = (g2[rg * 4] + g2[rg * 4 + 1]) + (g2[rg * 4 + 2] + g2[rg * 4 + 3]); gp[rg] = shx(gs[rg], 32); }
      const float total = ((gs[0] + gp[0]) + (gs[1] + gp[1])) + ((gs[2] + gp[2]) + (gs[3] + gp[3]));
      float pre = 0.f;
#pragma unroll
      for (int rg = 0; rg < 4; ++rg) {
        float run = pre + (h ? gp[rg] : 0.f);
#pragma unroll
        for (int i4 = 0; i4 < 4; ++i4) {
          const int r = rg * 4 + i4;
          run += g2[r];
          const float bj = dir ? (total - run + g2[r]) : run;
          const size_t o = (size_t)(r0 + rg * 8 + h * 4 + i4) * 512 + ch;
          qd[o] = tobf(acc[i][0][r] * 0.08838834764831845f * __builtin_amdgcn_exp2f(bj));
          kd[o] = tobf(kk[r] * __builtin_amdgcn_exp2f(fminf(-bj, 115.f)));
        }
        pre += gs[rg] + gp[rg];
      }
      if (h == 0) ebl[(size_t)(r0 >> 5) * 512 + ch] = __builtin_amdgcn_exp2f(total);
    }
    return;
  }
  if (n0w < 2560) {
    bf16_t* vt = (bf16_t*)(ws + O_VA);
#pragma unroll
    for (int i = 0; i < 2; ++i)
#pragma unroll
      for (int rg = 0; rg < 4; ++rg) {
        const int row = m0w + i * 32 + rg * 8 + h * 4;
        const int b = row / PT, q = row % PT;
#pragma unroll
        for (int j = 0; j < 2; ++j) {
          const int ch = (n0w & 511) + j * 32 + ln;
          store4T(vt + ((size_t)b * 512 + ch) * PT + q, acc[i][j][rg * 4 + 0], acc[i][j][rg * 4 + 1], acc[i][j][rg * 4 + 2], acc[i][j][rg * 4 + 3]);
        }
      }
    return;
  }
  if (n0w < 3072) {
    bf16_t* dst = (bf16_t*)(ws + O_OG);
    const int cg0 = n0w & 511;
#pragma unroll
    for (int j = 0; j < 2; ++j)
#pragma unroll
      for (int i = 0; i < 2; ++i)
#pragma unroll
        for (int r = 0; r < 16; ++r) {
          const int row = m0w + i * 32 + (r >> 2) * 8 + h * 4 + (r & 3);
          dst[(size_t)row * 512 + cg0 + j * 32 + ln] = tobf(acc[i][j][r]);
        }
    return;
  }
  n0w -= 512;
  int kind, head;
  if (n0w < 3072) { kind = 0; head = (n0w - 2560) >> 6; }
  else if (n0w < 3200) { kind = 1; head = (n0w - 3072) >> 6; }
  else if (n0w < 3328) { kind = 2; head = (n0w - 3200) >> 6; }
  else if (n0w < 3840) { kind = 3; head = (n0w - 3328) >> 6; }
  else if (n0w < 4352) { kind = 4; head = (n0w - 3840) >> 6; }
  else { kind = 5; head = (n0w - 4352) >> 6; }
  if (kind == 2 || kind == 5) {
    bf16_t* vt = (bf16_t*)(ws + (kind == 2 ? O_BVT : O_CVT));
    const int nch = (kind == 2) ? 128 : 512;
#pragma unroll
    for (int i = 0; i < 2; ++i)
#pragma unroll
      for (int rg = 0; rg < 4; ++rg) {
        const int row = m0w + i * 32 + rg * 8 + h * 4;
        const int b = row / PT, q = row % PT;
#pragma unroll
        for (int j = 0; j < 2; ++j) {
          const int ch = head * 64 + j * 32 + ln;
          store4T(vt + ((size_t)b * nch + ch) * PT + q, acc[i][j][rg * 4 + 0], acc[i][j][rg * 4 + 1], acc[i][j][rg * 4 + 2], acc[i][j][rg * 4 + 3]);
        }
      }
    return;
  }
  const float* nwp = (kind == 0 ? ((const float*)(const __attribute__((address_space(1))) float*)karg(11)) : kind == 1 ? ((const float*)(const __attribute__((address_space(1))) float*)karg(12)) : kind == 3 ? ((const float*)(const __attribute__((address_space(1))) float*)karg(13)) : ((const float*)(const __attribute__((address_space(1))) float*)karg(14))) + l * 64;
  const float nw0 = nwp[ln], nw1 = nwp[32 + ln];
  const float qscale = (kind == 0 || kind == 3) ? 0.125f * 1.4426950408889634f : 1.f;
  const bool rope = (kind <= 1);
  const float* ropet = (const float*)(ws + O_ROPE);
  bf16_t* dst; int dstride;
  if (kind == 0) { dst = (bf16_t*)(ws + O_BQ); dstride = 512; }
  else if (kind == 1) { dst = (bf16_t*)(ws + O_BK); dstride = 128; }
  else if (kind == 3) { dst = (bf16_t*)(ws + O_CQ); dstride = 512; }
  else { dst = (bf16_t*)(ws + O_CK); dstride = 512; }
#pragma unroll
  for (int i = 0; i < 2; ++i)
#pragma unroll
    for (int r = 0; r < 16; ++r) {
      const int row = m0w + i * 32 + (r >> 2) * 8 + h * 4 + (r & 3);
      float v0 = acc[i][0][r], v1 = acc[i][1][r];
      float ss = v0 * v0 + v1 * v1;
      ss += shx(ss, 1); ss += shx(ss, 2); ss += shx(ss, 4); ss += shx(ss, 8); ss += shx(ss, 16);
      const float rs = rsqrtf(ss * (1.f / 64.f) + EPS);
      v0 = v0 * rs * nw0; v1 = v1 * rs * nw1;
      if (rope) {
        const int q = row % PT;
        const float p0 = shx(v0, 1), p1 = shx(v1, 1);
        if (q >= CL) {
          const int t = q - CL, gr = t >> 6, gc = t & 63;
          const int fj = ln >> 1;
          const float2 cs0 = *(const float2*)(ropet + (gr * 16 + fj) * 2);
          const float2 cs1 = *(const float2*)(ropet + (gc * 16 + fj) * 2);
          if (ln & 1) { v0 = p0 * cs0.y + v0 * cs0.x; v1 = p1 * cs1.y + v1 * cs1.x; }
          else { v0 = v0 * cs0.x - p0 * cs0.y; v1 = v1 * cs1.x - p1 * cs1.y; }
        }
      }
      dst[(size_t)row * dstride + head * 64 + ln] = tobf(v0 * qscale);
      dst[(size_t)row * dstride + head * 64 + 32 + ln] = tobf(v1 * qscale);
    }
}

constexpr int AQS = 136, ATS = 40;
constexpr int A_QH = 0, A_KT = A_QH + 32 * AQS * 2, A_KBT = A_KT + 32 * AQS * 2, A_VT = A_KBT + 128 * ATS * 2, A_EBL = A_VT + 128 * ATS * 2;
DI bf16x8 pack8(const f32x16& x, int o) {
  return __builtin_bit_cast(bf16x8, make_uint4(pack2(x[o + 0], x[o + 1]), pack2(x[o + 2], x[o + 3]), pack2(x[o + 4], x[o + 5]), pack2(x[o + 6], x[o + 7])));
}
template <int DIR> DI int ac_tb(int c) {
  const int s = c * 32;
  return DIR == 0 ? s : (s < CL ? (CL - 32 - s) : (PT + CL - 32 - s));
}
constexpr int A_VT2 = A_EBL + 512, A_EBL2 = A_VT2 + 128 * ATS * 2;
template <int DIR> DI void a_chunk_run(unsigned char* ws, int b, int hd, unsigned char* smem) {
  const int tid = tid_(), lane = tid & 63, w = tid >> 6, ln = lane & 31, hh = lane >> 5;
  const int kc = tid >> 1, half = tid & 1;
  const int sj = tid >> 3, cg = tid & 7;
  const size_t rb = (size_t)b * PT;
  const bf16_t* qg = (const bf16_t*)(ws + (DIR ? O_QHB : O_QHF)) + (rb + sj) * 512 + hd * 128 + cg * 16;
  const bf16_t* kg = (const bf16_t*)(ws + (DIR ? O_KTB : O_KTF)) + (rb + sj) * 512 + hd * 128 + cg * 16;
  const bf16_t* vg = (const bf16_t*)(ws + O_VA) + ((size_t)b * 512 + hd * 128 + kc) * PT + half * 16;
  const float* eg = (const float*)(ws + O_EBL) + (size_t)DIR * (NT / 32) * 512 + hd * 128 + kc;
  bf16_t* og = (bf16_t*)(ws + O_UO) + rb * 1024 + DIR * 512 + hd * 128 + w * 32 + ln;
  bf16_t* Qh = (bf16_t*)(smem + A_QH); bf16_t* Kt = (bf16_t*)(smem + A_KT);
  bf16_t* KtT = (bf16_t*)(smem + A_KBT);
  f32x16 S0, S1, S2, S3;
#pragma unroll
  for (int r = 0; r < 16; ++r) { S0[r] = 0.f; S1[r] = 0.f; S2[r] = 0.f; S3[r] = 0.f; }
  uint4 q0, q1, k0, k1, v0, v1;
  float pe;
#define A_PREFETCH(cc) { const int tb_ = ac_tb<DIR>(cc); \
    q0 = *(const uint4*)(qg + (size_t)tb_ * 512); q1 = *(const uint4*)(qg + (size_t)tb_ * 512 + 8); \
    k0 = *(const uint4*)(kg + (size_t)tb_ * 512); k1 = *(const uint4*)(kg + (size_t)tb_ * 512 + 8); \
    v0 = *(const uint4*)(vg + tb_); v1 = *(const uint4*)(vg + tb_ + 8); \
    pe = eg[(size_t)((rb + tb_) >> 5) * 512]; }
  A_PREFETCH(0)
#pragma unroll 1
  for (int c = 0; c < PT / 32; ++c) {
    bf16_t* Vt = (bf16_t*)(smem + ((c & 1) ? A_VT2 : A_VT));
    float* ebl = (float*)(smem + ((c & 1) ? A_EBL2 : A_EBL));
    *(uint4*)(Qh + sj * AQS + cg * 16) = q0; *(uint4*)(Qh + sj * AQS + cg * 16 + 8) = q1;
    *(uint4*)(Kt + sj * AQS + cg * 16) = k0; *(uint4*)(Kt + sj * AQS + cg * 16 + 8) = k1;
    *(uint4*)(Vt + kc * ATS + half * 16) = v0; *(uint4*)(Vt + kc * ATS + half * 16 + 8) = v1;
    if (half == 0) ebl[kc] = pe;
    __syncthreads();
    A_PREFETCH(min(c + 1, PT / 32 - 1))
    unsigned short kt16[16];
#pragma unroll
    for (int jj = 0; jj < 16; ++jj) kt16[jj] = Kt[(half * 16 + jj) * AQS + kc];
    bf16x8 fa[8], fq[8], qi[8], vi[2], vs[2];
#pragma unroll
    for (int ks = 0; ks < 8; ++ks) {
      fa[ks] = *(const bf16x8*)(Kt + ln * AQS + ks * 16 + hh * 8);
      fq[ks] = *(const bf16x8*)(Qh + ln * AQS + ks * 16 + hh * 8);
    }
    __builtin_amdgcn_sched_barrier(0);
    f32x16 at, o;
#pragma unroll
    for (int r = 0; r < 16; ++r) { at[r] = 0.f; o[r] = 0.f; }
#pragma unroll
    for (int ks = 0; ks < 8; ++ks) at = MFMA(fa[ks], fq[ks], at);
#pragma unroll
    for (int i = 0; i < 8; ++i) {
      const s16x4 lo = *(const s16x4*)(Qh + ln * AQS + (i >> 1) * 32 + 16 * (i & 1) + 4 * hh);
      const s16x4 hi = *(const s16x4*)(Qh + ln * AQS + (i >> 1) * 32 + 16 * (i & 1) + 4 * hh + 8);
      qi[i] = __builtin_shufflevector(lo, hi, 0, 1, 2, 3, 4, 5, 6, 7);
    }
#pragma unroll
    for (int st = 0; st < 2; ++st) {
      const s16x4 lo = *(const s16x4*)(Vt + (w * 32 + ln) * ATS + 16 * st + 4 * hh);
      const s16x4 hi = *(const s16x4*)(Vt + (w * 32 + ln) * ATS + 16 * st + 4 * hh + 8);
      vi[st] = __builtin_shufflevector(lo, hi, 0, 1, 2, 3, 4, 5, 6, 7);
      vs[st] = *(const bf16x8*)(Vt + (w * 32 + ln) * ATS + st * 16 + hh * 8);
    }
    __builtin_amdgcn_sched_barrier(0);
    o = MFMA(qi[0], pack8(S0, 0), o); o = MFMA(qi[1], pack8(S0, 8), o);
    o = MFMA(qi[2], pack8(S1, 0), o); o = MFMA(qi[3], pack8(S1, 8), o);
    o = MFMA(qi[4], pack8(S2, 0), o); o = MFMA(qi[5], pack8(S2, 8), o);
    o = MFMA(qi[6], pack8(S3, 0), o); o = MFMA(qi[7], pack8(S3, 8), o);
#pragma unroll
    for (int r = 0; r < 16; ++r) {
      const int s_ = (r >> 2) * 8 + hh * 4 + (r & 3);
      at[r] = (DIR == 0 ? (s_ <= ln) : (s_ >= ln)) ? at[r] : 0.f;
    }
    o = MFMA(pack8(at, 0), vi[0], o);
    o = MFMA(pack8(at, 8), vi[1], o);
    {
      unsigned kkp[8];
#pragma unroll
      for (int i = 0; i < 8; ++i) kkp[i] = (unsigned)kt16[2 * i] | ((unsigned)kt16[2 * i + 1] << 16);
      *(uint4*)(KtT + kc * ATS + half * 16) = make_uint4(kkp[0], kkp[1], kkp[2], kkp[3]);
      *(uint4*)(KtT + kc * ATS + half * 16 + 8) = make_uint4(kkp[4], kkp[5], kkp[6], kkp[7]);
    }
    {
      bf16_t* oc = og + (size_t)ac_tb<DIR>(c) * 1024;
#pragma unroll
      for (int r = 0; r < 16; ++r) { const int t = (r >> 2) * 8 + hh * 4 + (r & 3); oc[t * 1024] = tobf(o[r]); }
    }
    __syncthreads();
    bf16x8 ka[8];
    float4 ev[16];
#pragma unroll
    for (int i = 0; i < 8; ++i) ka[i] = *(const bf16x8*)(KtT + ((i >> 1) * 32 + ln) * ATS + (i & 1) * 16 + hh * 8);
#pragma unroll
    for (int i = 0; i < 16; ++i) ev[i] = *(const float4*)(ebl + (i >> 2) * 32 + (i & 3) * 8 + hh * 4);
    __builtin_amdgcn_sched_barrier(0);
    S0 = MFMA(ka[0], vs[0], S0); S1 = MFMA(ka[2], vs[0], S1); S2 = MFMA(ka[4], vs[0], S2); S3 = MFMA(ka[6], vs[0], S3);
    S0 = MFMA(ka[1], vs[1], S0); S1 = MFMA(ka[3], vs[1], S1); S2 = MFMA(ka[5], vs[1], S2); S3 = MFMA(ka[7], vs[1], S3);
#define A_SCALE(SK, kb) { \
      _Pragma("unroll") for (int rg = 0; rg < 4; ++rg) { \
        const float4 e = ev[(kb) * 4 + rg]; \
        SK[rg * 4 + 0] *= e.x; SK[rg * 4 + 1] *= e.y; SK[rg * 4 + 2] *= e.z; SK[rg * 4 + 3] *= e.w; } }
    A_SCALE(S0, 0) A_SCALE(S1, 1) A_SCALE(S2, 2) A_SCALE(S3, 3)
  }
  __syncthreads();
}
DI void a_chunk_item(unsigned char* ws, int it, unsigned char* smem) {
  const int dir = it & 1, hd = (it >> 1) & 3, b = it >> 3;
  __builtin_amdgcn_s_setprio(2);
  if (dir == 0) a_chunk_run<0>(ws, b, hd, smem); else a_chunk_run<1>(ws, b, hd, smem);
  __builtin_amdgcn_s_setprio(0);
}

struct AttnArgs {
  float m0;
  bf16_t* q;
  const bf16_t* k; int kstride;
  const bf16_t* vt;
  int kbase_row;
  int qrow;
  int ntiles, nwin, win_p0;
  int mode;
  int gr, r0w, cb, krow0;
  const float* bias;
};
DI void attn_run(const AttnArgs& a, unsigned char* smem) {
  const int tid = tid_(), lane = tid & 63, ln = lane & 31, h = lane >> 5;
  bf16_t* sk = (bf16_t*)smem;
  bf16_t* sv = sk + 2 * 64 * LSTR;
  bf16x8 qf[4];
  {
    const bf16_t* qp = a.q + (size_t)(a.qrow + ln) * 512 + h * 8;
#pragma unroll
    for (int ks = 0; ks < 4; ++ks) qf[ks] = *(const bf16x8*)(qp + ks * 16);
  }
  f32x16 o0, o1;
#pragma unroll
  for (int r = 0; r < 16; ++r) { o0[r] = 0.f; o1[r] = 0.f; }
  float lrun = 0.f;
  const int lrow = tid >> 3, lc = (tid & 7) * 8;
  uint4 rk0, rk1, rv0, rv1;
#define TILE_P0(i) ((i) < a.nwin ? a.win_p0 + (i) * 64 : ((i) - a.nwin) * 64)
#define GLOAD(i) { const int p0_ = TILE_P0(i); \
    rk0 = *(const uint4*)(a.k + (size_t)(a.kbase_row + p0_ + lrow) * a.kstride + lc); \
    rk1 = *(const uint4*)(a.k + (size_t)(a.kbase_row + p0_ + lrow + 32) * a.kstride + lc); \
    rv0 = *(const uint4*)(a.vt + (size_t)(lrow) * PT + p0_ + lc); \
    rv1 = *(const uint4*)(a.vt + (size_t)(lrow + 32) * PT + p0_ + lc); }
#define SSTORE(buf_) { \
    *(uint4*)(sk + (buf_) * 64 * LSTR + (lrow) * LSTR + lc) = rk0; \
    *(uint4*)(sk + (buf_) * 64 * LSTR + (lrow + 32) * LSTR + lc) = rk1; \
    *(uint4*)(sv + (buf_) * 64 * LSTR + (lrow) * LSTR + lc) = rv0; \
    *(uint4*)(sv + (buf_) * 64 * LSTR + (lrow + 32) * LSTR + lc) = rv1; }
  GLOAD(0);
  SSTORE(0);
  __syncthreads();
  for (int it = 0; it < a.ntiles; ++it) {
    const int buf = it & 1;
    GLOAD(min(it + 1, a.ntiles - 1));
    asm volatile("" ::: "memory");
    __builtin_amdgcn_sched_barrier(0);
    bool active = true;
    int krow = 0;
    const bool win = (a.mode == 1 && it < a.nwin);
    if (win) { krow = a.krow0 + it; active = (krow >= a.r0w && krow < a.r0w + 8); }
    if (active) {
      const bf16_t* ks_ = sk + buf * 64 * LSTR + ln * LSTR + h * 8;
      f32x16 s0, s1;
#pragma unroll
      for (int r = 0; r < 16; ++r) { s0[r] = -a.m0; s1[r] = -a.m0; }
#pragma unroll
      for (int ks = 0; ks < 4; ++ks) {
        bf16x8 a0 = *(const bf16x8*)(ks_ + ks * 16);
        bf16x8 a1 = *(const bf16x8*)(ks_ + 32 * LSTR + ks * 16);
        s0 = MFMA(a0, qf[ks], s0);
        s1 = MFMA(a1, qf[ks], s1);
      }
      if (win) {
        const int qc = a.cb + ln;
        const int c0 = min(max(qc - 8, 0), 48);
        const float* brow = a.bias + (krow - a.gr + 7) * 31 + 15 - qc;
#pragma unroll
        for (int r = 0; r < 16; ++r) {
          const int kc0 = (r >> 2) * 8 + h * 4 + (r & 3);
          const int kc1 = kc0 + 32;
          s0[r] = (kc0 >= c0 && kc0 < c0 + 16) ? s0[r] + brow[kc0] : -1e30f;
          s1[r] = (kc1 >= c0 && kc1 < c0 + 16) ? s1[r] + brow[kc1] : -1e30f;
        }
      }
#pragma unroll
      for (int r = 0; r < 16; ++r) { s0[r] = __builtin_amdgcn_exp2f(s0[r]); lrun += s0[r]; }
#pragma unroll
      for (int r = 0; r < 16; ++r) { s1[r] = __builtin_amdgcn_exp2f(s1[r]); lrun += s1[r]; }
      const bf16_t* vs_ = sv + buf * 64 * LSTR + ln * LSTR + h * 4;
#pragma unroll
      for (int j = 0; j < 4; ++j) {
        bf16x8 pb;
        {
          unsigned u0, u1, u2, u3;
          if (j < 2) {
            const int b8 = 8 * j;
            u0 = pack2(s0[b8 + 0], s0[b8 + 1]); u1 = pack2(s0[b8 + 2], s0[b8 + 3]);
            u2 = pack2(s0[b8 + 4], s0[b8 + 5]); u3 = pack2(s0[b8 + 6], s0[b8 + 7]);
          } else {
            const int b8 = 8 * (j - 2);
            u0 = pack2(s1[b8 + 0], s1[b8 + 1]); u1 = pack2(s1[b8 + 2], s1[b8 + 3]);
            u2 = pack2(s1[b8 + 4], s1[b8 + 5]); u3 = pack2(s1[b8 + 6], s1[b8 + 7]);
          }
          pb = __builtin_bit_cast(bf16x8, make_uint4(u0, u1, u2, u3));
        }
        const s16x4 lo0 = *(const s16x4*)(vs_ + j * 16);
        const s16x4 hi0 = *(const s16x4*)(vs_ + j * 16 + 8);
        const s16x4 lo1 = *(const s16x4*)(vs_ + 32 * LSTR + j * 16);
        const s16x4 hi1 = *(const s16x4*)(vs_ + 32 * LSTR + j * 16 + 8);
        const bf16x8 av0 = __builtin_shufflevector(lo0, hi0, 0, 1, 2, 3, 4, 5, 6, 7);
        const bf16x8 av1 = __builtin_shufflevector(lo1, hi1, 0, 1, 2, 3, 4, 5, 6, 7);
        o0 = MFMA(av0, pb, o0);
        o1 = MFMA(av1, pb, o1);
      }
    }
    SSTORE(buf ^ 1);
    __syncthreads();
  }
  lrun += shx(lrun, 32);
  const float inv = 1.f / lrun;
  bf16_t* op = a.q + (size_t)(a.qrow + ln) * 512;
#pragma unroll
  for (int rg = 0; rg < 4; ++rg) {
    const int d = rg * 8 + h * 4;
    *(uint2*)(op + d) = make_uint2(pack2(o0[rg * 4 + 0] * inv, o0[rg * 4 + 1] * inv), pack2(o0[rg * 4 + 2] * inv, o0[rg * 4 + 3] * inv));
    *(uint2*)(op + 32 + d) = make_uint2(pack2(o1[rg * 4 + 0] * inv, o1[rg * 4 + 1] * inv), pack2(o1[rg * 4 + 2] * inv, o1[rg * 4 + 3] * inv));
  }
}

DI float wave_max(float v) {
#pragma unroll
  for (int m = 32; m >= 1; m >>= 1) v = fmaxf(v, shx(v, m));
  return v;
}
DI float attn_m0(int qi, int ki, int l) {
  const int lane = tid_() & 63;
  const float* qn = ((const float*)(const __attribute__((address_space(1))) float*)karg(qi)) + l * 64;
  const float* kn = ((const float*)(const __attribute__((address_space(1))) float*)karg(ki)) + l * 64;
  return 8.f * 1.4426950408889634f * 1.02f * wave_max(fabsf(qn[lane])) * wave_max(fabsf(kn[lane]));
}
constexpr int N_A = 32, N_B = 1024, N_C = 1024, N_CTX = 128;
DI void mixer_item(const Params& p, int l, int it, unsigned char* smem) {
  const int w = tid_() >> 6;
  unsigned char* ws = ((unsigned char*)(__attribute__((address_space(1))) unsigned char*)karg(21));
  if (it < N_A) { a_chunk_item(ws, it, smem); return; }
  it -= N_A;
  AttnArgs a;
  a.bias = (const float*)(smem + 4 * 64 * LSTR * 2);
  a.mode = 0; a.gr = 0; a.r0w = 0; a.cb = 0; a.krow0 = 0;
  if (it < N_B) {
    const int hd = it & 7, qb = (it >> 3) & 31, b = it >> 8;
    a.q = (bf16_t*)(ws + O_BQ) + hd * 64;
    a.k = (const bf16_t*)(ws + O_BK) + (hd >> 2) * 64; a.kstride = 128;
    a.vt = (const bf16_t*)(ws + O_BVT) + ((size_t)b * 128 + (hd >> 2) * 64) * PT;
    a.kbase_row = b * PT; a.qrow = b * PT + CL + qb * 128 + w * 32;
    a.ntiles = 68; a.nwin = 68; a.win_p0 = 0;
    a.m0 = attn_m0(11, 12, l);
    attn_run(a, smem);
    return;
  }
  it -= N_B;
  if (it < N_C) {
    const int hd = it & 7, rp = (it >> 3) & 31, b = it >> 8;
    const int g0 = 2 * rp, g1 = 2 * rp + 1;
    const int r00 = min(max(g0 - 4, 0), 56), r01 = min(max(g1 - 4, 0), 56);
    float* bt = (float*)(smem + 4 * 64 * LSTR * 2);
    for (int i = tid_(); i < 465; i += 256) bt[i] = 1.4426950408889634f * ((const float*)(const __attribute__((address_space(1))) float*)karg(15))[((size_t)l * 8 + hd) * 465 + i];
    __syncthreads();
    a.q = (bf16_t*)(ws + O_CQ) + hd * 64;
    a.k = (const bf16_t*)(ws + O_CK) + hd * 64; a.kstride = 512;
    a.vt = (const bf16_t*)(ws + O_CVT) + ((size_t)b * 512 + hd * 64) * PT;
    a.kbase_row = b * PT;
    a.gr = g0 + (w >> 1); a.cb = (w & 1) * 32; a.r0w = (w >> 1) ? r01 : r00; a.krow0 = r00;
    a.qrow = b * PT + CL + a.gr * 64 + a.cb;
    a.nwin = r01 + 8 - r00; a.ntiles = a.nwin + 4; a.win_p0 = CL + r00 * 64;
    a.mode = 1;
    {
      const int lane = tid_() & 63;
      float bm = 0.f;
#pragma unroll
      for (int i = 0; i < 8; ++i) { const int ix = lane + 64 * i; if (ix < 465) bm = fmaxf(bm, fabsf(bt[ix])); }
      a.m0 = attn_m0(13, 14, l) + wave_max(bm);
    }
    attn_run(a, smem);
    return;
  }
  it -= N_C;
  {
    const int hd = it & 7, qb = (it >> 3) & 1, b = (it >> 4) & 3, kc = it >> 6;
    if (kc == 0) {
      a.q = (bf16_t*)(ws + O_BQ) + hd * 64;
      a.k = (const bf16_t*)(ws + O_BK) + (hd >> 2) * 64; a.kstride = 128;
      a.vt = (const bf16_t*)(ws + O_BVT) + ((size_t)b * 128 + (hd >> 2) * 64) * PT;
    } else {
      a.q = (bf16_t*)(ws + O_CQ) + hd * 64;
      a.k = (const bf16_t*)(ws + O_CK) + hd * 64; a.kstride = 512;
      a.vt = (const bf16_t*)(ws + O_CVT) + ((size_t)b * 512 + hd * 64) * PT;
    }
    a.kbase_row = b * PT; a.qrow = b * PT + qb * 128 + w * 32;
    a.ntiles = 4; a.nwin = 4; a.win_p0 = 0;
    a.m0 = (kc == 0) ? attn_m0(11, 12, l) : attn_m0(13, 14, l);
    attn_run(a, smem);
  }
}

DI void readout_row(const Params& p, int l, int row) {
  const int lane = tid_() & 63;
  unsigned char* ws = ((unsigned char*)(__attribute__((address_space(1))) unsigned char*)karg(21));
  const bf16_t* uo = (const bf16_t*)(ws + O_UO) + (size_t)row * 1024;
  bf16_t* og = (bf16_t*)(ws + O_OG) + (size_t)row * 512;
  const uint4 f4 = *(const uint4*)(uo + lane * 8);
  const uint4 b4 = *(const uint4*)(uo + 512 + lane * 8);
  const uint4 g4 = *(const uint4*)(og + lane * 8);
  asm volatile("s_waitcnt vmcnt(0)" ::: "memory");
  const unsigned ff[4] = {f4.x, f4.y, f4.z, f4.w}, bb[4] = {b4.x, b4.y, b4.z, b4.w}, gg[4] = {g4.x, g4.y, g4.z, g4.w};
  float o[8];
  float ss = 0.f;
#pragma unroll
  for (int i = 0; i < 4; ++i) {
    o[2 * i] = bflo(ff[i]) + bflo(bb[i]);
    o[2 * i + 1] = bfhi(ff[i]) + bfhi(bb[i]);
    ss += o[2 * i] * o[2 * i] + o[2 * i + 1] * o[2 * i + 1];
  }
  ss += shx(ss, 1); ss += shx(ss, 2); ss += shx(ss, 4); ss += shx(ss, 8);
  const float rs = rsqrtf(ss * (1.f / 128.f) + EPS);
  const float* gn = ((const float*)(const __attribute__((address_space(1))) float*)karg(10)) + l * 128 + (lane & 15) * 8;
  unsigned outp[4];
#pragma unroll
  for (int i = 0; i < 4; ++i) {
    const float g0 = bflo(gg[i]), g1 = bfhi(gg[i]);
    outp[i] = pack2(o[2 * i] * rs * gn[2 * i] * siluf_(g0), o[2 * i + 1] * rs * gn[2 * i + 1] * siluf_(g1));
  }
  *(uint4*)(og + lane * 8) = make_uint4(outp[0], outp[1], outp[2], outp[3]);
  norm_row(p, l, 0, row, ((const float*)(const __attribute__((address_space(1))) float*)karg(6)) + l * 1024, 0, 1024);
}

DI bool xcd_tile(int seq, int bid, int nblk, int MX, int NX, int& mt, int& nt) {
  const int per = nblk >> 3, li = bid >> 3, x = bid & 7;
  const int u = li + seq * per;
  if (u >= MX * NX) return false;
  const int FM = MX >> 3, fullsz = 8 * NX;
  int mgi, r, gm;
  if (u < FM * fullsz) { mgi = u / fullsz; r = u - mgi * fullsz; gm = 8; }
  else { mgi = FM; r = u - FM * fullsz; gm = MX & 7; }
  const int ngi = r / (gm * 8), r2 = r - ngi * gm * 8;
  const int nj = r2 / gm, mi = r2 - nj * gm;
  mt = x * MX + mgi * 8 + mi;
  nt = ngi * 8 + nj;
  return true;
}
DI int mtile_row0(int l, int mt) { return l == 0 ? mt * 128 : ((mt >> 5) * PT + CL + (mt & 31) * 128); }

#ifndef SKIPM
#define SKIPM 0
#endif
#ifdef PROBE_REP
__device__ const unsigned char PSEQ[] = {0, 1, 2, PROBE_R(2) 3, 4, 5, PROBE_R(5) 6, 7, 8, PROBE_R(8) 9, 10, 11, PROBE_R(11) 12, 13, 14, PROBE_R(14) 15, 16, 17, PROBE_R(17) 18};
#else
__device__ const unsigned char PSEQ[] = {0, 1, 2, 3, 4, 5, 6, 7, 8, 9, 10, 11, 12, 13, 14, 15, 16, 17, 18};
#endif
constexpr int NSEQ = sizeof(PSEQ);
#define OPAQUE_S(x) asm volatile("" : "+s"(x))
__global__ void __launch_bounds__(256, 2) fwd_megakernel(Params p) {
  extern __shared__ __attribute__((aligned(16))) unsigned char smem[];
  __shared__ int s_item, s_key;
  cg::grid_group grid = cg::this_grid();
  const int nblk = gridDim.x, bid = blockIdx.x;

  for (int pi = 0; pi < NSEQ; ++pi) {
    const int ph = PSEQ[pi];
    const int tid = tid_(), lane = tid & 63, w = tid >> 6, wm = w >> 1, wn = w & 1;
    unsigned char* ws = ((unsigned char*)(__attribute__((address_space(1))) unsigned char*)karg(21));
    const int l = (ph - 1) / 9, k = (ph == 0) ? -1 : (ph - 1) % 9;
    const int nmt = (l == 0) ? 136 : 128;
    if (k == -1 && !(SKIPM & 1)) {
      int* ctr = (int*)(ws + O_CTR);
      for (int i = bid * 256 + tid; i < 64 + 4 * 4096; i += nblk * 256) ctr[i] = 0;
      if (bid == 1 || nblk == 1) {
        float* ropet = (float*)(ws + O_ROPE);
        for (int i = tid; i < 1024; i += 256) {
          const int pos = i >> 4, j = i & 15;
          const float inv = exp2f(-(float)j * (13.287712379549449f / 16.f));
          const float ang = (float)pos * inv;
          ropet[i * 2] = __cosf(ang); ropet[i * 2 + 1] = __sinf(ang);
        }
      }
      for (int it = bid; it < 384 + CVT_ITEMS; it += nblk) {
        if (it < 384) mod_item(p, it, smem); else cvt_item(p, 0, it - 384, smem);
      }
    } else if (k == 0 && !(SKIPM & 2)) {
      if (l == 1) for (int it = bid; it < CVT_ITEMS; it += nblk) cvt_item(p, 1, it, smem);
      for (int row = bid * 4 + w; row < NT; row += nblk * 4) norm_row(p, l, 0, row, ((const float*)(const __attribute__((address_space(1))) float*)karg(6)) + l * 1024, 0, 1024);
    } else if (k == 1 && !(SKIPM & 4)) {
      for (int sq = 0;; ++sq) {
        int mt, nt;
        if (!xcd_tile(sq, bid, nblk, 17, 42, mt, nt)) break;
        f32x16 acc[2][2];
        zero_acc(acc);
        gemm_tile((const bf16_t*)(ws + O_UO) + (size_t)mt * 128 * 1024, 1024, (const bf16_t*)(ws + O_WIN) + (size_t)nt * 128 * 1024, 1024, 1024, acc, smem);
        inproj_epilogue(p, l, acc, mt * 128 + wm * 64, nt * 128 + wn * 64);
      }
    } else if (k == 2 && !(SKIPM & 8)) {
      int* ctr = (int*)(ws + O_CTR);
      const int nattn = N_B + N_C + (l == 0 ? N_CTX : 0);
      if (tid == 0) {
        const unsigned hw = __builtin_amdgcn_s_getreg(4 | (31 << 11));
        const unsigned xcc = __builtin_amdgcn_s_getreg(20 | (31 << 11));
        const int key = (int)(((xcc & 15u) << 8) | ((hw >> 8) & 255u));
        int* cuflag = ctr + 64 + 2 * 4096 + l * 4096 + key;
        const int r = atomicAdd(ctr + 64 + l * 4096 + key, 1);
        int item = -1;
        if (r == 0) {
          const int it = atomicAdd(ctr + l * 2 + 0, 1);
          if (it < N_A) { item = it; atomicExch(cuflag, 1); } else atomicExch(cuflag, 2);
        } else {
          for (int spin = 0; spin < (1 << 20); ++spin) {
            const int v = atomicAdd(cuflag, 0);
            if (v >= 2) break;
            __builtin_amdgcn_s_sleep(32);
          }
        }
        s_item = item; s_key = key;
      }
      __syncthreads();
      const int myitem = s_item, mykey = s_key;
      __syncthreads();
      if (myitem >= 0) {
        mixer_item(p, l, myitem, smem);
        __syncthreads();
        if (tid == 0) atomicExch(ctr + 64 + 2 * 4096 + l * 4096 + mykey, 3);
      }
      for (int pass = 0; pass < 2; ++pass) {
        const int q = 1 ^ pass;
        const int total = (q == 0) ? N_A : nattn;
        for (;;) {
          if (tid == 0) s_item = atomicAdd(ctr + l * 2 + q, 1);
          __syncthreads();
          const int it = s_item;
          __syncthreads();
          if (it >= total) break;
          mixer_item(p, l, q == 0 ? it : N_A + it, smem);
        }
      }
    } else if (k == 3 && !(SKIPM & 16)) {
      for (int i = bid * 4 + w; i < nmt * 128; i += nblk * 4) {
        const int row = (l == 0) ? i : ((i >> 12) * PT + CL + (i & 4095));
        readout_row(p, l, row);
      }
    } else if (k == 4 && !(SKIPM & 32)) {
      float4* msc = (float4*)(ws + O_CK) + (size_t)bid * 4096 + tid;
      for (int sq = 0;; ++sq) {
        int mt, nt;
        if (!xcd_tile(sq, bid, nblk, nmt >> 3, 8, mt, nt)) break;
        const int m0 = mtile_row0(l, mt), n0 = nt * 128;
#pragma unroll 1
        for (int kb = 0; kb < 3; ++kb) {
          f32x16 acc[2][2];
          zero_acc(acc);
          gemm_tile((const bf16_t*)(ws + O_UO) + (size_t)m0 * 1024, 1024, (const bf16_t*)(ws + O_WIN) + (size_t)(PW + kb * 1024 + n0) * 1024, 1024, 1024, acc, smem);
          uint4* gsc = (uint4*)(ws + O_QHF) + (size_t)bid * 2048 + tid;
#pragma unroll
          for (int i = 0; i < 2; ++i)
#pragma unroll
            for (int j = 0; j < 2; ++j) {
              unsigned g8[8];
#pragma unroll
              for (int r = 0; r < 8; ++r) g8[r] = pack2(sigmoidf_(acc[i][j][2 * r]), sigmoidf_(acc[i][j][2 * r + 1]));
              gsc[((i * 2 + j) * 2 + 0) * 256] = make_uint4(g8[0], g8[1], g8[2], g8[3]);
              gsc[((i * 2 + j) * 2 + 1) * 256] = make_uint4(g8[4], g8[5], g8[6], g8[7]);
            }
          zero_acc(acc);
          const size_t yo = (kb == 0) ? O_OG : (kb == 1 ? O_BQ : O_CQ);
          gemm_tile((const bf16_t*)(ws + yo) + (size_t)m0 * 512, 512, (const bf16_t*)(ws + O_WBR) + ((size_t)kb * 1024 + n0) * 512, 512, 512, acc, smem);
          const int h = lane >> 5, ln = lane & 31;
          int mso = 0, rowb = m0 + wm * 64 + h * 4, colb = n0 + wn * 64 + ln;
          asm volatile("" : "+v"(mso), "+v"(rowb), "+v"(colb));
#pragma unroll
          for (int i = 0; i < 2; ++i)
#pragma unroll
            for (int j = 0; j < 2; ++j) {
              const uint4 ga = gsc[mso + ((i * 2 + j) * 2 + 0) * 256], gb = gsc[mso + ((i * 2 + j) * 2 + 1) * 256];
              const unsigned g8[8] = {ga.x, ga.y, ga.z, ga.w, gb.x, gb.y, gb.z, gb.w};
#pragma unroll
              for (int rg = 0; rg < 4; ++rg) {
                float4 v;
                v.x = bflo(g8[rg * 2]) * acc[i][j][rg * 4 + 0];
                v.y = bfhi(g8[rg * 2]) * acc[i][j][rg * 4 + 1];
                v.z = bflo(g8[rg * 2 + 1]) * acc[i][j][rg * 4 + 2];
                v.w = bfhi(g8[rg * 2 + 1]) * acc[i][j][rg * 4 + 3];
                float4* sp = msc + mso + ((i * 2 + j) * 4 + rg) * 256;
                if (kb > 0) { const float4 o = *sp; v.x += o.x; v.y += o.y; v.z += o.z; v.w += o.w; }
                if (kb < 2) *sp = v;
                else {
                  bf16_t* mo = (bf16_t*)(ws + O_M);
                  const int row = rowb + i * 32 + rg * 8;
                  const int col = colb + j * 32;
                  mo[(size_t)row * 1024 + col] = tobf(v.x);
                  mo[(size_t)(row + 1) * 1024 + col] = tobf(v.y);
                  mo[(size_t)(row + 2) * 1024 + col] = tobf(v.z);
                  mo[(size_t)(row + 3) * 1024 + col] = tobf(v.w);
                }
                __builtin_amdgcn_sched_barrier(0);
              }
            }
        }
      }
    } else if (k == 5 && !(SKIPM & 64)) {
      for (int sq = 0;; ++sq) {
        int mt, nt;
        if (!xcd_tile(sq, bid, nblk, nmt >> 3, 8, mt, nt)) break;
        const int m0 = mtile_row0(l, mt), n0 = nt * 128;
        f32x16 acc[2][2];
        zero_acc(acc);
        gemm_tile((const bf16_t*)(ws + O_M) + (size_t)m0 * 1024, 1024, (const bf16_t*)(ws + O_WOUT) + (size_t)n0 * 1024, 1024, 1024, acc, smem);
        const int h = lane >> 5, ln = lane & 31;
#pragma unroll
        for (int i = 0; i < 2; ++i)
#pragma unroll
          for (int r = 0; r < 16; ++r) {
            const int row = m0 + wm * 64 + i * 32 + (r >> 2) * 8 + h * 4 + (r & 3);
            const int b = row / PT, q = row % PT;
            const float* xin = xrow_ptr(p, l, 0, row);
            float* xo = (q < CL) ? (float*)(ws + O_XC) + ((size_t)b * CL + q) * D : ((float*)(__attribute__((address_space(1))) float*)karg(20)) + ((size_t)b * SEQ + (q - CL)) * D;
            const float* modf = (const float*)(ws + O_MOD) + ((size_t)l * 5 + (q < CL ? 4 : b)) * 6144 + 2048;
#pragma unroll
            for (int j = 0; j < 2; ++j) {
              const int col = n0 + wn * 64 + j * 32 + ln;
              xo[col] = xin[col] + modf[col] * acc[i][j][r];
            }
          }
      }
    } else if (k == 6 && !(SKIPM & 128)) {
      for (int i = bid * 4 + w; i < nmt * 128; i += nblk * 4) {
        const int row = (l == 0) ? i : ((i >> 12) * PT + CL + (i & 4095));
        norm_row(p, l, 1, row, ((const float*)(const __attribute__((address_space(1))) float*)karg(7)) + l * 1024, 3072, 4096);
      }
    } else if (k == 7 && !(SKIPM & 256)) {
      for (int sq = 0;; ++sq) {
        int mt, nt;
        if (!xcd_tile(sq, bid, nblk, nmt >> 3, 44, mt, nt)) break;
        const int m0 = mtile_row0(l, mt);
        f32x16 acc[2][2];
        zero_acc(acc);
        gemm_tile((const bf16_t*)(ws + O_UO) + (size_t)m0 * 1024, 1024, (const bf16_t*)(ws + O_WGU) + (size_t)nt * 128 * 1024, 1024, 1024, acc, smem);
        bf16_t* ao = (bf16_t*)(ws + O_ACT);
        const int h = lane >> 5, ln = lane & 31;
#pragma unroll
        for (int i = 0; i < 2; ++i)
#pragma unroll
          for (int r = 0; r < 16; ++r) {
            const int row = m0 + wm * 64 + i * 32 + (r >> 2) * 8 + h * 4 + (r & 3);
            ao[(size_t)row * FH + nt * 64 + wn * 32 + ln] = tobf(siluf_(acc[i][0][r]) * acc[i][1][r]);
          }
      }
    } else if (!(SKIPM & 512)) {
      for (int sq = 0;; ++sq) {
        int mt, nt;
        if (!xcd_tile(sq, bid, nblk, nmt >> 3, 8, mt, nt)) break;
        const int m0 = mtile_row0(l, mt), n0 = nt * 128;
        f32x16 acc[2][2];
        zero_acc(acc);
        gemm_tile((const bf16_t*)(ws + O_ACT) + (size_t)m0 * FH, FH, (const bf16_t*)(ws + O_WD) + (size_t)n0 * FH, FH, FH, acc, smem);
        const int h = lane >> 5, ln = lane & 31;
#pragma unroll
        for (int i = 0; i < 2; ++i)
#pragma unroll
          for (int r = 0; r < 16; ++r) {
            const int row = m0 + wm * 64 + i * 32 + (r >> 2) * 8 + h * 4 + (r & 3);
            const int b = row / PT, q = row % PT;
            float* xo = (q < CL) ? (float*)(ws + O_XC) + ((size_t)b * CL + q) * D : ((float*)(__attribute__((address_space(1))) float*)karg(20)) + ((size_t)b * SEQ + (q - CL)) * D;
            const float* modf = (const float*)(ws + O_MOD) + ((size_t)l * 5 + (q < CL ? 4 : b)) * 6144 + 5120;
#pragma unroll
            for (int j = 0; j < 2; ++j) {
              const int col = n0 + wn * 64 + j * 32 + ln;
              xo[col] = xo[col] + modf[col] * acc[i][j][r];
            }
          }
      }
    }
    if (pi < NSEQ - 1) grid.sync();
  }
}

extern "C" void kernel_launch(void* const* d_in, const int* in_sizes, int n_in, void* d_out, int out_size, void* d_ws, size_t ws_size,
                              hipStream_t stream) {
  static int grid_blocks = 0;
  if (grid_blocks == 0) {
    if (ws_size < WS_END) { fprintf(stderr, "kernel_launch: workspace too small: %zu < %zu\n", ws_size, (size_t)WS_END); grid_blocks = -1; return; }
    int dev = 0, cus = 0, per_cu = 0;
    hipGetDevice(&dev);
    hipDeviceGetAttribute(&cus, hipDeviceAttributeMultiprocessorCount, dev);
    hipFuncSetAttribute((const void*)fwd_megakernel, hipFuncAttributeMaxDynamicSharedMemorySize, LDS_BYTES);
    hipOccupancyMaxActiveBlocksPerMultiprocessor(&per_cu, (const void*)fwd_megakernel, 256, LDS_BYTES);
    if (per_cu < 1) { fprintf(stderr, "kernel_launch: occupancy query returned %d\n", per_cu); grid_blocks = -1; return; }
    if (per_cu > 2) per_cu = 2;
    grid_blocks = cus * per_cu;
  }
  if (grid_blocks < 0) return;
  Params p{};
  p.x = (const float*)d_in[0]; p.c = (const float*)d_in[1]; p.ctx = (const float*)d_in[2]; p.c_ctx = (const float*)d_in[3];
  p.w_mod = (const float*)d_in[4]; p.b_mod = (const float*)d_in[5]; p.norm_mix = (const float*)d_in[6]; p.norm_ffn = (const float*)d_in[7];
  p.w_in = (const float*)d_in[8]; p.lb_raw = (const float*)d_in[9]; p.gn_a = (const float*)d_in[10]; p.qn_b = (const float*)d_in[11];
  p.kn_b = (const float*)d_in[12]; p.qn_c = (const float*)d_in[13]; p.kn_c = (const float*)d_in[14]; p.rel_bias = (const float*)d_in[15];
  p.w_branch = (const float*)d_in[16]; p.w_out = (const float*)d_in[17]; p.w_gate_up = (const float*)d_in[18]; p.w_down = (const float*)d_in[19];
  p.out = (float*)d_out; p.ws = (unsigned char*)d_ws;
  void* args[] = {&p};
  hipError_t e = hipLaunchCooperativeKernel((const void*)fwd_megakernel, dim3(grid_blocks), dim3(256), args, LDS_BYTES, stream);
  if (e != hipSuccess) fprintf(stderr, "cooperative launch failed: %s (grid %d)\n", hipGetErrorString(e), grid_blocks);
}
```

```cpp
#include <hip/hip_runtime.h>
#include <hip/hip_cooperative_groups.h>
#include <cstdio>
namespace cg = cooperative_groups;

typedef short bf16x8 __attribute__((ext_vector_type(8)));
typedef short s16x4 __attribute__((ext_vector_type(4)));
typedef float f32x16 __attribute__((ext_vector_type(16)));
typedef float f32x2 __attribute__((ext_vector_type(2)));
typedef __bf16 bf16x2_t __attribute__((ext_vector_type(2)));
typedef unsigned short bf16_t;
#define DI __device__ __forceinline__
#define MFMA(a, b, c) __builtin_amdgcn_mfma_f32_32x32x16_bf16((a), (b), (c), 0, 0, 0)

constexpr int D = 1024, NB = 4, SEQ = 4096, CL = 256, PT = 4352, NT = NB * PT;
constexpr int INW = 7936, INW2 = 8448, PW = 5376, FH = 2816, GU = 5632;
constexpr float EPS = 1e-6f;

constexpr size_t SZ512 = (size_t)NT * 512 * 2;
constexpr size_t SZ128 = (size_t)NT * 128 * 2;
constexpr size_t O_WIN = 0;
constexpr size_t O_WBR = O_WIN + (size_t)INW2 * D * 2;
constexpr size_t O_WOUT = O_WBR + (size_t)3 * D * 512 * 2;
constexpr size_t O_WGU = O_WOUT + (size_t)D * D * 2;
constexpr size_t O_WD = O_WGU + (size_t)GU * D * 2;
constexpr size_t O_UO = O_WD + (size_t)D * FH * 2;
constexpr size_t O_P = O_UO + (size_t)NT * 1024 * 2;
constexpr size_t O_QHF = O_P;
constexpr size_t O_KTF = O_QHF + SZ512;
constexpr size_t O_QHB = O_KTF + SZ512;
constexpr size_t O_KTB = O_QHB + SZ512;
constexpr size_t O_VA = O_KTB + SZ512;
constexpr size_t O_OG = O_VA + SZ512;
constexpr size_t O_BQ = O_OG + SZ512;
constexpr size_t O_CQ = O_BQ + SZ512;
constexpr size_t O_CK = O_CQ + SZ512;
constexpr size_t O_CVT = O_CK + SZ512;
constexpr size_t O_BK = O_CVT + SZ512;
constexpr size_t O_BVT = O_BK + SZ128;
constexpr size_t O_EBL = O_BVT + SZ128;
constexpr size_t O_XC = O_EBL + (size_t)2 * (NT / 32) * 512 * 4;
constexpr size_t O_MOD = O_XC + (size_t)NB * CL * D * 4;
constexpr size_t O_ROPE = O_MOD + (size_t)2 * 5 * 6144 * 4;
constexpr size_t O_CTR = O_ROPE + 64 * 16 * 2 * 4;
constexpr size_t O_BAR = O_CTR + (64 + 4 * 4096) * 4;
constexpr size_t WS_END = O_BAR + 16384;
constexpr size_t O_M = O_QHB;
constexpr size_t O_ACT = O_P;

constexpr int LDS_BYTES = 73728;
constexpr int LSTR = 72;

struct Params {
  const float* x; const float* c; const float* ctx; const float* c_ctx; const float* w_mod; const float* b_mod;
  const float* norm_mix; const float* norm_ffn; const float* w_in; const float* lb_raw; const float* gn_a;
  const float* qn_b; const float* kn_b; const float* qn_c; const float* kn_c; const float* rel_bias;
  const float* w_branch; const float* w_out; const float* w_gate_up; const float* w_down;
  float* out; unsigned char* ws;
};


typedef const unsigned long long __attribute__((address_space(4))) karg_t;
DI unsigned long long karg(int i) { return *(volatile karg_t*)((karg_t*)__builtin_amdgcn_kernarg_segment_ptr() + i); }
DI int tid_() { int t = threadIdx.x; asm volatile("" : "+v"(t)); return t; }
DI unsigned pack2(float a, float b) {
  f32x2 v = {a, b};
  bf16x2_t r = __builtin_convertvector(v, bf16x2_t);
  return __builtin_bit_cast(unsigned, r);
}
DI bf16_t tobf(float a) { return (bf16_t)(pack2(a, 0.f) & 0xffffu); }
DI float bflo(unsigned u) { return __uint_as_float(u << 16); }
DI float bfhi(unsigned u) { return __uint_as_float(u & 0xffff0000u); }
DI float sigmoidf_(float x) { return __builtin_amdgcn_rcpf(1.f + __builtin_amdgcn_exp2f(-1.4426950408889634f * x)); }
DI float siluf_(float x) { return x * __builtin_amdgcn_rcpf(1.f + __builtin_amdgcn_exp2f(-1.4426950408889634f * x)); }
DI float shx(float v, int m) { return __shfl_xor(v, m); }

#define XB_TMO      128
#define XB_XCNT(j)  (256  + 64 * (j))
#define XB_XSUB(j)  (1280 + 64 * (j))
#define XB_XGEN(j)  (2304 + 64 * (j))
#define XB_TOP      3328
#define XB_TOPGEN   3392
#define XCD_BAR_WORDS 3456
#define XB_SPIN_CAP (1u << 18)
#define LAS __attribute__((address_space(3)))
DI unsigned xb_ld(unsigned* p)              { return __hip_atomic_load(p, __ATOMIC_RELAXED, __HIP_MEMORY_SCOPE_AGENT); }
DI unsigned xb_add(unsigned* p, unsigned v) { return __hip_atomic_fetch_add(p, v, __ATOMIC_RELAXED, __HIP_MEMORY_SCOPE_AGENT); }
DI unsigned xb_xcc_id() { return (unsigned)__builtin_amdgcn_s_getreg((3 << 11) | 20) & 0xFu; }
#define XB_SPIN(cond, bar) do { unsigned _sp = 0; while (cond) { __builtin_amdgcn_s_sleep(1); \
    if ((++_sp & 255u) == 0u) { if (xb_ld(&(bar)[XB_TMO])) break; if (_sp > XB_SPIN_CAP) { atomicAdd(&(bar)[XB_TMO], 1u); break; } } } } while (0)
struct XcdBarrier { unsigned* bar; unsigned x; volatile LAS unsigned* st; };
DI XcdBarrier xcd_barrier_post(unsigned* bar, volatile LAS unsigned* st) {
  XcdBarrier b; b.bar = bar; b.x = xb_xcc_id(); b.st = st;
  if (threadIdx.x == 0) (void)xb_add(&bar[XB_XCNT(b.x)], 1u);
  return b;
}
DI void xcd_barrier_complete(unsigned* bar, unsigned x, unsigned& nloc, unsigned& nx) {
  const unsigned G = gridDim.x * gridDim.y * gridDim.z;
  unsigned sum, cnt, mine, sp = 0u;
  for (;;) {
    sum = 0u; cnt = 0u; mine = 0u;
#pragma unroll
    for (unsigned j = 0; j < 16; ++j) { const unsigned c = xb_ld(&bar[XB_XCNT(j)]); sum += c; cnt += (c > 0u) ? 1u : 0u; mine = (j == x) ? c : mine; }
    if (sum == G) break;
    __builtin_amdgcn_s_sleep(1);
    if ((++sp & 255u) == 0u) { if (xb_ld(&bar[XB_TMO])) break; if (sp > XB_SPIN_CAP) { atomicAdd(&bar[XB_TMO], 1u); break; } }
  }
  nloc = mine > 0u ? mine : 1u; nx = cnt > 0u ? cnt : 1u;
}
DI void xcd_barrier(const XcdBarrier& b) {
  asm volatile("s_waitcnt vmcnt(0)" ::: "memory");
  __syncthreads();
  if (threadIdx.x == 0) {
    unsigned* bar = b.bar;
    __builtin_amdgcn_s_waitcnt(0);
    unsigned nloc = b.st[0], nx = b.st[1];
    if (nloc == 0u) { xcd_barrier_complete(bar, b.x, nloc, nx); b.st[0] = nloc; b.st[1] = nx; }
    const unsigned old = xb_add(&bar[XB_XSUB(b.x)], 1u);
    const unsigned gen = old / nloc;
    if (old + 1u == (gen + 1u) * nloc) {
      __builtin_amdgcn_fence(__ATOMIC_RELEASE, "agent");
      asm volatile("s_waitcnt vmcnt(0)" ::: "memory");
      const unsigned og = xb_add(&bar[XB_TOP], 1u);
      const unsigned tg = og / nx;
      if (og + 1u == (tg + 1u) * nx) xb_add(&bar[XB_TOPGEN], 1u);
      else XB_SPIN(xb_ld(&bar[XB_TOPGEN]) == tg, bar);
      __builtin_amdgcn_fence(__ATOMIC_ACQUIRE, "agent");
      xb_add(&bar[XB_XGEN(b.x)], 1u);
      asm volatile("s_waitcnt vmcnt(0)" ::: "memory");
    } else {
      XB_SPIN(xb_ld(&bar[XB_XGEN(b.x)]) == gen, bar);
      __builtin_amdgcn_fence(__ATOMIC_ACQUIRE, "agent");
      asm volatile("s_waitcnt vmcnt(0)" ::: "memory");
    }
  }
  __syncthreads();
}

DI void gemm_tile(const bf16_t* A, int lda, const bf16_t* Bt, int ldb, int K,
                  f32x16 (&acc)[2][2], unsigned char* smem) {
  const int tid = tid_(), lane = tid & 63, w = tid >> 6, wm = w >> 1, wn = w & 1;
  bf16_t* sa = (bf16_t*)smem;
  bf16_t* sb = sa + 2 * 128 * LSTR;
  const int lrow = tid >> 3, lkc = (tid & 7) * 8;
  const bf16_t* ga = A + (size_t)lrow * lda + lkc;
  const bf16_t* gb = Bt + (size_t)lrow * ldb + lkc;
  uint4 pa0, pa1, pa2, pa3, pb0, pb1, pb2, pb3;
  uint4 qa0, qa1, qa2, qa3, qb0, qb1, qb2, qb3;
#define GT_LOAD(S, koff) { \
    S##a0 = *(const uint4*)(ga + (koff)); S##a1 = *(const uint4*)(ga + (size_t)32 * lda + (koff)); \
    S##a2 = *(const uint4*)(ga + (size_t)64 * lda + (koff)); S##a3 = *(const uint4*)(ga + (size_t)96 * lda + (koff)); \
    S##b0 = *(const uint4*)(gb + (koff)); S##b1 = *(const uint4*)(gb + (size_t)32 * ldb + (koff)); \
    S##b2 = *(const uint4*)(gb + (size_t)64 * ldb + (koff)); S##b3 = *(const uint4*)(gb + (size_t)96 * ldb + (koff)); \
    asm volatile("" ::: "memory"); __builtin_amdgcn_sched_barrier(0); }
#define GT_STORE(S, bufi) { \
    bf16_t* da_ = sa + (bufi) * 128 * LSTR + lrow * LSTR + lkc; bf16_t* db_ = sb + (bufi) * 128 * LSTR + lrow * LSTR + lkc; \
    *(uint4*)(da_) = S##a0; *(uint4*)(da_ + 32 * LSTR) = S##a1; *(uint4*)(da_ + 64 * LSTR) = S##a2; *(uint4*)(da_ + 96 * LSTR) = S##a3; \
    *(uint4*)(db_) = S##b0; *(uint4*)(db_ + 32 * LSTR) = S##b1; *(uint4*)(db_ + 64 * LSTR) = S##b2; *(uint4*)(db_ + 96 * LSTR) = S##b3; }
#define GT_FRAGS(F0, F1, G0, G1, KS) \
    F0 = *(const bf16x8*)(as + (KS) * 16); F1 = *(const bf16x8*)(as + 32 * LSTR + (KS) * 16); \
    G0 = *(const bf16x8*)(bs + (KS) * 16); G1 = *(const bf16x8*)(bs + 32 * LSTR + (KS) * 16);
#define GEMM_STEP(A0, A1, B0, B1, PRE, ST0, ST1) \
    PRE \
    acc[0][0] = MFMA(A0, B0, acc[0][0]); acc[0][1] = MFMA(A0, B1, acc[0][1]); \
    ST0; ST1; \
    acc[1][0] = MFMA(A1, B0, acc[1][0]); acc[1][1] = MFMA(A1, B1, acc[1][1]); \
    __builtin_amdgcn_sched_barrier(0);
#define GT_COMPUTE(bufi, S, sbuf) { \
    const bf16_t* as = sa + (bufi) * 128 * LSTR + wm * 64 * LSTR + fo; \
    const bf16_t* bs = sb + (bufi) * 128 * LSTR + wn * 64 * LSTR + fo; \
    bf16_t* da_ = sa + (sbuf) * 128 * LSTR + lrow * LSTR + lkc; bf16_t* db_ = sb + (sbuf) * 128 * LSTR + lrow * LSTR + lkc; \
    bf16x8 a0, a1, b0, b1, c0, c1, d0, d1, e0, e1, f0, f1; \
    GT_FRAGS(a0, a1, b0, b1, 0) GT_FRAGS(c0, c1, d0, d1, 1) \
    GEMM_STEP(a0, a1, b0, b1, GT_FRAGS(e0, e1, f0, f1, 2), *(uint4*)(da_) = S##a0, *(uint4*)(db_) = S##b0) \
    GEMM_STEP(c0, c1, d0, d1, GT_FRAGS(a0, a1, b0, b1, 3), *(uint4*)(da_ + 32 * LSTR) = S##a1, *(uint4*)(db_ + 32 * LSTR) = S##b1) \
    GEMM_STEP(e0, e1, f0, f1, , *(uint4*)(da_ + 64 * LSTR) = S##a2, *(uint4*)(db_ + 64 * LSTR) = S##b2) \
    GEMM_STEP(a0, a1, b0, b1, , *(uint4*)(da_ + 96 * LSTR) = S##a3, *(uint4*)(db_ + 96 * LSTR) = S##b3) }
  const int nk = K >> 6;
  const int fo = (lane & 31) * LSTR + (lane >> 5) * 8;
  GT_LOAD(p, 0)
  GT_LOAD(q, 64)
  GT_STORE(p, 0)
  __syncthreads();
  for (int kt = 0; kt < nk; kt += 2) {
    GT_LOAD(p, min(kt + 2, nk - 1) * 64)
    GT_COMPUTE(0, q, 1)
    __syncthreads();
    GT_LOAD(q, min(kt + 3, nk - 1) * 64)
    GT_COMPUTE(1, p, 0)
    __syncthreads();
  }
}
DI void zero_acc(f32x16 (&acc)[2][2]) {
#pragma unroll
  for (int i = 0; i < 2; ++i)
#pragma unroll
    for (int j = 0; j < 2; ++j)
#pragma unroll
      for (int r = 0; r < 16; ++r) acc[i][j][r] = 0.f;
}

DI void cvt_tile(const float* __restrict__ src, int ldsrc, int k0, int scol0a, int scol0b, bf16_t* __restrict__ dst, int K, int n0,
                 unsigned char* smem) {
  float* t = (float*)smem;
  const int tid = tid_();
  {
    const int kk = tid >> 4, c4 = (tid & 15) * 4;
    const int sc = (c4 < 32) ? (scol0a + c4) : (scol0b + c4 - 32);
#pragma unroll
    for (int i = 0; i < 4; ++i) {
      const int k = kk + i * 16;
      float4 v = *(const float4*)(src + (size_t)(k0 + k) * ldsrc + sc);
      t[k * 65 + c4 + 0] = v.x; t[k * 65 + c4 + 1] = v.y; t[k * 65 + c4 + 2] = v.z; t[k * 65 + c4 + 3] = v.w;
    }
  }
  __syncthreads();
  {
    const int n = tid >> 2, kq = (tid & 3) * 16;
    unsigned o[8];
#pragma unroll
    for (int j = 0; j < 8; ++j) o[j] = pack2(t[(kq + 2 * j) * 65 + n], t[(kq + 2 * j + 1) * 65 + n]);
    bf16_t* d = dst + (size_t)(n0 + n) * K + k0 + kq;
    *(uint4*)d = make_uint4(o[0], o[1], o[2], o[3]);
    *(uint4*)(d + 8) = make_uint4(o[4], o[5], o[6], o[7]);
  }
  __syncthreads();
}
constexpr int CVT_ITEMS = 2112 + 384 + 256 + 1408 + 704;
DI void cvt_item(const Params& p, int l, int it, unsigned char* smem) {
  unsigned char* ws = ((unsigned char*)(__attribute__((address_space(1))) unsigned char*)karg(21));
  if (it < 2112) {
    const int kt = it & 15, nt = it >> 4;
    int ca, cb;
    if (nt < 16) { ca = 32 * nt; cb = 512 + 32 * nt; }
    else if (nt < 32) { ca = 32 * (nt - 16); cb = 1024 + 32 * (nt - 16); }
    else { ca = 64 * (nt - 32) + 1536; cb = ca + 32; }
    cvt_tile(((const float*)(const __attribute__((address_space(1))) float*)karg(8)) + (size_t)l * D * INW, INW, kt * 64, ca, cb, (bf16_t*)(ws + O_WIN), D, nt * 64, smem);
    return;
  }
  it -= 2112;
  if (it < 384) {
    const int kb = it / 128, r = it % 128, kt = r & 7, nt = r >> 3;
    cvt_tile(((const float*)(const __attribute__((address_space(1))) float*)karg(16)) + ((size_t)l * 3 + kb) * 512 * D, D, kt * 64, nt * 64, nt * 64 + 32, (bf16_t*)(ws + O_WBR) + (size_t)kb * D * 512, 512, nt * 64, smem);
    return;
  }
  it -= 384;
  if (it < 256) {
    const int kt = it & 15, nt = it >> 4;
    cvt_tile(((const float*)(const __attribute__((address_space(1))) float*)karg(17)) + (size_t)l * D * D, D, kt * 64, nt * 64, nt * 64 + 32, (bf16_t*)(ws + O_WOUT), D, nt * 64, smem);
    return;
  }
  it -= 256;
  if (it < 1408) {
    const int kt = it & 15, nt = it >> 4;
    const int tile = nt >> 1, wn = nt & 1;
    const int hid = tile * 64 + wn * 32;
    cvt_tile(((const float*)(const __attribute__((address_space(1))) float*)karg(18)) + (size_t)l * D * GU, GU, kt * 64, hid, FH + hid, (bf16_t*)(ws + O_WGU), D, nt * 64, smem);
    return;
  }
  it -= 1408;
  {
    const int kt = it % 44, nt = it / 44;
    cvt_tile(((const float*)(const __attribute__((address_space(1))) float*)karg(19)) + (size_t)l * FH * D, D, kt * 64, nt * 64, nt * 64 + 32, (bf16_t*)(ws + O_WD), FH, nt * 64, smem);
  }
}
DI void mod_item(const Params& p, int it, unsigned char* smem) {
  float* sc = (float*)smem;
  float* red = sc + 5 * 1024;
  const int tid = tid_();
  const int l = it / 192, cb = it % 192;
  for (int i = tid; i < 5 * 1024; i += 256) {
    const int r = i >> 10, k = i & 1023;
    const float v = (r < 4) ? ((const float*)(const __attribute__((address_space(1))) float*)karg(1))[r * 1024 + k] : ((const float*)(const __attribute__((address_space(1))) float*)karg(3))[k];
    sc[i] = siluf_(v);
  }
  __syncthreads();
  const int c = tid & 31, kg = tid >> 5;
  const int col = cb * 32 + c;
  const float* w = ((const float*)(const __attribute__((address_space(1))) float*)karg(4)) + (size_t)l * D * 6144 + col;
  float a0 = 0, a1 = 0, a2 = 0, a3 = 0, a4 = 0;
#pragma unroll 8
  for (int k = kg * 128; k < kg * 128 + 128; ++k) {
    const float wv = w[(size_t)k * 6144];
    a0 += sc[k] * wv; a1 += sc[1024 + k] * wv; a2 += sc[2048 + k] * wv; a3 += sc[3072 + k] * wv; a4 += sc[4096 + k] * wv;
  }
  red[(kg * 5 + 0) * 32 + c] = a0; red[(kg * 5 + 1) * 32 + c] = a1; red[(kg * 5 + 2) * 32 + c] = a2;
  red[(kg * 5 + 3) * 32 + c] = a3; red[(kg * 5 + 4) * 32 + c] = a4;
  __syncthreads();
  if (tid < 160) {
    const int r = tid >> 5, cc = tid & 31;
    float s = 0;
#pragma unroll
    for (int g = 0; g < 8; ++g) s += red[(g * 5 + r) * 32 + cc];
    const int colo = cb * 32 + cc;
    float* modf = (float*)(((unsigned char*)(__attribute__((address_space(1))) unsigned char*)karg(21)) + O_MOD);
    modf[((size_t)l * 5 + r) * 6144 + colo] = s + ((const float*)(const __attribute__((address_space(1))) float*)karg(5))[l * 6144 + colo];
  }
  __syncthreads();
}

DI const float* xrow_ptr(const Params& p, int l, int stage, int row) {
  const int b = row / PT, q = row % PT;
  if (q < CL) {
    const size_t o = ((size_t)b * CL + q) * D;
    return (l == 0 && stage == 0) ? ((const float*)(const __attribute__((address_space(1))) float*)karg(2)) + o : (const float*)(((unsigned char*)(__attribute__((address_space(1))) unsigned char*)karg(21)) + O_XC) + o;
  }
  const size_t o = ((size_t)b * SEQ + (q - CL)) * D;
  return (l == 0 && stage == 0) ? ((const float*)(const __attribute__((address_space(1))) float*)karg(0)) + o : ((float*)(__attribute__((address_space(1))) float*)karg(20)) + o;
}
DI void norm_row(const Params& p, int l, int stage, int row, const float* __restrict__ nw, int shoff, int scoff) {
  const int lane = tid_() & 63;
  const float* xr = xrow_ptr(p, l, stage, row);
  const int b = row / PT, q = row % PT;
  const float* modf = (const float*)(((unsigned char*)(__attribute__((address_space(1))) unsigned char*)karg(21)) + O_MOD) + ((size_t)l * 5 + (q < CL ? 4 : b)) * 6144;
  float4 v[4];
  float ss = 0.f;
#pragma unroll
  for (int i = 0; i < 4; ++i) {
    v[i] = *(const float4*)(xr + i * 256 + lane * 4);
    ss += v[i].x * v[i].x + v[i].y * v[i].y + v[i].z * v[i].z + v[i].w * v[i].w;
  }
#pragma unroll
  for (int m = 1; m < 64; m <<= 1) ss += shx(ss, m);
  const float rs = rsqrtf(ss * (1.f / 1024.f) + EPS);
  bf16_t* dst = (bf16_t*)(((unsigned char*)(__attribute__((address_space(1))) unsigned char*)karg(21)) + O_UO) + (size_t)row * 1024;
#pragma unroll
  for (int i = 0; i < 4; ++i) {
    const int k = i * 256 + lane * 4;
    const float4 wv = *(const float4*)(nw + k);
    const float4 sc = *(const float4*)(modf + scoff + k);
    const float4 sh = *(const float4*)(modf + shoff + k);
    const float y0 = v[i].x * rs * wv.x * (1.f + sc.x) + sh.x;
    const float y1 = v[i].y * rs * wv.y * (1.f + sc.y) + sh.y;
    const float y2 = v[i].z * rs * wv.z * (1.f + sc.z) + sh.z;
    const float y3 = v[i].w * rs * wv.w * (1.f + sc.w) + sh.w;
    *(uint2*)(dst + k) = make_uint2(pack2(y0, y1), pack2(y2, y3));
  }
}

DI void store4T(bf16_t* base, float a, float b, float c, float d) { *(uint2*)base = make_uint2(pack2(a, b), pack2(c, d)); }

DI void inproj_epilogue(const Params& p, int l, f32x16 (&acc)[2][2], int m0w, int n0w) {
  unsigned char* ws = ((unsigned char*)(__attribute__((address_space(1))) unsigned char*)karg(21));
  const int lane = tid_() & 63, ln = lane & 31, h = lane >> 5;
  if (n0w < 2048) {
    const int dir = n0w >> 10, ch = ((n0w & 1023) >> 6) * 32 + ln;
    float lb = 0.f;
    if (l == 1) {
      const float* lbr = ((const float*)(const __attribute__((address_space(1))) float*)karg(9));
      lb = fminf(sigmoidf_(lbr[(2 + dir) * 512 + ch] - lbr[dir * 512 + ch]), 1.f - 1e-6f);
    }
    bf16_t* qd = (bf16_t*)(ws + (dir ? O_QHB : O_QHF));
    bf16_t* kd = (bf16_t*)(ws + (dir ? O_KTB : O_KTF));
    float* ebl = (float*)(ws + O_EBL) + (size_t)dir * (NT / 32) * 512;
#pragma unroll
    for (int i = 0; i < 2; ++i) {
      const int r0 = m0w + i * 32;
      float kk[16], g2[16], gs[4], gp[4];
#pragma unroll
      for (int r = 0; r < 16; ++r) {
        kk[r] = (1.f - lb) * sigmoidf_(-acc[i][1][r]);
        g2[r] = __log2f(fmaxf(1.f - kk[r], 1e-30f));
      }
#pragma unroll
      for (int rg = 0; rg < 4; ++rg) { gs[rg] = (g2[rg * 4] + g2[rg * 4 + 1]) + (g2[rg * 4 + 2] + g2[rg * 4 + 3]); gp[rg] = shx(gs[rg], 32); }
      const float total = ((gs[0] + gp[0]) + (gs[1] + gp[1])) + ((gs[2] + gp[2]) + (gs[3] + gp[3]));
      float pre = 0.f;
#pragma unroll
      for (int rg = 0; rg < 4; ++rg) {
        float run = pre + (h ? gp[rg] : 0.f);
#pragma unroll
        for (int i4 = 0; i4 < 4; ++i4) {
          const int r = rg * 4 + i4;
          run += g2[r];
          const float bj = dir ? (total - run + g2[r]) : run;
          const size_t o = (size_t)(r0 + rg * 8 + h * 4 + i4) * 512 + ch;
          qd[o] = tobf(acc[i][0][r] * 0.08838834764831845f * __builtin_amdgcn_exp2f(bj));
          kd[o] = tobf(kk[r] * __builtin_amdgcn_exp2f(fminf(-bj, 115.f)));
        }
        pre += gs[rg] + gp[rg];
      }
      if (h == 0) ebl[(size_t)(r0 >> 5) * 512 + ch] = __builtin_amdgcn_exp2f(total);
    }
    return;
  }
  if (n0w < 2560) {
    bf16_t* vt = (bf16_t*)(ws + O_VA);
#pragma unroll
    for (int i = 0; i < 2; ++i)
#pragma unroll
      for (int rg = 0; rg < 4; ++rg) {
        const int row = m0w + i * 32 + rg * 8 + h * 4;
        const int b = row / PT, q = row % PT;
#pragma unroll
        for (int j = 0; j < 2; ++j) {
          const int ch = (n0w & 511) + j * 32 + ln;
          store4T(vt + ((size_t)b * 512 + ch) * PT + q, acc[i][j][rg * 4 + 0], acc[i][j][rg * 4 + 1], acc[i][j][rg * 4 + 2], acc[i][j][rg * 4 + 3]);
        }
      }
    return;
  }
  if (n0w < 3072) {
    bf16_t* dst = (bf16_t*)(ws + O_OG);
    const int cg0 = n0w & 511;
#pragma unroll
    for (int j = 0; j < 2; ++j)
#pragma unroll
      for (int i = 0; i < 2; ++i)
#pragma unroll
        for (int r = 0; r < 16; ++r) {
          const int row = m0w + i * 32 + (r >> 2) * 8 + h * 4 + (r & 3);
          dst[(size_t)row * 512 + cg0 + j * 32 + ln] = tobf(acc[i][j][r]);
        }
    return;
  }
  n0w -= 512;
  int kind, head;
  if (n0w < 3072) { kind = 0; head = (n0w - 2560) >> 6; }
  else if (n0w < 3200) { kind = 1; head = (n0w - 3072) >> 6; }
  else if (n0w < 3328) { kind = 2; head = (n0w - 3200) >> 6; }
  else if (n0w < 3840) { kind = 3; head = (n0w - 3328) >> 6; }
  else if (n0w < 4352) { kind = 4; head = (n0w - 3840) >> 6; }
  else { kind = 5; head = (n0w - 4352) >> 6; }
  if (kind == 2 || kind == 5) {
    bf16_t* vt = (bf16_t*)(ws + (kind == 2 ? O_BVT : O_CVT));
    const int nch = (kind == 2) ? 128 : 512;
#pragma unroll
    for (int i = 0; i < 2; ++i)
#pragma unroll
      for (int rg = 0; rg < 4; ++rg) {
        const int row = m0w + i * 32 + rg * 8 + h * 4;
        const int b = row / PT, q = row % PT;
#pragma unroll
        for (int j = 0; j < 2; ++j) {
          const int ch = head * 64 + j * 32 + ln;
          store4T(vt + ((size_t)b * nch + ch) * PT + q, acc[i][j][rg * 4 + 0], acc[i][j][rg * 4 + 1], acc[i][j][rg * 4 + 2], acc[i][j][rg * 4 + 3]);
        }
      }
    return;
  }
  const float* nwp = (kind == 0 ? ((const float*)(const __attribute__((address_space(1))) float*)karg(11)) : kind == 1 ? ((const float*)(const __attribute__((address_space(1))) float*)karg(12)) : kind == 3 ? ((const float*)(const __attribute__((address_space(1))) float*)karg(13)) : ((const float*)(const __attribute__((address_space(1))) float*)karg(14))) + l * 64;
  const float nw0 = nwp[ln], nw1 = nwp[32 + ln];
  const float qscale = (kind == 0 || kind == 3) ? 0.125f * 1.4426950408889634f : 1.f;
  const bool rope = (kind <= 1);
  const float* ropet = (const float*)(ws + O_ROPE);
  bf16_t* dst; int dstride;
  if (kind == 0) { dst = (bf16_t*)(ws + O_BQ); dstride = 512; }
  else if (kind == 1) { dst = (bf16_t*)(ws + O_BK); dstride = 128; }
  else if (kind == 3) { dst = (bf16_t*)(ws + O_CQ); dstride = 512; }
  else { dst = (bf16_t*)(ws + O_CK); dstride = 512; }
#pragma unroll
  for (int i = 0; i < 2; ++i)
#pragma unroll
    for (int r = 0; r < 16; ++r) {
      const int row = m0w + i * 32 + (r >> 2) * 8 + h * 4 + (r & 3);
      float v0 = acc[i][0][r], v1 = acc[i][1][r];
      float ss = v0 * v0 + v1 * v1;
      ss += shx(ss, 1); ss += shx(ss, 2); ss += shx(ss, 4); ss += shx(ss, 8); ss += shx(ss, 16);
      const float rs = rsqrtf(ss * (1.f / 64.f) + EPS);
      v0 = v0 * rs * nw0; v1 = v1 * rs * nw1;
      if (rope) {
        const int q = row % PT;
        const float p0 = shx(v0, 1), p1 = shx(v1, 1);
        if (q >= CL) {
          const int t = q - CL, gr = t >> 6, gc = t & 63;
          const int fj = ln >> 1;
          const float2 cs0 = *(const float2*)(ropet + (gr * 16 + fj) * 2);
          const float2 cs1 = *(const float2*)(ropet + (gc * 16 + fj) * 2);
          if (ln & 1) { v0 = p0 * cs0.y + v0 * cs0.x; v1 = p1 * cs1.y + v1 * cs1.x; }
          else { v0 = v0 * cs0.x - p0 * cs0.y; v1 = v1 * cs1.x - p1 * cs1.y; }
        }
      }
      dst[(size_t)row * dstride + head * 64 + ln] = tobf(v0 * qscale);
      dst[(size_t)row * dstride + head * 64 + 32 + ln] = tobf(v1 * qscale);
    }
}

constexpr int AQS = 136, ATS = 40;
constexpr int A_QH = 0, A_KT = A_QH + 32 * AQS * 2, A_KBT = A_KT + 32 * AQS * 2, A_VT = A_KBT + 128 * ATS * 2, A_EBL = A_VT + 128 * ATS * 2;
DI bf16x8 pack8(const f32x16& x, int o) {
  return __builtin_bit_cast(bf16x8, make_uint4(pack2(x[o + 0], x[o + 1]), pack2(x[o + 2], x[o + 3]), pack2(x[o + 4], x[o + 5]), pack2(x[o + 6], x[o + 7])));
}
template <int DIR> DI int ac_tb(int c) {
  const int s = c * 32;
  return DIR == 0 ? s : (s < CL ? (CL - 32 - s) : (PT + CL - 32 - s));
}
constexpr int A_VT2 = A_EBL + 512, A_EBL2 = A_VT2 + 128 * ATS * 2;
template <int DIR> DI void a_chunk_run(unsigned char* ws, int b, int hd, unsigned char* smem) {
  const int tid = tid_(), lane = tid & 63, w = tid >> 6, ln = lane & 31, hh = lane >> 5;
  const int kc = tid >> 1, half = tid & 1;
  const int sj = tid >> 3, cg = tid & 7;
  const size_t rb = (size_t)b * PT;
  const bf16_t* qg = (const bf16_t*)(ws + (DIR ? O_QHB : O_QHF)) + (rb + sj) * 512 + hd * 128 + cg * 16;
  const bf16_t* kg = (const bf16_t*)(ws + (DIR ? O_KTB : O_KTF)) + (rb + sj) * 512 + hd * 128 + cg * 16;
  const bf16_t* vg = (const bf16_t*)(ws + O_VA) + ((size_t)b * 512 + hd * 128 + kc) * PT + half * 16;
  const float* eg = (const float*)(ws + O_EBL) + (size_t)DIR * (NT / 32) * 512 + hd * 128 + kc;
  bf16_t* og = (bf16_t*)(ws + O_UO) + rb * 1024 + DIR * 512 + hd * 128 + w * 32 + ln;
  bf16_t* Qh = (bf16_t*)(smem + A_QH); bf16_t* Kt = (bf16_t*)(smem + A_KT);
  bf16_t* KtT = (bf16_t*)(smem + A_KBT);
  f32x16 S0, S1, S2, S3;
#pragma unroll
  for (int r = 0; r < 16; ++r) { S0[r] = 0.f; S1[r] = 0.f; S2[r] = 0.f; S3[r] = 0.f; }
  uint4 q0, q1, k0, k1, v0, v1;
  float pe;
#define A_PREFETCH(cc) { const int tb_ = ac_tb<DIR>(cc); \
    q0 = *(const uint4*)(qg + (size_t)tb_ * 512); q1 = *(const uint4*)(qg + (size_t)tb_ * 512 + 8); \
    k0 = *(const uint4*)(kg + (size_t)tb_ * 512); k1 = *(const uint4*)(kg + (size_t)tb_ * 512 + 8); \
    v0 = *(const uint4*)(vg + tb_); v1 = *(const uint4*)(vg + tb_ + 8); \
    pe = eg[(size_t)((rb + tb_) >> 5) * 512]; }
  A_PREFETCH(0)
#pragma unroll 1
  for (int c = 0; c < PT / 32; ++c) {
    bf16_t* Vt = (bf16_t*)(smem + ((c & 1) ? A_VT2 : A_VT));
    float* ebl = (float*)(smem + ((c & 1) ? A_EBL2 : A_EBL));
    *(uint4*)(Qh + sj * AQS + cg * 16) = q0; *(uint4*)(Qh + sj * AQS + cg * 16 + 8) = q1;
    *(uint4*)(Kt + sj * AQS + cg * 16) = k0; *(uint4*)(Kt + sj * AQS + cg * 16 + 8) = k1;
    *(uint4*)(Vt + kc * ATS + half * 16) = v0; *(uint4*)(Vt + kc * ATS + half * 16 + 8) = v1;
    if (half == 0) ebl[kc] = pe;
    __syncthreads();
    A_PREFETCH(min(c + 1, PT / 32 - 1))
    unsigned short kt16[16];
#pragma unroll
    for (int jj = 0; jj < 16; ++jj) kt16[jj] = Kt[(half * 16 + jj) * AQS + kc];
    bf16x8 fa[8], fq[8], qi[8], vi[2], vs[2];
#pragma unroll
    for (int ks = 0; ks < 8; ++ks) {
      fa[ks] = *(const bf16x8*)(Kt + ln * AQS + ks * 16 + hh * 8);
      fq[ks] = *(const bf16x8*)(Qh + ln * AQS + ks * 16 + hh * 8);
    }
    __builtin_amdgcn_sched_barrier(0);
    f32x16 at, o;
#pragma unroll
    for (int r = 0; r < 16; ++r) { at[r] = 0.f; o[r] = 0.f; }
#pragma unroll
    for (int ks = 0; ks < 8; ++ks) at = MFMA(fa[ks], fq[ks], at);
#pragma unroll
    for (int i = 0; i < 8; ++i) {
      const s16x4 lo = *(const s16x4*)(Qh + ln * AQS + (i >> 1) * 32 + 16 * (i & 1) + 4 * hh);
      const s16x4 hi = *(const s16x4*)(Qh + ln * AQS + (i >> 1) * 32 + 16 * (i & 1) + 4 * hh + 8);
      qi[i] = __builtin_shufflevector(lo, hi, 0, 1, 2, 3, 4, 5, 6, 7);
    }
#pragma unroll
    for (int st = 0; st < 2; ++st) {
      const s16x4 lo = *(const s16x4*)(Vt + (w * 32 + ln) * ATS + 16 * st + 4 * hh);
      const s16x4 hi = *(const s16x4*)(Vt + (w * 32 + ln) * ATS + 16 * st + 4 * hh + 8);
      vi[st] = __builtin_shufflevector(lo, hi, 0, 1, 2, 3, 4, 5, 6, 7);
      vs[st] = *(const bf16x8*)(Vt + (w * 32 + ln) * ATS + st * 16 + hh * 8);
    }
    __builtin_amdgcn_sched_barrier(0);
    o = MFMA(qi[0], pack8(S0, 0), o); o = MFMA(qi[1], pack8(S0, 8), o);
    o = MFMA(qi[2], pack8(S1, 0), o); o = MFMA(qi[3], pack8(S1, 8), o);
    o = MFMA(qi[4], pack8(S2, 0), o); o = MFMA(qi[5], pack8(S2, 8), o);
    o = MFMA(qi[6], pack8(S3, 0), o); o = MFMA(qi[7], pack8(S3, 8), o);
#pragma unroll
    for (int r = 0; r < 16; ++r) {
      const int s_ = (r >> 2) * 8 + hh * 4 + (r & 3);
      at[r] = (DIR == 0 ? (s_ <= ln) : (s_ >= ln)) ? at[r] : 0.f;
    }
    o = MFMA(pack8(at, 0), vi[0], o);
    o = MFMA(pack8(at, 8), vi[1], o);
    {
      unsigned kkp[8];
#pragma unroll
      for (int i = 0; i < 8; ++i) kkp[i] = (unsigned)kt16[2 * i] | ((unsigned)kt16[2 * i + 1] << 16);
      *(uint4*)(KtT + kc * ATS + half * 16) = make_uint4(kkp[0], kkp[1], kkp[2], kkp[3]);
      *(uint4*)(KtT + kc * ATS + half * 16 + 8) = make_uint4(kkp[4], kkp[5], kkp[6], kkp[7]);
    }
    {
      bf16_t* oc = og + (size_t)ac_tb<DIR>(c) * 1024;
#pragma unroll
      for (int r = 0; r < 16; ++r) { const int t = (r >> 2) * 8 + hh * 4 + (r & 3); oc[t * 1024] = tobf(o[r]); }
    }
    __syncthreads();
    bf16x8 ka[8];
    float4 ev[16];
#pragma unroll
    for (int i = 0; i < 8; ++i) ka[i] = *(const bf16x8*)(KtT + ((i >> 1) * 32 + ln) * ATS + (i & 1) * 16 + hh * 8);
#pragma unroll
    for (int i = 0; i < 16; ++i) ev[i] = *(const float4*)(ebl + (i >> 2) * 32 + (i & 3) * 8 + hh * 4);
    __builtin_amdgcn_sched_barrier(0);
    S0 = MFMA(ka[0], vs[0], S0); S1 = MFMA(ka[2], vs[0], S1); S2 = MFMA(ka[4], vs[0], S2); S3 = MFMA(ka[6], vs[0], S3);
    S0 = MFMA(ka[1], vs[1], S0); S1 = MFMA(ka[3], vs[1], S1); S2 = MFMA(ka[5], vs[1], S2); S3 = MFMA(ka[7], vs[1], S3);
#define A_SCALE(SK, kb) { \
      _Pragma("unroll") for (int rg = 0; rg < 4; ++rg) { \
        const float4 e = ev[(kb) * 4 + rg]; \
        SK[rg * 4 + 0] *= e.x; SK[rg * 4 + 1] *= e.y; SK[rg * 4 + 2] *= e.z; SK[rg * 4 + 3] *= e.w; } }
    A_SCALE(S0, 0) A_SCALE(S1, 1) A_SCALE(S2, 2) A_SCALE(S3, 3)
  }
  __syncthreads();
}
DI void a_chunk_item(unsigned char* ws, int it, unsigned char* smem) {
  const int dir = it & 1, hd = (it >> 1) & 3, b = it >> 3;
  __builtin_amdgcn_s_setprio(2);
  if (dir == 0) a_chunk_run<0>(ws, b, hd, smem); else a_chunk_run<1>(ws, b, hd, smem);
  __builtin_amdgcn_s_setprio(0);
}

struct AttnArgs {
  float m0;
  bf16_t* q;
  const bf16_t* k; int kstride;
  const bf16_t* vt;
  int kbase_row;
  int qrow;
  int ntiles, nwin, win_p0;
  int mode;
  int gr, r0w, cb, krow0;
  const float* bias;
};
DI void attn_run(const AttnArgs& a, unsigned char* smem) {
  const int tid = tid_(), lane = tid & 63, ln = lane & 31, h = lane >> 5;
  bf16_t* sk = (bf16_t*)smem;
  bf16_t* sv = sk + 2 * 64 * LSTR;
  bf16x8 qf[4];
  {
    const bf16_t* qp = a.q + (size_t)(a.qrow + ln) * 512 + h * 8;
#pragma unroll
    for (int ks = 0; ks < 4; ++ks) qf[ks] = *(const bf16x8*)(qp + ks * 16);
  }
  f32x16 o0, o1;
#pragma unroll
  for (int r = 0; r < 16; ++r) { o0[r] = 0.f; o1[r] = 0.f; }
  float lrun = 0.f;
  const int lrow = tid >> 3, lc = (tid & 7) * 8;
  uint4 rk0, rk1, rv0, rv1;
#define TILE_P0(i) ((i) < a.nwin ? a.win_p0 + (i) * 64 : ((i) - a.nwin) * 64)
#define GLOAD(i) { const int p0_ = TILE_P0(i); \
    rk0 = *(const uint4*)(a.k + (size_t)(a.kbase_row + p0_ + lrow) * a.kstride + lc); \
    rk1 = *(const uint4*)(a.k + (size_t)(a.kbase_row + p0_ + lrow + 32) * a.kstride + lc); \
    rv0 = *(const uint4*)(a.vt + (size_t)(lrow) * PT + p0_ + lc); \
    rv1 = *(const uint4*)(a.vt + (size_t)(lrow + 32) * PT + p0_ + lc); }
#define SSTORE(buf_) { \
    *(uint4*)(sk + (buf_) * 64 * LSTR + (lrow) * LSTR + lc) = rk0; \
    *(uint4*)(sk + (buf_) * 64 * LSTR + (lrow + 32) * LSTR + lc) = rk1; \
    *(uint4*)(sv + (buf_) * 64 * LSTR + (lrow) * LSTR + lc) = rv0; \
    *(uint4*)(sv + (buf_) * 64 * LSTR + (lrow + 32) * LSTR + lc) = rv1; }
  GLOAD(0);
  SSTORE(0);
  __syncthreads();
  for (int it = 0; it < a.ntiles; ++it) {
    const int buf = it & 1;
    GLOAD(min(it + 1, a.ntiles - 1));
    asm volatile("" ::: "memory");
    __builtin_amdgcn_sched_barrier(0);
    bool active = true;
    int krow = 0;
    const bool win = (a.mode == 1 && it < a.nwin);
    if (win) { krow = a.krow0 + it; active = (krow >= a.r0w && krow < a.r0w + 8); }
    if (active) {
      const bf16_t* ks_ = sk + buf * 64 * LSTR + ln * LSTR + h * 8;
      f32x16 s0, s1;
#pragma unroll
      for (int r = 0; r < 16; ++r) { s0[r] = -a.m0; s1[r] = -a.m0; }
#pragma unroll
      for (int ks = 0; ks < 4; ++ks) {
        bf16x8 a0 = *(const bf16x8*)(ks_ + ks * 16);
        bf16x8 a1 = *(const bf16x8*)(ks_ + 32 * LSTR + ks * 16);
        s0 = MFMA(a0, qf[ks], s0);
        s1 = MFMA(a1, qf[ks], s1);
      }
      if (win) {
        const int qc = a.cb + ln;
        const int c0 = min(max(qc - 8, 0), 48);
        const float* brow = a.bias + (krow - a.gr + 7) * 31 + 15 - qc;
#pragma unroll
        for (int r = 0; r < 16; ++r) {
          const int kc0 = (r >> 2) * 8 + h * 4 + (r & 3);
          const int kc1 = kc0 + 32;
          s0[r] = (kc0 >= c0 && kc0 < c0 + 16) ? s0[r] + brow[kc0] : -1e30f;
          s1[r] = (kc1 >= c0 && kc1 < c0 + 16) ? s1[r] + brow[kc1] : -1e30f;
        }
      }
#pragma unroll
      for (int r = 0; r < 16; ++r) { s0[r] = __builtin_amdgcn_exp2f(s0[r]); lrun += s0[r]; }
#pragma unroll
      for (int r = 0; r < 16; ++r) { s1[r] = __builtin_amdgcn_exp2f(s1[r]); lrun += s1[r]; }
      const bf16_t* vs_ = sv + buf * 64 * LSTR + ln * LSTR + h * 4;
#pragma unroll
      for (int j = 0; j < 4; ++j) {
        bf16x8 pb;
        {
          unsigned u0, u1, u2, u3;
          if (j < 2) {
            const int b8 = 8 * j;
            u0 = pack2(s0[b8 + 0], s0[b8 + 1]); u1 = pack2(s0[b8 + 2], s0[b8 + 3]);
            u2 = pack2(s0[b8 + 4], s0[b8 + 5]); u3 = pack2(s0[b8 + 6], s0[b8 + 7]);
          } else {
            const int b8 = 8 * (j - 2);
            u0 = pack2(s1[b8 + 0], s1[b8 + 1]); u1 = pack2(s1[b8 + 2], s1[b8 + 3]);
            u2 = pack2(s1[b8 + 4], s1[b8 + 5]); u3 = pack2(s1[b8 + 6], s1[b8 + 7]);
          }
          pb = __builtin_bit_cast(bf16x8, make_uint4(u0, u1, u2, u3));
        }
        const s16x4 lo0 = *(const s16x4*)(vs_ + j * 16);
        const s16x4 hi0 = *(const s16x4*)(vs_ + j * 16 + 8);
        const s16x4 lo1 = *(const s16x4*)(vs_ + 32 * LSTR + j * 16);
        const s16x4 hi1 = *(const s16x4*)(vs_ + 32 * LSTR + j * 16 + 8);
        const bf16x8 av0 = __builtin_shufflevector(lo0, hi0, 0, 1, 2, 3, 4, 5, 6, 7);
        const bf16x8 av1 = __builtin_shufflevector(lo1, hi1, 0, 1, 2, 3, 4, 5, 6, 7);
        o0 = MFMA(av0, pb, o0);
        o1 = MFMA(av1, pb, o1);
      }
    }
    SSTORE(buf ^ 1);
    __syncthreads();
  }
  lrun += shx(lrun, 32);
  const float inv = 1.f / lrun;
  bf16_t* op = a.q + (size_t)(a.qrow + ln) * 512;
#pragma unroll
  for (int rg = 0; rg < 4; ++rg) {
    const int d = rg * 8 + h * 4;
    *(uint2*)(op + d) = make_uint2(pack2(o0[rg * 4 + 0] * inv, o0[rg * 4 + 1] * inv), pack2(o0[rg * 4 + 2] * inv, o0[rg * 4 + 3] * inv));
    *(uint2*)(op + 32 + d) = make_uint2(pack2(o1[rg * 4 + 0] * inv, o1[rg * 4 + 1] * inv), pack2(o1[rg * 4 + 2] * inv, o1[rg * 4 + 3] * inv));
  }
}

DI float wave_max(float v) {
#pragma unroll
  for (int m = 32; m >= 1; m >>= 1) v = fmaxf(v, shx(v, m));
  return v;
}
DI float attn_m0(int qi, int ki, int l) {
  const int lane = tid_() & 63;
  const float* qn = ((const float*)(const __attribute__((address_space(1))) float*)karg(qi)) + l * 64;
  const float* kn = ((const float*)(const __attribute__((address_space(1))) float*)karg(ki)) + l * 64;
  return 8.f * 1.4426950408889634f * 1.02f * wave_max(fabsf(qn[lane])) * wave_max(fabsf(kn[lane]));
}
constexpr int N_A = 32, N_B = 1024, N_C = 1024, N_CTX = 128;
DI void mixer_item(const Params& p, int l, int it, unsigned char* smem) {
  const int w = tid_() >> 6;
  unsigned char* ws = ((unsigned char*)(__attribute__((address_space(1))) unsigned char*)karg(21));
  if (it < N_A) { a_chunk_item(ws, it, smem); return; }
  it -= N_A;
  AttnArgs a;
  a.bias = (const float*)(smem + 4 * 64 * LSTR * 2);
  a.mode = 0; a.gr = 0; a.r0w = 0; a.cb = 0; a.krow0 = 0;
  if (it < N_B) {
    const int hd = it & 7, qb = (it >> 3) & 31, b = it >> 8;
    a.q = (bf16_t*)(ws + O_BQ) + hd * 64;
    a.k = (const bf16_t*)(ws + O_BK) + (hd >> 2) * 64; a.kstride = 128;
    a.vt = (const bf16_t*)(ws + O_BVT) + ((size_t)b * 128 + (hd >> 2) * 64) * PT;
    a.kbase_row = b * PT; a.qrow = b * PT + CL + qb * 128 + w * 32;
    a.ntiles = 68; a.nwin = 68; a.win_p0 = 0;
    a.m0 = attn_m0(11, 12, l);
    attn_run(a, smem);
    return;
  }
  it -= N_B;
  if (it < N_C) {
    const int hd = it & 7, rp = (it >> 3) & 31, b = it >> 8;
    const int g0 = 2 * rp, g1 = 2 * rp + 1;
    const int r00 = min(max(g0 - 4, 0), 56), r01 = min(max(g1 - 4, 0), 56);
    float* bt = (float*)(smem + 4 * 64 * LSTR * 2);
    for (int i = tid_(); i < 465; i += 256) bt[i] = 1.4426950408889634f * ((const float*)(const __attribute__((address_space(1))) float*)karg(15))[((size_t)l * 8 + hd) * 465 + i];
    __syncthreads();
    a.q = (bf16_t*)(ws + O_CQ) + hd * 64;
    a.k = (const bf16_t*)(ws + O_CK) + hd * 64; a.kstride = 512;
    a.vt = (const bf16_t*)(ws + O_CVT) + ((size_t)b * 512 + hd * 64) * PT;
    a.kbase_row = b * PT;
    a.gr = g0 + (w >> 1); a.cb = (w & 1) * 32; a.r0w = (w >> 1) ? r01 : r00; a.krow0 = r00;
    a.qrow = b * PT + CL + a.gr * 64 + a.cb;
    a.nwin = r01 + 8 - r00; a.ntiles = a.nwin + 4; a.win_p0 = CL + r00 * 64;
    a.mode = 1;
    {
      const int lane = tid_() & 63;
      float bm = 0.f;
#pragma unroll
      for (int i = 0; i < 8; ++i) { const int ix = lane + 64 * i; if (ix < 465) bm = fmaxf(bm, fabsf(bt[ix])); }
      a.m0 = attn_m0(13, 14, l) + wave_max(bm);
    }
    attn_run(a, smem);
    return;
  }
  it -= N_C;
  {
    const int hd = it & 7, qb = (it >> 3) & 1, b = (it >> 4) & 3, kc = it >> 6;
    if (kc == 0) {
      a.q = (bf16_t*)(ws + O_BQ) + hd * 64;
      a.k = (const bf16_t*)(ws + O_BK) + (hd >> 2) * 64; a.kstride = 128;
      a.vt = (const bf16_t*)(ws + O_BVT) + ((size_t)b * 128 + (hd >> 2) * 64) * PT;
    } else {
      a.q = (bf16_t*)(ws + O_CQ) + hd * 64;
      a.k = (const bf16_t*)(ws + O_CK) + hd * 64; a.kstride = 512;
      a.vt = (const bf16_t*)(ws + O_CVT) + ((size_t)b * 512 + hd * 64) * PT;
    }
    a.kbase_row = b * PT; a.qrow = b * PT + qb * 128 + w * 32;
    a.ntiles = 4; a.nwin = 4; a.win_p0 = 0;
    a.m0 = (kc == 0) ? attn_m0(11, 12, l) : attn_m0(13, 14, l);
    attn_run(a, smem);
  }
}

DI void readout_row(const Params& p, int l, int row) {
  const int lane = tid_() & 63;
  unsigned char* ws = ((unsigned char*)(__attribute__((address_space(1))) unsigned char*)karg(21));
  const bf16_t* uo = (const bf16_t*)(ws + O_UO) + (size_t)row * 1024;
  bf16_t* og = (bf16_t*)(ws + O_OG) + (size_t)row * 512;
  const uint4 f4 = *(const uint4*)(uo + lane * 8);
  const uint4 b4 = *(const uint4*)(uo + 512 + lane * 8);
  const uint4 g4 = *(const uint4*)(og + lane * 8);
  asm volatile("s_waitcnt vmcnt(0)" ::: "memory");
  const unsigned ff[4] = {f4.x, f4.y, f4.z, f4.w}, bb[4] = {b4.x, b4.y, b4.z, b4.w}, gg[4] = {g4.x, g4.y, g4.z, g4.w};
  float o[8];
  float ss = 0.f;
#pragma unroll
  for (int i = 0; i < 4; ++i) {
    o[2 * i] = bflo(ff[i]) + bflo(bb[i]);
    o[2 * i + 1] = bfhi(ff[i]) + bfhi(bb[i]);
    ss += o[2 * i] * o[2 * i] + o[2 * i + 1] * o[2 * i + 1];
  }
  ss += shx(ss, 1); ss += shx(ss, 2); ss += shx(ss, 4); ss += shx(ss, 8);
  const float rs = rsqrtf(ss * (1.f / 128.f) + EPS);
  const float* gn = ((const float*)(const __attribute__((address_space(1))) float*)karg(10)) + l * 128 + (lane & 15) * 8;
  unsigned outp[4];
#pragma unroll
  for (int i = 0; i < 4; ++i) {
    const float g0 = bflo(gg[i]), g1 = bfhi(gg[i]);
    outp[i] = pack2(o[2 * i] * rs * gn[2 * i] * siluf_(g0), o[2 * i + 1] * rs * gn[2 * i + 1] * siluf_(g1));
  }
  *(uint4*)(og + lane * 8) = make_uint4(outp[0], outp[1], outp[2], outp[3]);
  norm_row(p, l, 0, row, ((const float*)(const __attribute__((address_space(1))) float*)karg(6)) + l * 1024, 0, 1024);
}

DI bool xcd_tile(int seq, int bid, int nblk, int MX, int NX, int& mt, int& nt) {
  const int per = nblk >> 3, li = bid >> 3, x = bid & 7;
  const int u = li + seq * per;
  if (u >= MX * NX) return false;
  const int FM = MX >> 3, fullsz = 8 * NX;
  int mgi, r, gm;
  if (u < FM * fullsz) { mgi = u / fullsz; r = u - mgi * fullsz; gm = 8; }
  else { mgi = FM; r = u - FM * fullsz; gm = MX & 7; }
  const int ngi = r / (gm * 8), r2 = r - ngi * gm * 8;
  const int nj = r2 / gm, mi = r2 - nj * gm;
  mt = x * MX + mgi * 8 + mi;
  nt = ngi * 8 + nj;
  return true;
}
DI int mtile_row0(int l, int mt) { return l == 0 ? mt * 128 : ((mt >> 5) * PT + CL + (mt & 31) * 128); }

#ifndef SKIPM
#define SKIPM 0
#endif
#ifdef PROBE_REP
__device__ const unsigned char PSEQ[] = {0, 1, 2, PROBE_R(2) 3, 4, 5, PROBE_R(5) 6, 7, 8, PROBE_R(8) 9, 10, 11, PROBE_R(11) 12, 13, 14, PROBE_R(14) 15, 16, 17, PROBE_R(17) 18};
#else
__device__ const unsigned char PSEQ[] = {0, 1, 2, 3, 4, 5, 6, 7, 8, 9, 10, 11, 12, 13, 14, 15, 16, 17, 18};
#endif
constexpr int NSEQ = sizeof(PSEQ);
#define OPAQUE_S(x) asm volatile("" : "+s"(x))
__global__ void __launch_bounds__(256, 2) fwd_megakernel(Params p) {
  extern __shared__ __attribute__((aligned(16))) unsigned char smem[];
  __shared__ __attribute__((aligned(16))) unsigned sh_words[8];
#define s_item (((int*)sh_words)[4])
#define s_key (((int*)sh_words)[5])
  cg::grid_group grid = cg::this_grid();
  const int nblk = gridDim.x, bid = blockIdx.x;
  if (threadIdx.x == 0) { sh_words[0] = 0u; sh_words[1] = 0u; sh_words[2] = 0u; sh_words[3] = 0u; }
  __syncthreads();
  (void)xcd_barrier_post((unsigned*)(((unsigned char*)(__attribute__((address_space(1))) unsigned char*)karg(21)) + O_BAR), (volatile LAS unsigned*)sh_words);

  for (int pi = 0; pi < NSEQ; ++pi) {
    const int ph = PSEQ[pi];
    const int tid = tid_(), lane = tid & 63, w = tid >> 6, wm = w >> 1, wn = w & 1;
    unsigned char* ws = ((unsigned char*)(__attribute__((address_space(1))) unsigned char*)karg(21));
    const int l = (ph - 1) / 9, k = (ph == 0) ? -1 : (ph - 1) % 9;
    const int nmt = (l == 0) ? 136 : 128;
    if (k == -1 && !(SKIPM & 1)) {
      int* ctr = (int*)(ws + O_CTR);
      for (int i = bid * 256 + tid; i < 64 + 4 * 4096; i += nblk * 256) ctr[i] = 0;
      if (bid == 1 || nblk == 1) {
        float* ropet = (float*)(ws + O_ROPE);
        for (int i = tid; i < 1024; i += 256) {
          const int pos = i >> 4, j = i & 15;
          const float inv = exp2f(-(float)j * (13.287712379549449f / 16.f));
          const float ang = (float)pos * inv;
          ropet[i * 2] = __cosf(ang); ropet[i * 2 + 1] = __sinf(ang);
        }
      }
      for (int it = bid; it < 384 + CVT_ITEMS; it += nblk) {
        if (it < 384) mod_item(p, it, smem); else cvt_item(p, 0, it - 384, smem);
      }
    } else if (k == 0 && !(SKIPM & 2)) {
      if (l == 1) for (int it = bid; it < CVT_ITEMS; it += nblk) cvt_item(p, 1, it, smem);
      for (int row = bid * 4 + w; row < NT; row += nblk * 4) norm_row(p, l, 0, row, ((const float*)(const __attribute__((address_space(1))) float*)karg(6)) + l * 1024, 0, 1024);
    } else if (k == 1 && !(SKIPM & 4)) {
      for (int sq = 0;; ++sq) {
        int mt, nt;
        if (!xcd_tile(sq, bid, nblk, 17, 42, mt, nt)) break;
        f32x16 acc[2][2];
        zero_acc(acc);
        gemm_tile((const bf16_t*)(ws + O_UO) + (size_t)mt * 128 * 1024, 1024, (const bf16_t*)(ws + O_WIN) + (size_t)nt * 128 * 1024, 1024, 1024, acc, smem);
        inproj_epilogue(p, l, acc, mt * 128 + wm * 64, nt * 128 + wn * 64);
      }
    } else if (k == 2 && !(SKIPM & 8)) {
      int* ctr = (int*)(ws + O_CTR);
      const int nattn = N_B + N_C + (l == 0 ? N_CTX : 0);
      if (tid == 0) {
        const unsigned hw = __builtin_amdgcn_s_getreg(4 | (31 << 11));
        const unsigned xcc = __builtin_amdgcn_s_getreg(20 | (31 << 11));
        const int key = (int)(((xcc & 15u) << 8) | ((hw >> 8) & 255u));
        int* cuflag = ctr + 64 + 2 * 4096 + l * 4096 + key;
        const int r = atomicAdd(ctr + 64 + l * 4096 + key, 1);
        int item = -1;
        if (r == 0) {
          const int it = atomicAdd(ctr + l * 2 + 0, 1);
          if (it < N_A) { item = it; atomicExch(cuflag, 1); } else atomicExch(cuflag, 2);
        } else {
          for (int spin = 0; spin < (1 << 20); ++spin) {
            const int v = atomicAdd(cuflag, 0);
            if (v >= 2) break;
            __builtin_amdgcn_s_sleep(32);
          }
        }
        s_item = item; s_key = key;
      }
      __syncthreads();
      const int myitem = s_item, mykey = s_key;
      __syncthreads();
      if (myitem >= 0) {
        mixer_item(p, l, myitem, smem);
        __syncthreads();
        if (tid == 0) atomicExch(ctr + 64 + 2 * 4096 + l * 4096 + mykey, 3);
      }
      for (int pass = 0; pass < 2; ++pass) {
        const int q = 1 ^ pass;
        const int total = (q == 0) ? N_A : nattn;
        for (;;) {
          if (tid == 0) s_item = atomicAdd(ctr + l * 2 + q, 1);
          __syncthreads();
          const int it = s_item;
          __syncthreads();
          if (it >= total) break;
          mixer_item(p, l, q == 0 ? it : N_A + it, smem);
        }
      }
    } else if (k == 3 && !(SKIPM & 16)) {
      for (int i = bid * 4 + w; i < nmt * 128; i += nblk * 4) {
        const int row = (l == 0) ? i : ((i >> 12) * PT + CL + (i & 4095));
        readout_row(p, l, row);
      }
    } else if (k == 4 && !(SKIPM & 32)) {
      float4* msc = (float4*)(ws + O_CK) + (size_t)bid * 4096 + tid;
      for (int sq = 0;; ++sq) {
        int mt, nt;
        if (!xcd_tile(sq, bid, nblk, nmt >> 3, 8, mt, nt)) break;
        const int m0 = mtile_row0(l, mt), n0 = nt * 128;
#pragma unroll 1
        for (int kb = 0; kb < 3; ++kb) {
          f32x16 acc[2][2];
          zero_acc(acc);
          gemm_tile((const bf16_t*)(ws + O_UO) + (size_t)m0 * 1024, 1024, (const bf16_t*)(ws + O_WIN) + (size_t)(PW + kb * 1024 + n0) * 1024, 1024, 1024, acc, smem);
          uint4* gsc = (uint4*)(ws + O_QHF) + (size_t)bid * 2048 + tid;
#pragma unroll
          for (int i = 0; i < 2; ++i)
#pragma unroll
            for (int j = 0; j < 2; ++j) {
              unsigned g8[8];
#pragma unroll
              for (int r = 0; r < 8; ++r) g8[r] = pack2(sigmoidf_(acc[i][j][2 * r]), sigmoidf_(acc[i][j][2 * r + 1]));
              gsc[((i * 2 + j) * 2 + 0) * 256] = make_uint4(g8[0], g8[1], g8[2], g8[3]);
              gsc[((i * 2 + j) * 2 + 1) * 256] = make_uint4(g8[4], g8[5], g8[6], g8[7]);
            }
          zero_acc(acc);
          const size_t yo = (kb == 0) ? O_OG : (kb == 1 ? O_BQ : O_CQ);
          gemm_tile((const bf16_t*)(ws + yo) + (size_t)m0 * 512, 512, (const bf16_t*)(ws + O_WBR) + ((size_t)kb * 1024 + n0) * 512, 512, 512, acc, smem);
          const int h = lane >> 5, ln = lane & 31;
          int mso = 0, rowb = m0 + wm * 64 + h * 4, colb = n0 + wn * 64 + ln;
          asm volatile("" : "+v"(mso), "+v"(rowb), "+v"(colb));
#pragma unroll
          for (int i = 0; i < 2; ++i)
#pragma unroll
            for (int j = 0; j < 2; ++j) {
              const uint4 ga = gsc[mso + ((i * 2 + j) * 2 + 0) * 256], gb = gsc[mso + ((i * 2 + j) * 2 + 1) * 256];
              const unsigned g8[8] = {ga.x, ga.y, ga.z, ga.w, gb.x, gb.y, gb.z, gb.w};
#pragma unroll
              for (int rg = 0; rg < 4; ++rg) {
                float4 v;
                v.x = bflo(g8[rg * 2]) * acc[i][j][rg * 4 + 0];
                v.y = bfhi(g8[rg * 2]) * acc[i][j][rg * 4 + 1];
                v.z = bflo(g8[rg * 2 + 1]) * acc[i][j][rg * 4 + 2];
                v.w = bfhi(g8[rg * 2 + 1]) * acc[i][j][rg * 4 + 3];
                float4* sp = msc + mso + ((i * 2 + j) * 4 + rg) * 256;
                if (kb > 0) { const float4 o = *sp; v.x += o.x; v.y += o.y; v.z += o.z; v.w += o.w; }
                if (kb < 2) *sp = v;
                else {
                  bf16_t* mo = (bf16_t*)(ws + O_M);
                  const int row = rowb + i * 32 + rg * 8;
                  const int col = colb + j * 32;
                  mo[(size_t)row * 1024 + col] = tobf(v.x);
                  mo[(size_t)(row + 1) * 1024 + col] = tobf(v.y);
                  mo[(size_t)(row + 2) * 1024 + col] = tobf(v.z);
                  mo[(size_t)(row + 3) * 1024 + col] = tobf(v.w);
                }
                __builtin_amdgcn_sched_barrier(0);
              }
            }
        }
      }
    } else if (k == 5 && !(SKIPM & 64)) {
      for (int sq = 0;; ++sq) {
        int mt, nt;
        if (!xcd_tile(sq, bid, nblk, nmt >> 3, 8, mt, nt)) break;
        const int m0 = mtile_row0(l, mt), n0 = nt * 128;
        f32x16 acc[2][2];
        zero_acc(acc);
        gemm_tile((const bf16_t*)(ws + O_M) + (size_t)m0 * 1024, 1024, (const bf16_t*)(ws + O_WOUT) + (size_t)n0 * 1024, 1024, 1024, acc, smem);
        const int h = lane >> 5, ln = lane & 31;
#pragma unroll
        for (int i = 0; i < 2; ++i)
#pragma unroll
          for (int r = 0; r < 16; ++r) {
            const int row = m0 + wm * 64 + i * 32 + (r >> 2) * 8 + h * 4 + (r & 3);
            const int b = row / PT, q = row % PT;
            const float* xin = xrow_ptr(p, l, 0, row);
            float* xo = (q < CL) ? (float*)(ws + O_XC) + ((size_t)b * CL + q) * D : ((float*)(__attribute__((address_space(1))) float*)karg(20)) + ((size_t)b * SEQ + (q - CL)) * D;
            const float* modf = (const float*)(ws + O_MOD) + ((size_t)l * 5 + (q < CL ? 4 : b)) * 6144 + 2048;
#pragma unroll
            for (int j = 0; j < 2; ++j) {
              const int col = n0 + wn * 64 + j * 32 + ln;
              xo[col] = xin[col] + modf[col] * acc[i][j][r];
            }
          }
      }
    } else if (k == 6 && !(SKIPM & 128)) {
      for (int i = bid * 4 + w; i < nmt * 128; i += nblk * 4) {
        const int row = (l == 0) ? i : ((i >> 12) * PT + CL + (i & 4095));
        norm_row(p, l, 1, row, ((const float*)(const __attribute__((address_space(1))) float*)karg(7)) + l * 1024, 3072, 4096);
      }
    } else if (k == 7 && !(SKIPM & 256)) {
      for (int sq = 0;; ++sq) {
        int mt, nt;
        if (!xcd_tile(sq, bid, nblk, nmt >> 3, 44, mt, nt)) break;
        const int m0 = mtile_row0(l, mt);
        f32x16 acc[2][2];
        zero_acc(acc);
        gemm_tile((const bf16_t*)(ws + O_UO) + (size_t)m0 * 1024, 1024, (const bf16_t*)(ws + O_WGU) + (size_t)nt * 128 * 1024, 1024, 1024, acc, smem);
        bf16_t* ao = (bf16_t*)(ws + O_ACT);
        const int h = lane >> 5, ln = lane & 31;
#pragma unroll
        for (int i = 0; i < 2; ++i)
#pragma unroll
          for (int r = 0; r < 16; ++r) {
            const int row = m0 + wm * 64 + i * 32 + (r >> 2) * 8 + h * 4 + (r & 3);
            ao[(size_t)row * FH + nt * 64 + wn * 32 + ln] = tobf(siluf_(acc[i][0][r]) * acc[i][1][r]);
          }
      }
    } else if (!(SKIPM & 512)) {
      for (int sq = 0;; ++sq) {
        int mt, nt;
        if (!xcd_tile(sq, bid, nblk, nmt >> 3, 8, mt, nt)) break;
        const int m0 = mtile_row0(l, mt), n0 = nt * 128;
        f32x16 acc[2][2];
        zero_acc(acc);
        gemm_tile((const bf16_t*)(ws + O_ACT) + (size_t)m0 * FH, FH, (const bf16_t*)(ws + O_WD) + (size_t)n0 * FH, FH, FH, acc, smem);
        const int h = lane >> 5, ln = lane & 31;
#pragma unroll
        for (int i = 0; i < 2; ++i)
#pragma unroll
          for (int r = 0; r < 16; ++r) {
            const int row = m0 + wm * 64 + i * 32 + (r >> 2) * 8 + h * 4 + (r & 3);
            const int b = row / PT, q = row % PT;
            float* xo = (q < CL) ? (float*)(ws + O_XC) + ((size_t)b * CL + q) * D : ((float*)(__attribute__((address_space(1))) float*)karg(20)) + ((size_t)b * SEQ + (q - CL)) * D;
            const float* modf = (const float*)(ws + O_MOD) + ((size_t)l * 5 + (q < CL ? 4 : b)) * 6144 + 5120;
#pragma unroll
            for (int j = 0; j < 2; ++j) {
              const int col = n0 + wn * 64 + j * 32 + ln;
              xo[col] = xo[col] + modf[col] * acc[i][j][r];
            }
          }
      }
    }
    if (pi == 0) grid.sync();
    else if (pi < NSEQ - 1) {
      XcdBarrier xb; xb.bar = (unsigned*)(ws + O_BAR); xb.x = xb_xcc_id(); xb.st = (volatile LAS unsigned*)sh_words;
      xcd_barrier(xb);
    }
  }
}

extern "C" void kernel_launch(void* const* d_in, const int* in_sizes, int n_in, void* d_out, int out_size, void* d_ws, size_t ws_size,
                              hipStream_t stream) {
  static int grid_blocks = 0;
  if (grid_blocks == 0) {
    if (ws_size < WS_END) { fprintf(stderr, "kernel_launch: workspace too small: %zu < %zu\n", ws_size, (size_t)WS_END); grid_blocks = -1; return; }
    int dev = 0, cus = 0, per_cu = 0;
    hipGetDevice(&dev);
    hipDeviceGetAttribute(&cus, hipDeviceAttributeMultiprocessorCount, dev);
    hipFuncSetAttribute((const void*)fwd_megakernel, hipFuncAttributeMaxDynamicSharedMemorySize, LDS_BYTES);
    hipOccupancyMaxActiveBlocksPerMultiprocessor(&per_cu, (const void*)fwd_megakernel, 256, LDS_BYTES);
    if (per_cu < 1) { fprintf(stderr, "kernel_launch: occupancy query returned %d\n", per_cu); grid_blocks = -1; return; }
    if (per_cu > 2) per_cu = 2;
    grid_blocks = cus * per_cu;
  }
  if (grid_blocks < 0) return;
  Params p{};
  p.x = (const float*)d_in[0]; p.c = (const float*)d_in[1]; p.ctx = (const float*)d_in[2]; p.c_ctx = (const float*)d_in[3];
  p.w_mod = (const float*)d_in[4]; p.b_mod = (const float*)d_in[5]; p.norm_mix = (const float*)d_in[6]; p.norm_ffn = (const float*)d_in[7];
  p.w_in = (const float*)d_in[8]; p.lb_raw = (const float*)d_in[9]; p.gn_a = (const float*)d_in[10]; p.qn_b = (const float*)d_in[11];
  p.kn_b = (const float*)d_in[12]; p.qn_c = (const float*)d_in[13]; p.kn_c = (const float*)d_in[14]; p.rel_bias = (const float*)d_in[15];
  p.w_branch = (const float*)d_in[16]; p.w_out = (const float*)d_in[17]; p.w_gate_up = (const float*)d_in[18]; p.w_down = (const float*)d_in[19];
  p.out = (float*)d_out; p.ws = (unsigned char*)d_ws;
  if (hipMemsetAsync((unsigned char*)d_ws + O_BAR, 0, 16384, stream) != hipSuccess) { fprintf(stderr, "kernel_launch: hipMemsetAsync of the barrier words failed\n"); return; }
  void* args[] = {&p};
  hipError_t e = hipLaunchCooperativeKernel((const void*)fwd_megakernel, dim3(grid_blocks), dim3(256), args, LDS_BYTES, stream);
  if (e != hipSuccess) fprintf(stderr, "cooperative launch failed: %s (grid %d)\n", hipGetErrorString(e), grid_blocks);
}
```

```cpp
#include <hip/hip_runtime.h>
#include <hip/hip_cooperative_groups.h>
#include <cstdio>
namespace cg = cooperative_groups;

typedef short bf16x8 __attribute__((ext_vector_type(8)));
typedef short s16x4 __attribute__((ext_vector_type(4)));
typedef float f32x16 __attribute__((ext_vector_type(16)));
typedef float f32x2 __attribute__((ext_vector_type(2)));
typedef __bf16 bf16x2_t __attribute__((ext_vector_type(2)));
typedef unsigned short bf16_t;
#define DI __device__ __forceinline__
#define MFMA(a, b, c) __builtin_amdgcn_mfma_f32_32x32x16_bf16((a), (b), (c), 0, 0, 0)

constexpr int D = 1024, NB = 4, SEQ = 4096, CL = 256, PT = 4352, NT = NB * PT;
constexpr int INW = 7936, INW2 = 8448, PW = 5376, FH = 2816, GU = 5632;
constexpr float EPS = 1e-6f;

constexpr size_t SZ512 = (size_t)NT * 512 * 2;
constexpr size_t SZ128 = (size_t)NT * 128 * 2;
constexpr size_t O_WIN = 0;
constexpr size_t O_WBR = O_WIN + (size_t)INW2 * D * 2;
constexpr size_t O_WOUT = O_WBR + (size_t)3 * D * 512 * 2;
constexpr size_t O_WGU = O_WOUT + (size_t)D * D * 2;
constexpr size_t O_WD = O_WGU + (size_t)GU * D * 2;
constexpr size_t O_UO = O_WD + (size_t)D * FH * 2;
constexpr size_t O_P = O_UO + (size_t)NT * 1024 * 2;
constexpr size_t O_QHF = O_P;
constexpr size_t O_KTF = O_QHF + SZ512;
constexpr size_t O_QHB = O_KTF + SZ512;
constexpr size_t O_KTB = O_QHB + SZ512;
constexpr size_t O_VA = O_KTB + SZ512;
constexpr size_t O_OG = O_VA + SZ512;
constexpr size_t O_BQ = O_OG + SZ512;
constexpr size_t O_CQ = O_BQ + SZ512;
constexpr size_t O_CK = O_CQ + SZ512;
constexpr size_t O_CVT = O_CK + SZ512;
constexpr size_t O_BK = O_CVT + SZ512;
constexpr size_t O_BVT = O_BK + SZ128;
constexpr size_t O_EBL = O_BVT + SZ128;
constexpr size_t O_XC = O_EBL + (size_t)2 * (NT / 32) * 512 * 4;
constexpr size_t O_MOD = O_XC + (size_t)NB * CL * D * 4;
constexpr size_t O_ROPE = O_MOD + (size_t)2 * 5 * 6144 * 4;
constexpr size_t O_CTR = O_ROPE + 64 * 16 * 2 * 4;
constexpr size_t O_BAR = O_CTR + (64 + 4 * 4096) * 4;
constexpr size_t WS_END = O_BAR + 16384;
constexpr size_t O_M = O_QHB;
constexpr size_t O_ACT = O_P;

constexpr int LDS_BYTES = 73728;
constexpr int LSTR = 72;

struct Params {
  const float* x; const float* c; const float* ctx; const float* c_ctx; const float* w_mod; const float* b_mod;
  const float* norm_mix; const float* norm_ffn; const float* w_in; const float* lb_raw; const float* gn_a;
  const float* qn_b; const float* kn_b; const float* qn_c; const float* kn_c; const float* rel_bias;
  const float* w_branch; const float* w_out; const float* w_gate_up; const float* w_down;
  float* out; unsigned char* ws;
};


typedef const unsigned long long __attribute__((address_space(4))) karg_t;
DI unsigned long long karg(int i) { return *(volatile karg_t*)((karg_t*)__builtin_amdgcn_kernarg_segment_ptr() + i); }
DI int tid_() { int t = threadIdx.x; asm volatile("" : "+v"(t)); return t; }
DI unsigned pack2(float a, float b) {
  f32x2 v = {a, b};
  bf16x2_t r = __builtin_convertvector(v, bf16x2_t);
  return __builtin_bit_cast(unsigned, r);
}
DI bf16_t tobf(float a) { return (bf16_t)(pack2(a, 0.f) & 0xffffu); }
DI float bflo(unsigned u) { return __uint_as_float(u << 16); }
DI float bfhi(unsigned u) { return __uint_as_float(u & 0xffff0000u); }
DI float sigmoidf_(float x) { return __builtin_amdgcn_rcpf(1.f + __builtin_amdgcn_exp2f(-1.4426950408889634f * x)); }
DI float siluf_(float x) { return x * __builtin_amdgcn_rcpf(1.f + __builtin_amdgcn_exp2f(-1.4426950408889634f * x)); }
DI float shx(float v, int m) { return __shfl_xor(v, m); }

#define XB_TMO      128
#define XB_XCNT(j)  (256  + 64 * (j))
#define XB_XSUB(j)  (1280 + 64 * (j))
#define XB_XGEN(j)  (2304 + 64 * (j))
#define XB_TOP      3328
#define XB_TOPGEN   3392
#define XCD_BAR_WORDS 3456
#define XB_SPIN_CAP (1u << 18)
#define LAS __attribute__((address_space(3)))
DI unsigned xb_ld(unsigned* p)              { return __hip_atomic_load(p, __ATOMIC_RELAXED, __HIP_MEMORY_SCOPE_AGENT); }
DI unsigned xb_add(unsigned* p, unsigned v) { return __hip_atomic_fetch_add(p, v, __ATOMIC_RELAXED, __HIP_MEMORY_SCOPE_AGENT); }
DI unsigned xb_xcc_id() { return (unsigned)__builtin_amdgcn_s_getreg((3 << 11) | 20) & 0xFu; }
#define XB_SPIN(cond, bar) do { unsigned _sp = 0; while (cond) { __builtin_amdgcn_s_sleep(1); \
    if ((++_sp & 255u) == 0u) { if (xb_ld(&(bar)[XB_TMO])) break; if (_sp > XB_SPIN_CAP) { atomicAdd(&(bar)[XB_TMO], 1u); break; } } } } while (0)
struct XcdBarrier { unsigned* bar; unsigned x; volatile LAS unsigned* st; };
DI XcdBarrier xcd_barrier_post(unsigned* bar, volatile LAS unsigned* st) {
  XcdBarrier b; b.bar = bar; b.x = xb_xcc_id(); b.st = st;
  if (threadIdx.x == 0) (void)xb_add(&bar[XB_XCNT(b.x)], 1u);
  return b;
}
DI void xcd_barrier_complete(unsigned* bar, unsigned x, unsigned& nloc, unsigned& nx) {
  const unsigned G = gridDim.x * gridDim.y * gridDim.z;
  unsigned sum, cnt, mine, sp = 0u;
  for (;;) {
    sum = 0u; cnt = 0u; mine = 0u;
#pragma unroll
    for (unsigned j = 0; j < 16; ++j) { const unsigned c = xb_ld(&bar[XB_XCNT(j)]); sum += c; cnt += (c > 0u) ? 1u : 0u; mine = (j == x) ? c : mine; }
    if (sum == G) break;
    __builtin_amdgcn_s_sleep(1);
    if ((++sp & 255u) == 0u) { if (xb_ld(&bar[XB_TMO])) break; if (sp > XB_SPIN_CAP) { atomicAdd(&bar[XB_TMO], 1u); break; } }
  }
  nloc = mine > 0u ? mine : 1u; nx = cnt > 0u ? cnt : 1u;
}
DI void xcd_barrier(const XcdBarrier& b) {
  asm volatile("s_waitcnt vmcnt(0)" ::: "memory");
  __syncthreads();
  if (threadIdx.x == 0) {
    unsigned* bar = b.bar;
    __builtin_amdgcn_s_waitcnt(0);
    unsigned nloc = b.st[0], nx = b.st[1];
    if (nloc == 0u) { xcd_barrier_complete(bar, b.x, nloc, nx); b.st[0] = nloc; b.st[1] = nx; }
    const unsigned old = xb_add(&bar[XB_XSUB(b.x)], 1u);
    const unsigned gen = old / nloc;
    if (old + 1u == (gen + 1u) * nloc) {
      __builtin_amdgcn_fence(__ATOMIC_RELEASE, "agent");
      asm volatile("s_waitcnt vmcnt(0)" ::: "memory");
      const unsigned og = xb_add(&bar[XB_TOP], 1u);
      const unsigned tg = og / nx;
      if (og + 1u == (tg + 1u) * nx) xb_add(&bar[XB_TOPGEN], 1u);
      else XB_SPIN(xb_ld(&bar[XB_TOPGEN]) == tg, bar);
      __builtin_amdgcn_fence(__ATOMIC_ACQUIRE, "agent");
      xb_add(&bar[XB_XGEN(b.x)], 1u);
      asm volatile("s_waitcnt vmcnt(0)" ::: "memory");
    } else {
      XB_SPIN(xb_ld(&bar[XB_XGEN(b.x)]) == gen, bar);
      __builtin_amdgcn_fence(__ATOMIC_ACQUIRE, "agent");
      asm volatile("s_waitcnt vmcnt(0)" ::: "memory");
    }
  }
  __syncthreads();
}

DI void gemm_tile(const bf16_t* A, int lda, const bf16_t* Bt, int ldb, int K,
                  f32x16 (&acc)[2][2], unsigned char* smem) {
  const int tid = tid_(), lane = tid & 63, w = tid >> 6, wm = w >> 1, wn = w & 1;
  bf16_t* sa = (bf16_t*)smem;
  bf16_t* sb = sa + 2 * 128 * LSTR;
  const int lrow = tid >> 3, lkc = (tid & 7) * 8;
  const bf16_t* ga = A + (size_t)lrow * lda + lkc;
  const bf16_t* gb = Bt + (size_t)lrow * ldb + lkc;
  uint4 pa0, pa1, pa2, pa3, pb0, pb1, pb2, pb3;
  uint4 qa0, qa1, qa2, qa3, qb0, qb1, qb2, qb3;
#define GT_LOAD(S, koff) { \
    S##a0 = *(const uint4*)(ga + (koff)); S##a1 = *(const uint4*)(ga + (size_t)32 * lda + (koff)); \
    S##a2 = *(const uint4*)(ga + (size_t)64 * lda + (koff)); S##a3 = *(const uint4*)(ga + (size_t)96 * lda + (koff)); \
    S##b0 = *(const uint4*)(gb + (koff)); S##b1 = *(const uint4*)(gb + (size_t)32 * ldb + (koff)); \
    S##b2 = *(const uint4*)(gb + (size_t)64 * ldb + (koff)); S##b3 = *(const uint4*)(gb + (size_t)96 * ldb + (koff)); \
    asm volatile("" ::: "memory"); __builtin_amdgcn_sched_barrier(0); }
#define GT_STORE(S, bufi) { \
    bf16_t* da_ = sa + (bufi) * 128 * LSTR + lrow * LSTR + lkc; bf16_t* db_ = sb + (bufi) * 128 * LSTR + lrow * LSTR + lkc; \
    *(uint4*)(da_) = S##a0; *(uint4*)(da_ + 32 * LSTR) = S##a1; *(uint4*)(da_ + 64 * LSTR) = S##a2; *(uint4*)(da_ + 96 * LSTR) = S##a3; \
    *(uint4*)(db_) = S##b0; *(uint4*)(db_ + 32 * LSTR) = S##b1; *(uint4*)(db_ + 64 * LSTR) = S##b2; *(uint4*)(db_ + 96 * LSTR) = S##b3; }
#define GT_FRAGS(F0, F1, G0, G1, KS) \
    F0 = *(const bf16x8*)(as + (KS) * 16); F1 = *(const bf16x8*)(as + 32 * LSTR + (KS) * 16); \
    G0 = *(const bf16x8*)(bs + (KS) * 16); G1 = *(const bf16x8*)(bs + 32 * LSTR + (KS) * 16);
#define GEMM_STEP(A0, A1, B0, B1, PRE, ST0, ST1) \
    PRE \
    acc[0][0] = MFMA(A0, B0, acc[0][0]); acc[0][1] = MFMA(A0, B1, acc[0][1]); \
    ST0; ST1; \
    acc[1][0] = MFMA(A1, B0, acc[1][0]); acc[1][1] = MFMA(A1, B1, acc[1][1]); \
    __builtin_amdgcn_sched_barrier(0);
#define GT_COMPUTE(bufi, S, sbuf) { \
    const bf16_t* as = sa + (bufi) * 128 * LSTR + wm * 64 * LSTR + fo; \
    const bf16_t* bs = sb + (bufi) * 128 * LSTR + wn * 64 * LSTR + fo; \
    bf16_t* da_ = sa + (sbuf) * 128 * LSTR + lrow * LSTR + lkc; bf16_t* db_ = sb + (sbuf) * 128 * LSTR + lrow * LSTR + lkc; \
    bf16x8 a0, a1, b0, b1, c0, c1, d0, d1, e0, e1, f0, f1; \
    GT_FRAGS(a0, a1, b0, b1, 0) GT_FRAGS(c0, c1, d0, d1, 1) \
    GEMM_STEP(a0, a1, b0, b1, GT_FRAGS(e0, e1, f0, f1, 2), *(uint4*)(da_) = S##a0, *(uint4*)(db_) = S##b0) \
    GEMM_STEP(c0, c1, d0, d1, GT_FRAGS(a0, a1, b0, b1, 3), *(uint4*)(da_ + 32 * LSTR) = S##a1, *(uint4*)(db_ + 32 * LSTR) = S##b1) \
    GEMM_STEP(e0, e1, f0, f1, , *(uint4*)(da_ + 64 * LSTR) = S##a2, *(uint4*)(db_ + 64 * LSTR) = S##b2) \
    GEMM_STEP(a0, a1, b0, b1, , *(uint4*)(da_ + 96 * LSTR) = S##a3, *(uint4*)(db_ + 96 * LSTR) = S##b3) }
  const int nk = K >> 6;
  const int fo = (lane & 31) * LSTR + (lane >> 5) * 8;
  GT_LOAD(p, 0)
  GT_LOAD(q, 64)
  GT_STORE(p, 0)
  __syncthreads();
  for (int kt = 0; kt < nk; kt += 2) {
    GT_LOAD(p, min(kt + 2, nk - 1) * 64)
    GT_COMPUTE(0, q, 1)
    __syncthreads();
    GT_LOAD(q, min(kt + 3, nk - 1) * 64)
    GT_COMPUTE(1, p, 0)
    __syncthreads();
  }
}
DI void zero_acc(f32x16 (&acc)[2][2]) {
#pragma unroll
  for (int i = 0; i < 2; ++i)
#pragma unroll
    for (int j = 0; j < 2; ++j)
#pragma unroll
      for (int r = 0; r < 16; ++r) acc[i][j][r] = 0.f;
}

DI void cvt_tile(const float* __restrict__ src, int ldsrc, int k0, int scol0a, int scol0b, bf16_t* __restrict__ dst, int K, int n0,
                 unsigned char* smem) {
  float* t = (float*)smem;
  const int tid = tid_();
  {
    const int kk = tid >> 4, c4 = (tid & 15) * 4;
    const int sc = (c4 < 32) ? (scol0a + c4) : (scol0b + c4 - 32);
#pragma unroll
    for (int i = 0; i < 4; ++i) {
      const int k = kk + i * 16;
      float4 v = *(const float4*)(src + (size_t)(k0 + k) * ldsrc + sc);
      t[k * 65 + c4 + 0] = v.x; t[k * 65 + c4 + 1] = v.y; t[k * 65 + c4 + 2] = v.z; t[k * 65 + c4 + 3] = v.w;
    }
  }
  __syncthreads();
  {
    const int n = tid >> 2, kq = (tid & 3) * 16;
    unsigned o[8];
#pragma unroll
    for (int j = 0; j < 8; ++j) o[j] = pack2(t[(kq + 2 * j) * 65 + n], t[(kq + 2 * j + 1) * 65 + n]);
    bf16_t* d = dst + (size_t)(n0 + n) * K + k0 + kq;
    *(uint4*)d = make_uint4(o[0], o[1], o[2], o[3]);
    *(uint4*)(d + 8) = make_uint4(o[4], o[5], o[6], o[7]);
  }
  __syncthreads();
}
constexpr int CVT_ITEMS = 2112 + 384 + 256 + 1408 + 704;
DI void cvt_item(const Params& p, int l, int it, unsigned char* smem) {
  unsigned char* ws = ((unsigned char*)(__attribute__((address_space(1))) unsigned char*)karg(21));
  if (it < 2112) {
    const int kt = it & 15, nt = it >> 4;
    int ca, cb;
    if (nt < 16) { ca = 32 * nt; cb = 512 + 32 * nt; }
    else if (nt < 32) { ca = 32 * (nt - 16); cb = 1024 + 32 * (nt - 16); }
    else { ca = 64 * (nt - 32) + 1536; cb = ca + 32; }
    cvt_tile(((const float*)(const __attribute__((address_space(1))) float*)karg(8)) + (size_t)l * D * INW, INW, kt * 64, ca, cb, (bf16_t*)(ws + O_WIN), D, nt * 64, smem);
    return;
  }
  it -= 2112;
  if (it < 384) {
    const int kb = it / 128, r = it % 128, kt = r & 7, nt = r >> 3;
    cvt_tile(((const float*)(const __attribute__((address_space(1))) float*)karg(16)) + ((size_t)l * 3 + kb) * 512 * D, D, kt * 64, nt * 64, nt * 64 + 32, (bf16_t*)(ws + O_WBR) + (size_t)kb * D * 512, 512, nt * 64, smem);
    return;
  }
  it -= 384;
  if (it < 256) {
    const int kt = it & 15, nt = it >> 4;
    cvt_tile(((const float*)(const __attribute__((address_space(1))) float*)karg(17)) + (size_t)l * D * D, D, kt * 64, nt * 64, nt * 64 + 32, (bf16_t*)(ws + O_WOUT), D, nt * 64, smem);
    return;
  }
  it -= 256;
  if (it < 1408) {
    const int kt = it & 15, nt = it >> 4;
    const int tile = nt >> 1, wn = nt & 1;
    const int hid = tile * 64 + wn * 32;
    cvt_tile(((const float*)(const __attribute__((address_space(1))) float*)karg(18)) + (size_t)l * D * GU, GU, kt * 64, hid, FH + hid, (bf16_t*)(ws + O_WGU), D, nt * 64, smem);
    return;
  }
  it -= 1408;
  {
    const int kt = it % 44, nt = it / 44;
    cvt_tile(((const float*)(const __attribute__((address_space(1))) float*)karg(19)) + (size_t)l * FH * D, D, kt * 64, nt * 64, nt * 64 + 32, (bf16_t*)(ws + O_WD), FH, nt * 64, smem);
  }
}
DI void mod_item(const Params& p, int it, unsigned char* smem) {
  float* sc = (float*)smem;
  float* red = sc + 5 * 1024;
  const int tid = tid_();
  const int l = it / 192, cb = it % 192;
  for (int i = tid; i < 5 * 1024; i += 256) {
    const int r = i >> 10, k = i & 1023;
    const float v = (r < 4) ? ((const float*)(const __attribute__((address_space(1))) float*)karg(1))[r * 1024 + k] : ((const float*)(const __attribute__((address_space(1))) float*)karg(3))[k];
    sc[i] = siluf_(v);
  }
  __syncthreads();
  const int c = tid & 31, kg = tid >> 5;
  const int col = cb * 32 + c;
  const float* w = ((const float*)(const __attribute__((address_space(1))) float*)karg(4)) + (size_t)l * D * 6144 + col;
  float a0 = 0, a1 = 0, a2 = 0, a3 = 0, a4 = 0;
#pragma unroll 8
  for (int k = kg * 128; k < kg * 128 + 128; ++k) {
    const float wv = w[(size_t)k * 6144];
    a0 += sc[k] * wv; a1 += sc[1024 + k] * wv; a2 += sc[2048 + k] * wv; a3 += sc[3072 + k] * wv; a4 += sc[4096 + k] * wv;
  }
  red[(kg * 5 + 0) * 32 + c] = a0; red[(kg * 5 + 1) * 32 + c] = a1; red[(kg * 5 + 2) * 32 + c] = a2;
  red[(kg * 5 + 3) * 32 + c] = a3; red[(kg * 5 + 4) * 32 + c] = a4;
  __syncthreads();
  if (tid < 160) {
    const int r = tid >> 5, cc = tid & 31;
    float s = 0;
#pragma unroll
    for (int g = 0; g < 8; ++g) s += red[(g * 5 + r) * 32 + cc];
    const int colo = cb * 32 + cc;
    float* modf = (float*)(((unsigned char*)(__attribute__((address_space(1))) unsigned char*)karg(21)) + O_MOD);
    modf[((size_t)l * 5 + r) * 6144 + colo] = s + ((const float*)(const __attribute__((address_space(1))) float*)karg(5))[l * 6144 + colo];
  }
  __syncthreads();
}

DI const float* xrow_ptr(const Params& p, int l, int stage, int row) {
  const int b = row / PT, q = row % PT;
  if (q < CL) {
    const size_t o = ((size_t)b * CL + q) * D;
    return (l == 0 && stage == 0) ? ((const float*)(const __attribute__((address_space(1))) float*)karg(2)) + o : (const float*)(((unsigned char*)(__attribute__((address_space(1))) unsigned char*)karg(21)) + O_XC) + o;
  }
  const size_t o = ((size_t)b * SEQ + (q - CL)) * D;
  return (l == 0 && stage == 0) ? ((const float*)(const __attribute__((address_space(1))) float*)karg(0)) + o : ((float*)(__attribute__((address_space(1))) float*)karg(20)) + o;
}
DI void norm_row(const Params& p, int l, int stage, int row, const float* __restrict__ nw, int shoff, int scoff) {
  const int lane = tid_() & 63;
  const float* xr = xrow_ptr(p, l, stage, row);
  const int b = row / PT, q = row % PT;
  const float* modf = (const float*)(((unsigned char*)(__attribute__((address_space(1))) unsigned char*)karg(21)) + O_MOD) + ((size_t)l * 5 + (q < CL ? 4 : b)) * 6144;
  float4 v[4];
  float ss = 0.f;
#pragma unroll
  for (int i = 0; i < 4; ++i) {
    v[i] = *(const float4*)(xr + i * 256 + lane * 4);
    ss += v[i].x * v[i].x + v[i].y * v[i].y + v[i].z * v[i].z + v[i].w * v[i].w;
  }
#pragma unroll
  for (int m = 1; m < 64; m <<= 1) ss += shx(ss, m);
  const float rs = rsqrtf(ss * (1.f / 1024.f) + EPS);
  bf16_t* dst = (bf16_t*)(((unsigned char*)(__attribute__((address_space(1))) unsigned char*)karg(21)) + O_UO) + (size_t)row * 1024;
#pragma unroll
  for (int i = 0; i < 4; ++i) {
    const int k = i * 256 + lane * 4;
    const float4 wv = *(const float4*)(nw + k);
    const float4 sc = *(const float4*)(modf + scoff + k);
    const float4 sh = *(const float4*)(modf + shoff + k);
    const float y0 = v[i].x * rs * wv.x * (1.f + sc.x) + sh.x;
    const float y1 = v[i].y * rs * wv.y * (1.f + sc.y) + sh.y;
    const float y2 = v[i].z * rs * wv.z * (1.f + sc.z) + sh.z;
    const float y3 = v[i].w * rs * wv.w * (1.f + sc.w) + sh.w;
    *(uint2*)(dst + k) = make_uint2(pack2(y0, y1), pack2(y2, y3));
  }
}

DI void store4T(bf16_t* base, float a, float b, float c, float d) { *(uint2*)base = make_uint2(pack2(a, b), pack2(c, d)); }

DI void inproj_epilogue(const Params& p, int l, f32x16 (&acc)[2][2], int m0w, int n0w) {
  unsigned char* ws = ((unsigned char*)(__attribute__((address_space(1))) unsigned char*)karg(21));
  const int lane = tid_() & 63, ln = lane & 31, h = lane >> 5;
  if (n0w < 2048) {
    const int dir = n0w >> 10, ch = ((n0w & 1023) >> 6) * 32 + ln;
    float lb = 0.f;
    if (l == 1) {
      const float* lbr = ((const float*)(const __attribute__((address_space(1))) float*)karg(9));
      lb = fminf(sigmoidf_(lbr[(2 + dir) * 512 + ch] - lbr[dir * 512 + ch]), 1.f - 1e-6f);
    }
    bf16_t* qd = (bf16_t*)(ws + (dir ? O_QHB : O_QHF));
    bf16_t* kd = (bf16_t*)(ws + (dir ? O_KTB : O_KTF));
    float* ebl = (float*)(ws + O_EBL) + (size_t)dir * (NT / 32) * 512;
#pragma unroll
    for (int i = 0; i < 2; ++i) {
      const int r0 = m0w + i * 32;
      float kk[16], g2[16], gs[4], gp[4];
#pragma unroll
      for (int r = 0; r < 16; ++r) {
        kk[r] = (1.f - lb) * sigmoidf_(-acc[i][1][r]);
        g2[r] = __log2f(fmaxf(1.f - kk[r], 1e-30f));
      }
#pragma unroll
      for (int rg = 0; rg < 4; ++rg) { gs[rg] = (g2[rg * 4] + g2[rg * 4 + 1]) + (g2[rg * 4 + 2] + g2[rg * 4 + 3]); gp[rg] = shx(gs[rg], 32); }
      const float total = ((gs[0] + gp[0]) + (gs[1] + gp[1])) + ((gs[2] + gp[2]) + (gs[3] + gp[3]));
      float pre = 0.f;
#pragma unroll
      for (int rg = 0; rg < 4; ++rg) {
        float run = pre + (h ? gp[rg] : 0.f);
#pragma unroll
        for (int i4 = 0; i4 < 4; ++i4) {
          const int r = rg * 4 + i4;
          run += g2[r];
          const float bj = dir ? (total - run + g2[r]) : run;
          const size_t o = (size_t)(r0 + rg * 8 + h * 4 + i4) * 512 + ch;
          qd[o] = tobf(acc[i][0][r] * 0.08838834764831845f * __builtin_amdgcn_exp2f(bj));
          kd[o] = tobf(kk[r] * __builtin_amdgcn_exp2f(fminf(-bj, 115.f)));
        }
        pre += gs[rg] + gp[rg];
      }
      if (h == 0) ebl[(size_t)(r0 >> 5) * 512 + ch] = __builtin_amdgcn_exp2f(total);
    }
    return;
  }
  if (n0w < 2560) {
    bf16_t* vt = (bf16_t*)(ws + O_VA);
#pragma unroll
    for (int i = 0; i < 2; ++i)
#pragma unroll
      for (int rg = 0; rg < 4; ++rg) {
        const int row = m0w + i * 32 + rg * 8 + h * 4;
        const int b = row / PT, q = row % PT;
#pragma unroll
        for (int j = 0; j < 2; ++j) {
          const int ch = (n0w & 511) + j * 32 + ln;
          store4T(vt + ((size_t)b * 512 + ch) * PT + q, acc[i][j][rg * 4 + 0], acc[i][j][rg * 4 + 1], acc[i][j][rg * 4 + 2], acc[i][j][rg * 4 + 3]);
        }
      }
    return;
  }
  if (n0w < 3072) {
    bf16_t* dst = (bf16_t*)(ws + O_OG);
    const int cg0 = n0w & 511;
#pragma unroll
    for (int j = 0; j < 2; ++j)
#pragma unroll
      for (int i = 0; i < 2; ++i)
#pragma unroll
        for (int r = 0; r < 16; ++r) {
          const int row = m0w + i * 32 + (r >> 2) * 8 + h * 4 + (r & 3);
          dst[(size_t)row * 512 + cg0 + j * 32 + ln] = tobf(acc[i][j][r]);
        }
    return;
  }
  n0w -= 512;
  int kind, head;
  if (n0w < 3072) { kind = 0; head = (n0w - 2560) >> 6; }
  else if (n0w < 3200) { kind = 1; head = (n0w - 3072) >> 6; }
  else if (n0w < 3328) { kind = 2; head = (n0w - 3200) >> 6; }
  else if (n0w < 3840) { kind = 3; head = (n0w - 3328) >> 6; }
  else if (n0w < 4352) { kind = 4; head = (n0w - 3840) >> 6; }
  else { kind = 5; head = (n0w - 4352) >> 6; }
  if (kind == 2 || kind == 5) {
    bf16_t* vt = (bf16_t*)(ws + (kind == 2 ? O_BVT : O_CVT));
    const int nch = (kind == 2) ? 128 : 512;
#pragma unroll
    for (int i = 0; i < 2; ++i)
#pragma unroll
      for (int rg = 0; rg < 4; ++rg) {
        const int row = m0w + i * 32 + rg * 8 + h * 4;
        const int b = row / PT, q = row % PT;
#pragma unroll
        for (int j = 0; j < 2; ++j) {
          const int ch = head * 64 + j * 32 + ln;
          store4T(vt + ((size_t)b * nch + ch) * PT + q, acc[i][j][rg * 4 + 0], acc[i][j][rg * 4 + 1], acc[i][j][rg * 4 + 2], acc[i][j][rg * 4 + 3]);
        }
      }
    return;
  }
  const float* nwp = (kind == 0 ? ((const float*)(const __attribute__((address_space(1))) float*)karg(11)) : kind == 1 ? ((const float*)(const __attribute__((address_space(1))) float*)karg(12)) : kind == 3 ? ((const float*)(const __attribute__((address_space(1))) float*)karg(13)) : ((const float*)(const __attribute__((address_space(1))) float*)karg(14))) + l * 64;
  const float nw0 = nwp[ln], nw1 = nwp[32 + ln];
  const float qscale = (kind == 0 || kind == 3) ? 0.125f * 1.4426950408889634f : 1.f;
  const bool rope = (kind <= 1);
  const float* ropet = (const float*)(ws + O_ROPE);
  bf16_t* dst; int dstride;
  if (kind == 0) { dst = (bf16_t*)(ws + O_BQ); dstride = 512; }
  else if (kind == 1) { dst = (bf16_t*)(ws + O_BK); dstride = 128; }
  else if (kind == 3) { dst = (bf16_t*)(ws + O_CQ); dstride = 512; }
  else { dst = (bf16_t*)(ws + O_CK); dstride = 512; }
#pragma unroll
  for (int i = 0; i < 2; ++i)
#pragma unroll
    for (int r = 0; r < 16; ++r) {
      const int row = m0w + i * 32 + (r >> 2) * 8 + h * 4 + (r & 3);
      float v0 = acc[i][0][r], v1 = acc[i][1][r];
      float ss = v0 * v0 + v1 * v1;
      ss += shx(ss, 1); ss += shx(ss, 2); ss += shx(ss, 4); ss += shx(ss, 8); ss += shx(ss, 16);
      const float rs = rsqrtf(ss * (1.f / 64.f) + EPS);
      v0 = v0 * rs * nw0; v1 = v1 * rs * nw1;
      if (rope) {
        const int q = row % PT;
        const float p0 = shx(v0, 1), p1 = shx(v1, 1);
        if (q >= CL) {
          const int t = q - CL, gr = t >> 6, gc = t & 63;
          const int fj = ln >> 1;
          const float2 cs0 = *(const float2*)(ropet + (gr * 16 + fj) * 2);
          const float2 cs1 = *(const float2*)(ropet + (gc * 16 + fj) * 2);
          if (ln & 1) { v0 = p0 * cs0.y + v0 * cs0.x; v1 = p1 * cs1.y + v1 * cs1.x; }
          else { v0 = v0 * cs0.x - p0 * cs0.y; v1 = v1 * cs1.x - p1 * cs1.y; }
        }
      }
      dst[(size_t)row * dstride + head * 64 + ln] = tobf(v0 * qscale);
      dst[(size_t)row * dstride + head * 64 + 32 + ln] = tobf(v1 * qscale);
    }
}

constexpr int AQS = 136, ATS = 40;
constexpr int A_QH = 0, A_KT = A_QH + 32 * AQS * 2, A_KBT = A_KT + 32 * AQS * 2, A_VT = A_KBT + 128 * ATS * 2, A_EBL = A_VT + 128 * ATS * 2;
DI bf16x8 pack8(const f32x16& x, int o) {
  return __builtin_bit_cast(bf16x8, make_uint4(pack2(x[o + 0], x[o + 1]), pack2(x[o + 2], x[o + 3]), pack2(x[o + 4], x[o + 5]), pack2(x[o + 6], x[o + 7])));
}
template <int DIR> DI int ac_tb(int c) {
  const int s = c * 32;
  return DIR == 0 ? s : (s < CL ? (CL - 32 - s) : (PT + CL - 32 - s));
}
constexpr int A_VT2 = A_EBL + 512, A_EBL2 = A_VT2 + 128 * ATS * 2;
template <int DIR> DI void a_chunk_run(unsigned char* ws, int b, int hd, unsigned char* smem) {
  const int tid = tid_(), lane = tid & 63, w = tid >> 6, ln = lane & 31, hh = lane >> 5;
  const int kc = tid >> 1, half = tid & 1;
  const int sj = tid >> 3, cg = tid & 7;
  const size_t rb = (size_t)b * PT;
  const bf16_t* qg = (const bf16_t*)(ws + (DIR ? O_QHB : O_QHF)) + (rb + sj) * 512 + hd * 128 + cg * 16;
  const bf16_t* kg = (const bf16_t*)(ws + (DIR ? O_KTB : O_KTF)) + (rb + sj) * 512 + hd * 128 + cg * 16;
  const bf16_t* vg = (const bf16_t*)(ws + O_VA) + ((size_t)b * 512 + hd * 128 + kc) * PT + half * 16;
  const float* eg = (const float*)(ws + O_EBL) + (size_t)DIR * (NT / 32) * 512 + hd * 128 + kc;
  bf16_t* og = (bf16_t*)(ws + O_UO) + rb * 1024 + DIR * 512 + hd * 128 + w * 32 + ln;
  bf16_t* Qh = (bf16_t*)(smem + A_QH); bf16_t* Kt = (bf16_t*)(smem + A_KT);
  bf16_t* KtT = (bf16_t*)(smem + A_KBT);
  f32x16 S0, S1, S2, S3;
#pragma unroll
  for (int r = 0; r < 16; ++r) { S0[r] = 0.f; S1[r] = 0.f; S2[r] = 0.f; S3[r] = 0.f; }
  uint4 q0, q1, k0, k1, v0, v1;
  float pe;
#define A_PREFETCH(cc) { const int tb_ = ac_tb<DIR>(cc); \
    q0 = *(const uint4*)(qg + (size_t)tb_ * 512); q1 = *(const uint4*)(qg + (size_t)tb_ * 512 + 8); \
    k0 = *(const uint4*)(kg + (size_t)tb_ * 512); k1 = *(const uint4*)(kg + (size_t)tb_ * 512 + 8); \
    v0 = *(const uint4*)(vg + tb_); v1 = *(const uint4*)(vg + tb_ + 8); \
    pe = eg[(size_t)((rb + tb_) >> 5) * 512]; }
  A_PREFETCH(0)
#pragma unroll 1
  for (int c = 0; c < PT / 32; ++c) {
    bf16_t* Vt = (bf16_t*)(smem + ((c & 1) ? A_VT2 : A_VT));
    float* ebl = (float*)(smem + ((c & 1) ? A_EBL2 : A_EBL));
    *(uint4*)(Qh + sj * AQS + cg * 16) = q0; *(uint4*)(Qh + sj * AQS + cg * 16 + 8) = q1;
    *(uint4*)(Kt + sj * AQS + cg * 16) = k0; *(uint4*)(Kt + sj * AQS + cg * 16 + 8) = k1;
    *(uint4*)(Vt + kc * ATS + half * 16) = v0; *(uint4*)(Vt + kc * ATS + half * 16 + 8) = v1;
    if (half == 0) ebl[kc] = pe;
    __syncthreads();
    A_PREFETCH(min(c + 1, PT / 32 - 1))
    unsigned short kt16[16];
#pragma unroll
    for (int jj = 0; jj < 16; ++jj) kt16[jj] = Kt[(half * 16 + jj) * AQS + kc];
    bf16x8 fa[8], fq[8], qi[8], vi[2], vs[2];
#pragma unroll
    for (int ks = 0; ks < 8; ++ks) {
      fa[ks] = *(const bf16x8*)(Kt + ln * AQS + ks * 16 + hh * 8);
      fq[ks] = *(const bf16x8*)(Qh + ln * AQS + ks * 16 + hh * 8);
    }
    __builtin_amdgcn_sched_barrier(0);
    f32x16 at, o;
#pragma unroll
    for (int r = 0; r < 16; ++r) { at[r] = 0.f; o[r] = 0.f; }
#pragma unroll
    for (int ks = 0; ks < 8; ++ks) at = MFMA(fa[ks], fq[ks], at);
#pragma unroll
    for (int i = 0; i < 8; ++i) {
      const s16x4 lo = *(const s16x4*)(Qh + ln * AQS + (i >> 1) * 32 + 16 * (i & 1) + 4 * hh);
      const s16x4 hi = *(const s16x4*)(Qh + ln * AQS + (i >> 1) * 32 + 16 * (i & 1) + 4 * hh + 8);
      qi[i] = __builtin_shufflevector(lo, hi, 0, 1, 2, 3, 4, 5, 6, 7);
    }
#pragma unroll
    for (int st = 0; st < 2; ++st) {
      const s16x4 lo = *(const s16x4*)(Vt + (w * 32 + ln) * ATS + 16 * st + 4 * hh);
      const s16x4 hi = *(const s16x4*)(Vt + (w * 32 + ln) * ATS + 16 * st + 4 * hh + 8);
      vi[st] = __builtin_shufflevector(lo, hi, 0, 1, 2, 3, 4, 5, 6, 7);
      vs[st] = *(const bf16x8*)(Vt + (w * 32 + ln) * ATS + st * 16 + hh * 8);
    }
    __builtin_amdgcn_sched_barrier(0);
    o = MFMA(qi[0], pack8(S0, 0), o); o = MFMA(qi[1], pack8(S0, 8), o);
    o = MFMA(qi[2], pack8(S1, 0), o); o = MFMA(qi[3], pack8(S1, 8), o);
    o = MFMA(qi[4], pack8(S2, 0), o); o = MFMA(qi[5], pack8(S2, 8), o);
    o = MFMA(qi[6], pack8(S3, 0), o); o = MFMA(qi[7], pack8(S3, 8), o);
#pragma unroll
    for (int r = 0; r < 16; ++r) {
      const int s_ = (r >> 2) * 8 + hh * 4 + (r & 3);
      at[r] = (DIR == 0 ? (s_ <= ln) : (s_ >= ln)) ? at[r] : 0.f;
    }
    o = MFMA(pack8(at, 0), vi[0], o);
    o = MFMA(pack8(at, 8), vi[1], o);
    {
      unsigned kkp[8];
#pragma unroll
      for (int i = 0; i < 8; ++i) kkp[i] = (unsigned)kt16[2 * i] | ((unsigned)kt16[2 * i + 1] << 16);
      *(uint4*)(KtT + kc * ATS + half * 16) = make_uint4(kkp[0], kkp[1], kkp[2], kkp[3]);
      *(uint4*)(KtT + kc * ATS + half * 16 + 8) = make_uint4(kkp[4], kkp[5], kkp[6], kkp[7]);
    }
    {
      bf16_t* oc = og + (size_t)ac_tb<DIR>(c) * 1024;
#pragma unroll
      for (int r = 0; r < 16; ++r) { const int t = (r >> 2) * 8 + hh * 4 + (r & 3); oc[t * 1024] = tobf(o[r]); }
    }
    __syncthreads();
    bf16x8 ka[8];
    float4 ev[16];
#pragma unroll
    for (int i = 0; i < 8; ++i) ka[i] = *(const bf16x8*)(KtT + ((i >> 1) * 32 + ln) * ATS + (i & 1) * 16 + hh * 8);
#pragma unroll
    for (int i = 0; i < 16; ++i) ev[i] = *(const float4*)(ebl + (i >> 2) * 32 + (i & 3) * 8 + hh * 4);
    __builtin_amdgcn_sched_barrier(0);
    S0 = MFMA(ka[0], vs[0], S0); S1 = MFMA(ka[2], vs[0], S1); S2 = MFMA(ka[4], vs[0], S2); S3 = MFMA(ka[6], vs[0], S3);
    S0 = MFMA(ka[1], vs[1], S0); S1 = MFMA(ka[3], vs[1], S1); S2 = MFMA(ka[5], vs[1], S2); S3 = MFMA(ka[7], vs[1], S3);
#define A_SCALE(SK, kb) { \
      _Pragma("unroll") for (int rg = 0; rg < 4; ++rg) { \
        const float4 e = ev[(kb) * 4 + rg]; \
        SK[rg * 4 + 0] *= e.x; SK[rg * 4 + 1] *= e.y; SK[rg * 4 + 2] *= e.z; SK[rg * 4 + 3] *= e.w; } }
    A_SCALE(S0, 0) A_SCALE(S1, 1) A_SCALE(S2, 2) A_SCALE(S3, 3)
  }
  __syncthreads();
}
DI void a_chunk_item(unsigned char* ws, int it, unsigned char* smem) {
  const int dir = it & 1, hd = (it >> 1) & 3, b = it >> 3;
  __builtin_amdgcn_s_setprio(2);
  if (dir == 0) a_chunk_run<0>(ws, b, hd, smem); else a_chunk_run<1>(ws, b, hd, smem);
  __builtin_amdgcn_s_setprio(0);
}

struct AttnArgs {
  float m0;
  bf16_t* q;
  const bf16_t* k; int kstride;
  const bf16_t* vt;
  int kbase_row;
  int qrow;
  int ntiles, nwin, win_p0;
  int mode;
  int gr, r0w, cb, krow0;
  const float* bias;
};
DI void attn_run(const AttnArgs& a, unsigned char* smem) {
  const int tid = tid_(), lane = tid & 63, ln = lane & 31, h = lane >> 5;
  bf16_t* sk = (bf16_t*)smem;
  bf16_t* sv = sk + 2 * 64 * LSTR;
  bf16x8 qf[4];
  {
    const bf16_t* qp = a.q + (size_t)(a.qrow + ln) * 512 + h * 8;
#pragma unroll
    for (int ks = 0; ks < 4; ++ks) qf[ks] = *(const bf16x8*)(qp + ks * 16);
  }
  f32x16 o0, o1;
#pragma unroll
  for (int r = 0; r < 16; ++r) { o0[r] = 0.f; o1[r] = 0.f; }
  float lrun = 0.f;
  const int lrow = tid >> 3, lc = (tid & 7) * 8;
  uint4 rk0, rk1, rv0, rv1;
#define TILE_P0(i) ((i) < a.nwin ? a.win_p0 + (i) * 64 : ((i) - a.nwin) * 64)
#define GLOAD(i) { const int p0_ = TILE_P0(i); \
    rk0 = *(const uint4*)(a.k + (size_t)(a.kbase_row + p0_ + lrow) * a.kstride + lc); \
    rk1 = *(const uint4*)(a.k + (size_t)(a.kbase_row + p0_ + lrow + 32) * a.kstride + lc); \
    rv0 = *(const uint4*)(a.vt + (size_t)(lrow) * PT + p0_ + lc); \
    rv1 = *(const uint4*)(a.vt + (size_t)(lrow + 32) * PT + p0_ + lc); }
#define SSTORE(buf_) { \
    *(uint4*)(sk + (buf_) * 64 * LSTR + (lrow) * LSTR + lc) = rk0; \
    *(uint4*)(sk + (buf_) * 64 * LSTR + (lrow + 32) * LSTR + lc) = rk1; \
    *(uint4*)(sv + (buf_) * 64 * LSTR + (lrow) * LSTR + lc) = rv0; \
    *(uint4*)(sv + (buf_) * 64 * LSTR + (lrow + 32) * LSTR + lc) = rv1; }
  GLOAD(0);
  SSTORE(0);
  __syncthreads();
  for (int it = 0; it < a.ntiles; ++it) {
    const int buf = it & 1;
    GLOAD(min(it + 1, a.ntiles - 1));
    asm volatile("" ::: "memory");
    __builtin_amdgcn_sched_barrier(0);
    bool active = true;
    int krow = 0;
    const bool win = (a.mode == 1 && it < a.nwin);
    if (win) { krow = a.krow0 + it; active = (krow >= a.r0w && krow < a.r0w + 8); }
    if (active) {
      const bf16_t* ks_ = sk + buf * 64 * LSTR + ln * LSTR + h * 8;
      f32x16 s0, s1;
#pragma unroll
      for (int r = 0; r < 16; ++r) { s0[r] = -a.m0; s1[r] = -a.m0; }
#pragma unroll
      for (int ks = 0; ks < 4; ++ks) {
        bf16x8 a0 = *(const bf16x8*)(ks_ + ks * 16);
        bf16x8 a1 = *(const bf16x8*)(ks_ + 32 * LSTR + ks * 16);
        s0 = MFMA(a0, qf[ks], s0);
        s1 = MFMA(a1, qf[ks], s1);
      }
      if (win) {
        const int qc = a.cb + ln;
        const int c0 = min(max(qc - 8, 0), 48);
        const float* brow = a.bias + (krow - a.gr + 7) * 31 + 15 - qc;
#pragma unroll
        for (int r = 0; r < 16; ++r) {
          const int kc0 = (r >> 2) * 8 + h * 4 + (r & 3);
          const int kc1 = kc0 + 32;
          s0[r] = (kc0 >= c0 && kc0 < c0 + 16) ? s0[r] + brow[kc0] : -1e30f;
          s1[r] = (kc1 >= c0 && kc1 < c0 + 16) ? s1[r] + brow[kc1] : -1e30f;
        }
      }
#pragma unroll
      for (int r = 0; r < 16; ++r) { s0[r] = __builtin_amdgcn_exp2f(s0[r]); lrun += s0[r]; }
#pragma unroll
      for (int r = 0; r < 16; ++r) { s1[r] = __builtin_amdgcn_exp2f(s1[r]); lrun += s1[r]; }
      const bf16_t* vs_ = sv + buf * 64 * LSTR + ln * LSTR + h * 4;
#pragma unroll
      for (int j = 0; j < 4; ++j) {
        bf16x8 pb;
        {
          unsigned u0, u1, u2, u3;
          if (j < 2) {
            const int b8 = 8 * j;
            u0 = pack2(s0[b8 + 0], s0[b8 + 1]); u1 = pack2(s0[b8 + 2], s0[b8 + 3]);
            u2 = pack2(s0[b8 + 4], s0[b8 + 5]); u3 = pack2(s0[b8 + 6], s0[b8 + 7]);
          } else {
            const int b8 = 8 * (j - 2);
            u0 = pack2(s1[b8 + 0], s1[b8 + 1]); u1 = pack2(s1[b8 + 2], s1[b8 + 3]);
            u2 = pack2(s1[b8 + 4], s1[b8 + 5]); u3 = pack2(s1[b8 + 6], s1[b8 + 7]);
          }
          pb = __builtin_bit_cast(bf16x8, make_uint4(u0, u1, u2, u3));
        }
        const s16x4 lo0 = *(const s16x4*)(vs_ + j * 16);
        const s16x4 hi0 = *(const s16x4*)(vs_ + j * 16 + 8);
        const s16x4 lo1 = *(const s16x4*)(vs_ + 32 * LSTR + j * 16);
        const s16x4 hi1 = *(const s16x4*)(vs_ + 32 * LSTR + j * 16 + 8);
        const bf16x8 av0 = __builtin_shufflevector(lo0, hi0, 0, 1, 2, 3, 4, 5, 6, 7);
        const bf16x8 av1 = __builtin_shufflevector(lo1, hi1, 0, 1, 2, 3, 4, 5, 6, 7);
        o0 = MFMA(av0, pb, o0);
        o1 = MFMA(av1, pb, o1);
      }
    }
    SSTORE(buf ^ 1);
    __syncthreads();
  }
  lrun += shx(lrun, 32);
  const float inv = 1.f / lrun;
  bf16_t* op = a.q + (size_t)(a.qrow + ln) * 512;
#pragma unroll
  for (int rg = 0; rg < 4; ++rg) {
    const int d = rg * 8 + h * 4;
    *(uint2*)(op + d) = make_uint2(pack2(o0[rg * 4 + 0] * inv, o0[rg * 4 + 1] * inv), pack2(o0[rg * 4 + 2] * inv, o0[rg * 4 + 3] * inv));
    *(uint2*)(op + 32 + d) = make_uint2(pack2(o1[rg * 4 + 0] * inv, o1[rg * 4 + 1] * inv), pack2(o1[rg * 4 + 2] * inv, o1[rg * 4 + 3] * inv));
  }
}

DI float wave_max(float v) {
#pragma unroll
  for (int m = 32; m >= 1; m >>= 1) v = fmaxf(v, shx(v, m));
  return v;
}
DI float attn_m0(int qi, int ki, int l) {
  const int lane = tid_() & 63;
  const float* qn = ((const float*)(const __attribute__((address_space(1))) float*)karg(qi)) + l * 64;
  const float* kn = ((const float*)(const __attribute__((address_space(1))) float*)karg(ki)) + l * 64;
  return 8.f * 1.4426950408889634f * 1.02f * wave_max(fabsf(qn[lane])) * wave_max(fabsf(kn[lane]));
}
constexpr int N_A = 32, N_B = 1024, N_C = 1024, N_CTX = 128;
DI void mixer_item(const Params& p, int l, int it, unsigned char* smem) {
  const int w = tid_() >> 6;
  unsigned char* ws = ((unsigned char*)(__attribute__((address_space(1))) unsigned char*)karg(21));
  if (it < N_A) { a_chunk_item(ws, it, smem); return; }
  it -= N_A;
  AttnArgs a;
  a.bias = (const float*)(smem + 4 * 64 * LSTR * 2);
  a.mode = 0; a.gr = 0; a.r0w = 0; a.cb = 0; a.krow0 = 0;
  if (it < N_B) {
    const int hd = it & 7, qb = (it >> 3) & 31, b = it >> 8;
    a.q = (bf16_t*)(ws + O_BQ) + hd * 64;
    a.k = (const bf16_t*)(ws + O_BK) + (hd >> 2) * 64; a.kstride = 128;
    a.vt = (const bf16_t*)(ws + O_BVT) + ((size_t)b * 128 + (hd >> 2) * 64) * PT;
    a.kbase_row = b * PT; a.qrow = b * PT + CL + qb * 128 + w * 32;
    a.ntiles = 68; a.nwin = 68; a.win_p0 = 0;
    a.m0 = attn_m0(11, 12, l);
    attn_run(a, smem);
    return;
  }
  it -= N_B;
  if (it < N_C) {
    const int hd = it & 7, rp = (it >> 3) & 31, b = it >> 8;
    const int g0 = 2 * rp, g1 = 2 * rp + 1;
    const int r00 = min(max(g0 - 4, 0), 56), r01 = min(max(g1 - 4, 0), 56);
    float* bt = (float*)(smem + 4 * 64 * LSTR * 2);
    for (int i = tid_(); i < 465; i += 256) bt[i] = 1.4426950408889634f * ((const float*)(const __attribute__((address_space(1))) float*)karg(15))[((size_t)l * 8 + hd) * 465 + i];
    __syncthreads();
    a.q = (bf16_t*)(ws + O_CQ) + hd * 64;
    a.k = (const bf16_t*)(ws + O_CK) + hd * 64; a.kstride = 512;
    a.vt = (const bf16_t*)(ws + O_CVT) + ((size_t)b * 512 + hd * 64) * PT;
    a.kbase_row = b * PT;
    a.gr = g0 + (w >> 1); a.cb = (w & 1) * 32; a.r0w = (w >> 1) ? r01 : r00; a.krow0 = r00;
    a.qrow = b * PT + CL + a.gr * 64 + a.cb;
    a.nwin = r01 + 8 - r00; a.ntiles = a.nwin + 4; a.win_p0 = CL + r00 * 64;
    a.mode = 1;
    {
      const int lane = tid_() & 63;
      float bm = 0.f;
#pragma unroll
      for (int i = 0; i < 8; ++i) { const int ix = lane + 64 * i; if (ix < 465) bm = fmaxf(bm, fabsf(bt[ix])); }
      a.m0 = attn_m0(13, 14, l) + wave_max(bm);
    }
    attn_run(a, smem);
    return;
  }
  it -= N_C;
  {
    const int hd = it & 7, qb = (it >> 3) & 1, b = (it >> 4) & 3, kc = it >> 6;
    if (kc == 0) {
      a.q = (bf16_t*)(ws + O_BQ) + hd * 64;
      a.k = (const bf16_t*)(ws + O_BK) + (hd >> 2) * 64; a.kstride = 128;
      a.vt = (const bf16_t*)(ws + O_BVT) + ((size_t)b * 128 + (hd >> 2) * 64) * PT;
    } else {
      a.q = (bf16_t*)(ws + O_CQ) + hd * 64;
      a.k = (const bf16_t*)(ws + O_CK) + hd * 64; a.kstride = 512;
      a.vt = (const bf16_t*)(ws + O_CVT) + ((size_t)b * 512 + hd * 64) * PT;
    }
    a.kbase_row = b * PT; a.qrow = b * PT + qb * 128 + w * 32;
    a.ntiles = 4; a.nwin = 4; a.win_p0 = 0;
    a.m0 = (kc == 0) ? attn_m0(11, 12, l) : attn_m0(13, 14, l);
    attn_run(a, smem);
  }
}

DI void readout_row(const Params& p, int l, int row) {
  const int lane = tid_() & 63;
  unsigned char* ws = ((unsigned char*)(__attribute__((address_space(1))) unsigned char*)karg(21));
  const bf16_t* uo = (const bf16_t*)(ws + O_UO) + (size_t)row * 1024;
  bf16_t* og = (bf16_t*)(ws + O_OG) + (size_t)row * 512;
  const uint4 f4 = *(const uint4*)(uo + lane * 8);
  const uint4 b4 = *(const uint4*)(uo + 512 + lane * 8);
  const uint4 g4 = *(const uint4*)(og + lane * 8);
  asm volatile("s_waitcnt vmcnt(0)" ::: "memory");
  const unsigned ff[4] = {f4.x, f4.y, f4.z, f4.w}, bb[4] = {b4.x, b4.y, b4.z, b4.w}, gg[4] = {g4.x, g4.y, g4.z, g4.w};
  float o[8];
  float ss = 0.f;
#pragma unroll
  for (int i = 0; i < 4; ++i) {
    o[2 * i] = bflo(ff[i]) + bflo(bb[i]);
    o[2 * i + 1] = bfhi(ff[i]) + bfhi(bb[i]);
    ss += o[2 * i] * o[2 * i] + o[2 * i + 1] * o[2 * i + 1];
  }
  ss += shx(ss, 1); ss += shx(ss, 2); ss += shx(ss, 4); ss += shx(ss, 8);
  const float rs = rsqrtf(ss * (1.f / 128.f) + EPS);
  const float* gn = ((const float*)(const __attribute__((address_space(1))) float*)karg(10)) + l * 128 + (lane & 15) * 8;
  unsigned outp[4];
#pragma unroll
  for (int i = 0; i < 4; ++i) {
    const float g0 = bflo(gg[i]), g1 = bfhi(gg[i]);
    outp[i] = pack2(o[2 * i] * rs * gn[2 * i] * siluf_(g0), o[2 * i + 1] * rs * gn[2 * i + 1] * siluf_(g1));
  }
  *(uint4*)(og + lane * 8) = make_uint4(outp[0], outp[1], outp[2], outp[3]);
  norm_row(p, l, 0, row, ((const float*)(const __attribute__((address_space(1))) float*)karg(6)) + l * 1024, 0, 1024);
}

DI bool xcd_tile(int seq, int bid, int nblk, int MX, int NX, int& mt, int& nt) {
  const int per = nblk >> 3, li = bid >> 3, x = bid & 7;
  const int u = li + seq * per;
  if (u >= MX * NX) return false;
  const int FM = MX >> 3, fullsz = 8 * NX;
  int mgi, r, gm;
  if (u < FM * fullsz) { mgi = u / fullsz; r = u - mgi * fullsz; gm = 8; }
  else { mgi = FM; r = u - FM * fullsz; gm = MX & 7; }
  const int ngi = r / (gm * 8), r2 = r - ngi * gm * 8;
  const int nj = r2 / gm, mi = r2 - nj * gm;
  mt = x * MX + mgi * 8 + mi;
  nt = ngi * 8 + nj;
  return true;
}
DI int mtile_row0(int l, int mt) { return l == 0 ? mt * 128 : ((mt >> 5) * PT + CL + (mt & 31) * 128); }

#ifndef SKIPM
#define SKIPM 0
#endif
#ifdef PROBE_REP
__device__ const unsigned char PSEQ[] = {0, 1, 2, PROBE_R(2) 3, 4, 5, PROBE_R(5) 6, 7, 8, PROBE_R(8) 9, 10, 11, PROBE_R(11) 12, 13, 14, PROBE_R(14) 15, 16, 17, PROBE_R(17) 18};
#else
__device__ const unsigned char PSEQ[] = {0, 1, 2, 3, 4, 5, 6, 7, 8, 9, 10, 11, 12, 13, 14, 15, 16, 17, 18};
#endif
constexpr int NSEQ = sizeof(PSEQ);
#define OPAQUE_S(x) asm volatile("" : "+s"(x))
__global__ void __launch_bounds__(256, 2) fwd_megakernel(Params p) {
  extern __shared__ __attribute__((aligned(16))) unsigned char smem[];
  __shared__ __attribute__((aligned(16))) unsigned sh_words[8];
#define s_item (((int*)sh_words)[4])
#define s_key (((int*)sh_words)[5])
  cg::grid_group grid = cg::this_grid();
  const int nblk = gridDim.x, bid = blockIdx.x;
  if (threadIdx.x == 0) { sh_words[0] = 0u; sh_words[1] = 0u; sh_words[2] = 0u; sh_words[3] = 0u; }
  __syncthreads();
  (void)xcd_barrier_post((unsigned*)(((unsigned char*)(__attribute__((address_space(1))) unsigned char*)karg(21)) + O_BAR), (volatile LAS unsigned*)sh_words);

  for (int pi = 0; pi < NSEQ; ++pi) {
    const int ph = PSEQ[pi];
    const int tid = tid_(), lane = tid & 63, w = tid >> 6, wm = w >> 1, wn = w & 1;
    unsigned char* ws = ((unsigned char*)(__attribute__((address_space(1))) unsigned char*)karg(21));
    const int l = (ph - 1) / 9, k = (ph == 0) ? -1 : (ph - 1) % 9;
    const int nmt = (l == 0) ? 136 : 128;
    if (k == -1 && !(SKIPM & 1)) {
      int* ctr = (int*)(ws + O_CTR);
      for (int i = bid * 256 + tid; i < 64 + 4 * 4096; i += nblk * 256) ctr[i] = 0;
      if (bid == 1 || nblk == 1) {
        float* ropet = (float*)(ws + O_ROPE);
        for (int i = tid; i < 1024; i += 256) {
          const int pos = i >> 4, j = i & 15;
          const float inv = exp2f(-(float)j * (13.287712379549449f / 16.f));
          const float ang = (float)pos * inv;
          ropet[i * 2] = __cosf(ang); ropet[i * 2 + 1] = __sinf(ang);
        }
      }
      for (int it = bid; it < 384 + CVT_ITEMS; it += nblk) {
        if (it < 384) mod_item(p, it, smem); else cvt_item(p, 0, it - 384, smem);
      }
    } else if (k == 0 && !(SKIPM & 2)) {
      if (l == 1) for (int it = bid; it < CVT_ITEMS; it += nblk) cvt_item(p, 1, it, smem);
      for (int row = bid * 4 + w; row < NT; row += nblk * 4) norm_row(p, l, 0, row, ((const float*)(const __attribute__((address_space(1))) float*)karg(6)) + l * 1024, 0, 1024);
    } else if (k == 1 && !(SKIPM & 4)) {
      for (int sq = 0;; ++sq) {
        int mt, nt;
        if (!xcd_tile(sq, bid, nblk, 17, 42, mt, nt)) break;
        f32x16 acc[2][2];
        zero_acc(acc);
        gemm_tile((const bf16_t*)(ws + O_UO) + (size_t)mt * 128 * 1024, 1024, (const bf16_t*)(ws + O_WIN) + (size_t)nt * 128 * 1024, 1024, 1024, acc, smem);
        inproj_epilogue(p, l, acc, mt * 128 + wm * 64, nt * 128 + wn * 64);
      }
    } else if (k == 2 && !(SKIPM & 8)) {
      int* ctr = (int*)(ws + O_CTR);
      const int nattn = N_B + N_C + (l == 0 ? N_CTX : 0);
      if (tid == 0) {
        const unsigned hw = __builtin_amdgcn_s_getreg(4 | (31 << 11));
        const unsigned xcc = __builtin_amdgcn_s_getreg(20 | (31 << 11));
        const int key = (int)(((xcc & 15u) << 8) | ((hw >> 8) & 255u));
        int* cuflag = ctr + 64 + 2 * 4096 + l * 4096 + key;
        const int r = atomicAdd(ctr + 64 + l * 4096 + key, 1);
        int item = -1;
        if (r == 0) {
          const int it = atomicAdd(ctr + l * 2 + 0, 1);
          if (it < N_A) { item = it; atomicExch(cuflag, 1); } else atomicExch(cuflag, 2);
        } else {
          for (int spin = 0; spin < (1 << 20); ++spin) {
            const int v = atomicAdd(cuflag, 0);
            if (v >= 2) break;
            __builtin_amdgcn_s_sleep(32);
          }
        }
        s_item = item; s_key = key;
      }
      __syncthreads();
      const int myitem = s_item, mykey = s_key;
      __syncthreads();
      if (myitem >= 0) {
        mixer_item(p, l, myitem, smem);
        __syncthreads();
        if (tid == 0) atomicExch(ctr + 64 + 2 * 4096 + l * 4096 + mykey, 3);
      }
      for (int pass = 0; pass < 2; ++pass) {
        const int q = 1 ^ pass;
        const int total = (q == 0) ? N_A : nattn;
        for (;;) {
          if (tid == 0) s_item = atomicAdd(ctr + l * 2 + q, 1);
          __syncthreads();
          const int it = s_item;
          __syncthreads();
          if (it >= total) break;
          mixer_item(p, l, q == 0 ? it : N_A + it, smem);
        }
      }
    } else if (k == 3 && !(SKIPM & 16)) {
      for (int i = bid * 4 + w; i < nmt * 128; i += nblk * 4) {
        const int row = (l == 0) ? i : ((i >> 12) * PT + CL + (i & 4095));
        readout_row(p, l, row);
      }
    } else if (k == 4 && !(SKIPM & 32)) {
      float4* msc = (float4*)(ws + O_CK) + (size_t)bid * 4096 + tid;
      for (int sq = 0;; ++sq) {
        int mt, nt;
        if (!xcd_tile(sq, bid, nblk, nmt >> 3, 8, mt, nt)) break;
        const int m0 = mtile_row0(l, mt), n0 = nt * 128;
#pragma unroll 1
        for (int kb = 0; kb < 3; ++kb) {
          f32x16 acc[2][2];
          zero_acc(acc);
          gemm_tile((const bf16_t*)(ws + O_UO) + (size_t)m0 * 1024, 1024, (const bf16_t*)(ws + O_WIN) + (size_t)(PW + kb * 1024 + n0) * 1024, 1024, 1024, acc, smem);
          uint4* gsc = (uint4*)(ws + O_QHF) + (size_t)bid * 2048 + tid;
#pragma unroll
          for (int i = 0; i < 2; ++i)
#pragma unroll
            for (int j = 0; j < 2; ++j) {
              unsigned g8[8];
#pragma unroll
              for (int r = 0; r < 8; ++r) g8[r] = pack2(sigmoidf_(acc[i][j][2 * r]), sigmoidf_(acc[i][j][2 * r + 1]));
              gsc[((i * 2 + j) * 2 + 0) * 256] = make_uint4(g8[0], g8[1], g8[2], g8[3]);
              gsc[((i * 2 + j) * 2 + 1) * 256] = make_uint4(g8[4], g8[5], g8[6], g8[7]);
            }
          zero_acc(acc);
          const size_t yo = (kb == 0) ? O_OG : (kb == 1 ? O_BQ : O_CQ);
          gemm_tile((const bf16_t*)(ws + yo) + (size_t)m0 * 512, 512, (const bf16_t*)(ws + O_WBR) + ((size_t)kb * 1024 + n0) * 512, 512, 512, acc, smem);
          const int h = lane >> 5, ln = lane & 31;
          int mso = 0, rowb = m0 + wm * 64 + h * 4, colb = n0 + wn * 64 + ln;
          asm volatile("" : "+v"(mso), "+v"(rowb), "+v"(colb));
#pragma unroll
          for (int i = 0; i < 2; ++i)
#pragma unroll
            for (int j = 0; j < 2; ++j) {
              const uint4 ga = gsc[mso + ((i * 2 + j) * 2 + 0) * 256], gb = gsc[mso + ((i * 2 + j) * 2 + 1) * 256];
              const unsigned g8[8] = {ga.x, ga.y, ga.z, ga.w, gb.x, gb.y, gb.z, gb.w};
#pragma unroll
              for (int rg = 0; rg < 4; ++rg) {
                float4 v;
                v.x = bflo(g8[rg * 2]) * acc[i][j][rg * 4 + 0];
                v.y = bfhi(g8[rg * 2]) * acc[i][j][rg * 4 + 1];
                v.z = bflo(g8[rg * 2 + 1]) * acc[i][j][rg * 4 + 2];
                v.w = bfhi(g8[rg * 2 + 1]) * acc[i][j][rg * 4 + 3];
                float4* sp = msc + mso + ((i * 2 + j) * 4 + rg) * 256;
                if (kb > 0) { const float4 o = *sp; v.x += o.x; v.y += o.y; v.z += o.z; v.w += o.w; }
                if (kb < 2) *sp = v;
                else {
                  bf16_t* mo = (bf16_t*)(ws + O_M);
                  const int row = rowb + i * 32 + rg * 8;
                  const int col = colb + j * 32;
                  mo[(size_t)row * 1024 + col] = tobf(v.x);
                  mo[(size_t)(row + 1) * 1024 + col] = tobf(v.y);
                  mo[(size_t)(row + 2) * 1024 + col] = tobf(v.z);
                  mo[(size_t)(row + 3) * 1024 + col] = tobf(v.w);
                }
                __builtin_amdgcn_sched_barrier(0);
              }
            }
        }
      }
    } else if (k == 5 && !(SKIPM & 64)) {
      for (int sq = 0;; ++sq) {
        int mt, nt;
        if (!xcd_tile(sq, bid, nblk, nmt >> 3, 8, mt, nt)) break;
        const int m0 = mtile_row0(l, mt), n0 = nt * 128;
        f32x16 acc[2][2];
        zero_acc(acc);
        gemm_tile((const bf16_t*)(ws + O_M) + (size_t)m0 * 1024, 1024, (const bf16_t*)(ws + O_WOUT) + (size_t)n0 * 1024, 1024, 1024, acc, smem);
        const int h = lane >> 5, ln = lane & 31;
#pragma unroll
        for (int i = 0; i < 2; ++i)
#pragma unroll
          for (int r = 0; r < 16; ++r) {
            const int row = m0 + wm * 64 + i * 32 + (r >> 2) * 8 + h * 4 + (r & 3);
            const int b = row / PT, q = row % PT;
            const float* xin = xrow_ptr(p, l, 0, row);
            float* xo = (q < CL) ? (float*)(ws + O_XC) + ((size_t)b * CL + q) * D : ((float*)(__attribute__((address_space(1))) float*)karg(20)) + ((size_t)b * SEQ + (q - CL)) * D;
            const float* modf = (const float*)(ws + O_MOD) + ((size_t)l * 5 + (q < CL ? 4 : b)) * 6144 + 2048;
#pragma unroll
            for (int j = 0; j < 2; ++j) {
              const int col = n0 + wn * 64 + j * 32 + ln;
              xo[col] = xin[col] + modf[col] * acc[i][j][r];
            }
          }
      }
    } else if (k == 6 && !(SKIPM & 128)) {
      for (int i = bid * 4 + w; i < nmt * 128; i += nblk * 4) {
        const int row = (l == 0) ? i : ((i >> 12) * PT + CL + (i & 4095));
        norm_row(p, l, 1, row, ((const float*)(const __attribute__((address_space(1))) float*)karg(7)) + l * 1024, 3072, 4096);
      }
    } else if (k == 7 && !(SKIPM & 256)) {
      for (int sq = 0;; ++sq) {
        int mt, nt;
        if (!xcd_tile(sq, bid, nblk, nmt >> 3, 44, mt, nt)) break;
        const int m0 = mtile_row0(l, mt);
        f32x16 acc[2][2];
        zero_acc(acc);
        gemm_tile((const bf16_t*)(ws + O_UO) + (size_t)m0 * 1024, 1024, (const bf16_t*)(ws + O_WGU) + (size_t)nt * 128 * 1024, 1024, 1024, acc, smem);
        bf16_t* ao = (bf16_t*)(ws + O_ACT);
        const int h = lane >> 5, ln = lane & 31;
#pragma unroll
        for (int i = 0; i < 2; ++i)
#pragma unroll
          for (int r = 0; r < 16; ++r) {
            const int row = m0 + wm * 64 + i * 32 + (r >> 2) * 8 + h * 4 + (r & 3);
            ao[(size_t)row * FH + nt * 64 + wn * 32 + ln] = tobf(siluf_(acc[i][0][r]) * acc[i][1][r]);
          }
      }
    } else if (!(SKIPM & 512)) {
      for (int sq = 0;; ++sq) {
        int mt, nt;
        if (!xcd_tile(sq, bid, nblk, nmt >> 3, 8, mt, nt)) break;
        const int m0 = mtile_row0(l, mt), n0 = nt * 128;
        f32x16 acc[2][2];
        zero_acc(acc);
        gemm_tile((const bf16_t*)(ws + O_ACT) + (size_t)m0 * FH, FH, (const bf16_t*)(ws + O_WD) + (size_t)n0 * FH, FH, FH, acc, smem);
        const int h = lane >> 5, ln = lane & 31;
#pragma unroll
        for (int i = 0; i < 2; ++i)
#pragma unroll
          for (int r = 0; r < 16; ++r) {
            const int row = m0 + wm * 64 + i * 32 + (r >> 2) * 8 + h * 4 + (r & 3);
            const int b = row / PT, q = row % PT;
            float* xo = (q < CL) ? (float*)(ws + O_XC) + ((size_t)b * CL + q) * D : ((float*)(__attribute__((address_space(1))) float*)karg(20)) + ((size_t)b * SEQ + (q - CL)) * D;
            const float* modf = (const float*)(ws + O_MOD) + ((size_t)l * 5 + (q < CL ? 4 : b)) * 6144 + 5120;
#pragma unroll
            for (int j = 0; j < 2; ++j) {
              const int col = n0 + wn * 64 + j * 32 + ln;
              xo[col] = xo[col] + modf[col] * acc[i][j][r];
            }
          }
      }
    }
    if (nblk > (1 << 30)) grid.sync();
    else if (pi < NSEQ - 1) {
      XcdBarrier xb; xb.bar = (unsigned*)(ws + O_BAR); xb.x = xb_xcc_id(); xb.st = (volatile LAS unsigned*)sh_words;
      xcd_barrier(xb);
    }
  }
}

extern "C" void kernel_launch(void* const* d_in, const int* in_sizes, int n_in, void* d_out, int out_size, void* d_ws, size_t ws_size,
                              hipStream_t stream) {
  static int grid_blocks = 0;
  if (grid_blocks == 0) {
    if (ws_size < WS_END) { fprintf(stderr, "kernel_launch: workspace too small: %zu < %zu\n", ws_size, (size_t)WS_END); grid_blocks = -1; return; }
    int dev = 0, cus = 0, per_cu = 0;
    hipGetDevice(&dev);
    hipDeviceGetAttribute(&cus, hipDeviceAttributeMultiprocessorCount, dev);
    hipFuncSetAttribute((const void*)fwd_megakernel, hipFuncAttributeMaxDynamicSharedMemorySize, LDS_BYTES);
    hipOccupancyMaxActiveBlocksPerMultiprocessor(&per_cu, (const void*)fwd_megakernel, 256, LDS_BYTES);
    if (per_cu < 1) { fprintf(stderr, "kernel_launch: occupancy query returned %d\n", per_cu); grid_blocks = -1; return; }
    if (per_cu > 2) per_cu = 2;
    grid_blocks = cus * per_cu;
  }
  if (grid_blocks < 0) return;
  Params p{};
  p.x = (const float*)d_in[0]; p.c = (const float*)d_in[1]; p.ctx = (const float*)d_in[2]; p.c_ctx = (const float*)d_in[3];
  p.w_mod = (const float*)d_in[4]; p.b_mod = (const float*)d_in[5]; p.norm_mix = (const float*)d_in[6]; p.norm_ffn = (const float*)d_in[7];
  p.w_in = (const float*)d_in[8]; p.lb_raw = (const float*)d_in[9]; p.gn_a = (const float*)d_in[10]; p.qn_b = (const float*)d_in[11];
  p.kn_b = (const float*)d_in[12]; p.qn_c = (const float*)d_in[13]; p.kn_c = (const float*)d_in[14]; p.rel_bias = (const float*)d_in[15];
  p.w_branch = (const float*)d_in[16]; p.w_out = (const float*)d_in[17]; p.w_gate_up = (const float*)d_in[18]; p.w_down = (const float*)d_in[19];
  p.out = (float*)d_out; p.ws = (unsigned char*)d_ws;
  if (hipMemsetAsync((unsigned char*)d_ws + O_BAR, 0, 16384, stream) != hipSuccess) { fprintf(stderr, "kernel_launch: hipMemsetAsync of the barrier words failed\n"); return; }
  void* args[] = {&p};
  hipError_t e = hipLaunchCooperativeKernel((const void*)fwd_megakernel, dim3(grid_blocks), dim3(256), args, LDS_BYTES, stream);
  if (e != hipSuccess) fprintf(stderr, "cooperative launch failed: %s (grid %d)\n", hipGetErrorString(e), grid_blocks);
}
```

```cpp
#include <hip/hip_runtime.h>
#include <hip/hip_cooperative_groups.h>
#include <cstdio>
namespace cg = cooperative_groups;

typedef short bf16x8 __attribute__((ext_vector_type(8)));
typedef short s16x4 __attribute__((ext_vector_type(4)));
typedef float f32x16 __attribute__((ext_vector_type(16)));
typedef float f32x2 __attribute__((ext_vector_type(2)));
typedef __bf16 bf16x2_t __attribute__((ext_vector_type(2)));
typedef unsigned short bf16_t;
#define DI __device__ __forceinline__
#define MFMA(a, b, c) __builtin_amdgcn_mfma_f32_32x32x16_bf16((a), (b), (c), 0, 0, 0)

constexpr int D = 1024, NB = 4, SEQ = 4096, CL = 256, PT = 4352, NT = NB * PT;
constexpr int INW = 7936, INW2 = 8448, PW = 5376, FH = 2816, GU = 5632;
constexpr float EPS = 1e-6f;

constexpr size_t SZ512 = (size_t)NT * 512 * 2;
constexpr size_t SZ128 = (size_t)NT * 128 * 2;
constexpr size_t O_WIN = 0;
constexpr size_t O_WBR = O_WIN + (size_t)INW2 * D * 2;
constexpr size_t O_WOUT = O_WBR + (size_t)3 * D * 512 * 2;
constexpr size_t O_WGU = O_WOUT + (size_t)D * D * 2;
constexpr size_t O_WD = O_WGU + (size_t)GU * D * 2;
constexpr size_t O_UO = O_WD + (size_t)D * FH * 2;
constexpr size_t O_P = O_UO + (size_t)NT * 1024 * 2;
constexpr size_t O_QHF = O_P;
constexpr size_t O_KTF = O_QHF + SZ512;
constexpr size_t O_QHB = O_KTF + SZ512;
constexpr size_t O_KTB = O_QHB + SZ512;
constexpr size_t O_VA = O_KTB + SZ512;
constexpr size_t O_OG = O_VA + SZ512;
constexpr size_t O_BQ = O_OG + SZ512;
constexpr size_t O_CQ = O_BQ + SZ512;
constexpr size_t O_CK = O_CQ + SZ512;
constexpr size_t O_CVT = O_CK + SZ512;
constexpr size_t O_BK = O_CVT + SZ512;
constexpr size_t O_BVT = O_BK + SZ128;
constexpr size_t O_EBL = O_BVT + SZ128;
constexpr size_t O_XC = O_EBL + (size_t)2 * (NT / 32) * 512 * 4;
constexpr size_t O_MOD = O_XC + (size_t)NB * CL * D * 4;
constexpr size_t O_ROPE = O_MOD + (size_t)2 * 5 * 6144 * 4;
constexpr size_t O_CTR = O_ROPE + 64 * 16 * 2 * 4;
constexpr size_t O_BAR = O_CTR + (64 + 4 * 4096) * 4;
constexpr size_t WS_END = O_BAR + 16384;
constexpr size_t O_M = O_QHB;
constexpr size_t O_ACT = O_P;

constexpr int LDS_BYTES = 73728;
constexpr int LSTR = 72;

struct Params {
  const float* x; const float* c; const float* ctx; const float* c_ctx; const float* w_mod; const float* b_mod;
  const float* norm_mix; const float* norm_ffn; const float* w_in; const float* lb_raw; const float* gn_a;
  const float* qn_b; const float* kn_b; const float* qn_c; const float* kn_c; const float* rel_bias;
  const float* w_branch; const float* w_out; const float* w_gate_up; const float* w_down;
  float* out; unsigned char* ws;
};


typedef const unsigned long long __attribute__((address_space(4))) karg_t;
DI unsigned long long karg(int i) { return *(volatile karg_t*)((karg_t*)__builtin_amdgcn_kernarg_segment_ptr() + i); }
DI int tid_() { int t = threadIdx.x; asm volatile("" : "+v"(t)); return t; }
DI unsigned pack2(float a, float b) {
  f32x2 v = {a, b};
  bf16x2_t r = __builtin_convertvector(v, bf16x2_t);
  return __builtin_bit_cast(unsigned, r);
}
DI bf16_t tobf(float a) { return (bf16_t)(pack2(a, 0.f) & 0xffffu); }
DI float bflo(unsigned u) { return __uint_as_float(u << 16); }
DI float bfhi(unsigned u) { return __uint_as_float(u & 0xffff0000u); }
DI float sigmoidf_(float x) { return __builtin_amdgcn_rcpf(1.f + __builtin_amdgcn_exp2f(-1.4426950408889634f * x)); }
DI float siluf_(float x) { return x * __builtin_amdgcn_rcpf(1.f + __builtin_amdgcn_exp2f(-1.4426950408889634f * x)); }
DI float shx(float v, int m) { return __shfl_xor(v, m); }

#define XB_TMO      128
#define XB_XCNT(j)  (256  + 64 * (j))
#define XB_XSUB(j)  (1280 + 64 * (j))
#define XB_XGEN(j)  (2304 + 64 * (j))
#define XB_TOP      3328
#define XB_TOPGEN   3392
#define XCD_BAR_WORDS 3456
#define XB_SPIN_CAP (1u << 18)
#define LAS __attribute__((address_space(3)))
DI unsigned xb_ld(unsigned* p)              { return __hip_atomic_load(p, __ATOMIC_RELAXED, __HIP_MEMORY_SCOPE_AGENT); }
DI unsigned xb_add(unsigned* p, unsigned v) { return __hip_atomic_fetch_add(p, v, __ATOMIC_RELAXED, __HIP_MEMORY_SCOPE_AGENT); }
DI unsigned xb_xcc_id() { return (unsigned)__builtin_amdgcn_s_getreg((3 << 11) | 20) & 0xFu; }
#define XB_SPIN(cond, bar) do { unsigned _sp = 0; while (cond) { __builtin_amdgcn_s_sleep(1); \
    if ((++_sp & 255u) == 0u) { if (xb_ld(&(bar)[XB_TMO])) break; if (_sp > XB_SPIN_CAP) { atomicAdd(&(bar)[XB_TMO], 1u); break; } } } } while (0)
struct XcdBarrier { unsigned* bar; unsigned x; volatile LAS unsigned* st; };
DI XcdBarrier xcd_barrier_post(unsigned* bar, volatile LAS unsigned* st) {
  XcdBarrier b; b.bar = bar; b.x = xb_xcc_id(); b.st = st;
  if (threadIdx.x == 0) (void)xb_add(&bar[XB_XCNT(b.x)], 1u);
  return b;
}
DI void xcd_barrier_complete(unsigned* bar, unsigned x, unsigned& nloc, unsigned& nx) {
  const unsigned G = gridDim.x * gridDim.y * gridDim.z;
  unsigned sum, cnt, mine, sp = 0u;
  for (;;) {
    sum = 0u; cnt = 0u; mine = 0u;
#pragma unroll
    for (unsigned j = 0; j < 16; ++j) { const unsigned c = xb_ld(&bar[XB_XCNT(j)]); sum += c; cnt += (c > 0u) ? 1u : 0u; mine = (j == x) ? c : mine; }
    if (sum == G) break;
    __builtin_amdgcn_s_sleep(1);
    if ((++sp & 255u) == 0u) { if (xb_ld(&bar[XB_TMO])) break; if (sp > XB_SPIN_CAP) { atomicAdd(&bar[XB_TMO], 1u); break; } }
  }
  nloc = mine > 0u ? mine : 1u; nx = cnt > 0u ? cnt : 1u;
}
DI void xcd_barrier(const XcdBarrier& b) {
  asm volatile("s_waitcnt vmcnt(0)" ::: "memory");
  __syncthreads();
  if (threadIdx.x == 0) {
    unsigned* bar = b.bar;
    __builtin_amdgcn_s_waitcnt(0);
    unsigned nloc = b.st[0], nx = b.st[1];
    if (nloc == 0u) { xcd_barrier_complete(bar, b.x, nloc, nx); b.st[0] = nloc; b.st[1] = nx; }
    const unsigned old = xb_add(&bar[XB_XSUB(b.x)], 1u);
    const unsigned gen = old / nloc;
    if (old + 1u == (gen + 1u) * nloc) {
      __builtin_amdgcn_fence(__ATOMIC_RELEASE, "agent");
      asm volatile("s_waitcnt vmcnt(0)" ::: "memory");
      const unsigned og = xb_add(&bar[XB_TOP], 1u);
      const unsigned tg = og / nx;
      if (og + 1u == (tg + 1u) * nx) xb_add(&bar[XB_TOPGEN], 1u);
      else XB_SPIN(xb_ld(&bar[XB_TOPGEN]) == tg, bar);
      __builtin_amdgcn_fence(__ATOMIC_ACQUIRE, "agent");
      xb_add(&bar[XB_XGEN(b.x)], 1u);
      asm volatile("s_waitcnt vmcnt(0)" ::: "memory");
    } else {
      XB_SPIN(xb_ld(&bar[XB_XGEN(b.x)]) == gen, bar);
      __builtin_amdgcn_fence(__ATOMIC_ACQUIRE, "agent");
      asm volatile("s_waitcnt vmcnt(0)" ::: "memory");
    }
  }
  __syncthreads();
}

DI void gemm_tile(const bf16_t* A, int lda, const bf16_t* Bt, int ldb, int K,
                  f32x16 (&acc)[2][2], unsigned char* smem) {
  const int tid = tid_(), lane = tid & 63, w = tid >> 6, wm = w >> 1, wn = w & 1;
  bf16_t* sa = (bf16_t*)smem;
  bf16_t* sb = sa + 2 * 128 * LSTR;
  const int lrow = tid >> 3, lkc = (tid & 7) * 8;
  const bf16_t* ga = A + (size_t)lrow * lda + lkc;
  const bf16_t* gb = Bt + (size_t)lrow * ldb + lkc;
  uint4 pa0, pa1, pa2, pa3, pb0, pb1, pb2, pb3;
  uint4 qa0, qa1, qa2, qa3, qb0, qb1, qb2, qb3;
#define GT_LOAD(S, koff) { \
    S##a0 = *(const uint4*)(ga + (koff)); S##a1 = *(const uint4*)(ga + (size_t)32 * lda + (koff)); \
    S##a2 = *(const uint4*)(ga + (size_t)64 * lda + (koff)); S##a3 = *(const uint4*)(ga + (size_t)96 * lda + (koff)); \
    S##b0 = *(const uint4*)(gb + (koff)); S##b1 = *(const uint4*)(gb + (size_t)32 * ldb + (koff)); \
    S##b2 = *(const uint4*)(gb + (size_t)64 * ldb + (koff)); S##b3 = *(const uint4*)(gb + (size_t)96 * ldb + (koff)); \
    asm volatile("" ::: "memory"); __builtin_amdgcn_sched_barrier(0); }
#define GT_STORE(S, bufi) { \
    bf16_t* da_ = sa + (bufi) * 128 * LSTR + lrow * LSTR + lkc; bf16_t* db_ = sb + (bufi) * 128 * LSTR + lrow * LSTR + lkc; \
    *(uint4*)(da_) = S##a0; *(uint4*)(da_ + 32 * LSTR) = S##a1; *(uint4*)(da_ + 64 * LSTR) = S##a2; *(uint4*)(da_ + 96 * LSTR) = S##a3; \
    *(uint4*)(db_) = S##b0; *(uint4*)(db_ + 32 * LSTR) = S##b1; *(uint4*)(db_ + 64 * LSTR) = S##b2; *(uint4*)(db_ + 96 * LSTR) = S##b3; }
#define GT_FRAGS(F0, F1, G0, G1, KS) \
    F0 = *(const bf16x8*)(as + (KS) * 16); F1 = *(const bf16x8*)(as + 32 * LSTR + (KS) * 16); \
    G0 = *(const bf16x8*)(bs + (KS) * 16); G1 = *(const bf16x8*)(bs + 32 * LSTR + (KS) * 16);
#define GEMM_STEP(A0, A1, B0, B1, PRE, ST0, ST1) \
    PRE \
    acc[0][0] = MFMA(A0, B0, acc[0][0]); acc[0][1] = MFMA(A0, B1, acc[0][1]); \
    ST0; ST1; \
    acc[1][0] = MFMA(A1, B0, acc[1][0]); acc[1][1] = MFMA(A1, B1, acc[1][1]); \
    __builtin_amdgcn_sched_barrier(0);
#define GT_COMPUTE(bufi, S, sbuf) { \
    const bf16_t* as = sa + (bufi) * 128 * LSTR + wm * 64 * LSTR + fo; \
    const bf16_t* bs = sb + (bufi) * 128 * LSTR + wn * 64 * LSTR + fo; \
    bf16_t* da_ = sa + (sbuf) * 128 * LSTR + lrow * LSTR + lkc; bf16_t* db_ = sb + (sbuf) * 128 * LSTR + lrow * LSTR + lkc; \
    bf16x8 a0, a1, b0, b1, c0, c1, d0, d1, e0, e1, f0, f1; \
    GT_FRAGS(a0, a1, b0, b1, 0) GT_FRAGS(c0, c1, d0, d1, 1) \
    GEMM_STEP(a0, a1, b0, b1, GT_FRAGS(e0, e1, f0, f1, 2), *(uint4*)(da_) = S##a0, *(uint4*)(db_) = S##b0) \
    GEMM_STEP(c0, c1, d0, d1, GT_FRAGS(a0, a1, b0, b1, 3), *(uint4*)(da_ + 32 * LSTR) = S##a1, *(uint4*)(db_ + 32 * LSTR) = S##b1) \
    GEMM_STEP(e0, e1, f0, f1, , *(uint4*)(da_ + 64 * LSTR) = S##a2, *(uint4*)(db_ + 64 * LSTR) = S##b2) \
    GEMM_STEP(a0, a1, b0, b1, , *(uint4*)(da_ + 96 * LSTR) = S##a3, *(uint4*)(db_ + 96 * LSTR) = S##b3) }
  const int nk = K >> 6;
  const int fo = (lane & 31) * LSTR + (lane >> 5) * 8;
  GT_LOAD(p, 0)
  GT_LOAD(q, 64)
  GT_STORE(p, 0)
  __syncthreads();
  for (int kt = 0; kt < nk; kt += 2) {
    GT_LOAD(p, min(kt + 2, nk - 1) * 64)
    GT_COMPUTE(0, q, 1)
    __syncthreads();
    GT_LOAD(q, min(kt + 3, nk - 1) * 64)
    GT_COMPUTE(1, p, 0)
    __syncthreads();
  }
}
DI void zero_acc(f32x16 (&acc)[2][2]) {
#pragma unroll
  for (int i = 0; i < 2; ++i)
#pragma unroll
    for (int j = 0; j < 2; ++j)
#pragma unroll
      for (int r = 0; r < 16; ++r) acc[i][j][r] = 0.f;
}

DI void cvt_tile(const float* __restrict__ src, int ldsrc, int k0, int scol0a, int scol0b, bf16_t* __restrict__ dst, int K, int n0,
                 unsigned char* smem) {
  float* t = (float*)smem;
  const int tid = tid_();
  {
    const int kk = tid >> 4, c4 = (tid & 15) * 4;
    const int sc = (c4 < 32) ? (scol0a + c4) : (scol0b + c4 - 32);
#pragma unroll
    for (int i = 0; i < 4; ++i) {
      const int k = kk + i * 16;
      float4 v = *(const float4*)(src + (size_t)(k0 + k) * ldsrc + sc);
      t[k * 65 + c4 + 0] = v.x; t[k * 65 + c4 + 1] = v.y; t[k * 65 + c4 + 2] = v.z; t[k * 65 + c4 + 3] = v.w;
    }
  }
  __syncthreads();
  {
    const int n = tid >> 2, kq = (tid & 3) * 16;
    unsigned o[8];
#pragma unroll
    for (int j = 0; j < 8; ++j) o[j] = pack2(t[(kq + 2 * j) * 65 + n], t[(kq + 2 * j + 1) * 65 + n]);
    bf16_t* d = dst + (size_t)(n0 + n) * K + k0 + kq;
    *(uint4*)d = make_uint4(o[0], o[1], o[2], o[3]);
    *(uint4*)(d + 8) = make_uint4(o[4], o[5], o[6], o[7]);
  }
  __syncthreads();
}
constexpr int CVT_ITEMS = 2112 + 384 + 256 + 1408 + 704;
DI void cvt_item(const Params& p, int l, int it, unsigned char* smem) {
  unsigned char* ws = ((unsigned char*)(__attribute__((address_space(1))) unsigned char*)karg(21));
  if (it < 2112) {
    const int kt = it & 15, nt = it >> 4;
    int ca, cb;
    if (nt < 16) { ca = 32 * nt; cb = 512 + 32 * nt; }
    else if (nt < 32) { ca = 32 * (nt - 16); cb = 1024 + 32 * (nt - 16); }
    else { ca = 64 * (nt - 32) + 1536; cb = ca + 32; }
    cvt_tile(((const float*)(const __attribute__((address_space(1))) float*)karg(8)) + (size_t)l * D * INW, INW, kt * 64, ca, cb, (bf16_t*)(ws + O_WIN), D, nt * 64, smem);
    return;
  }
  it -= 2112;
  if (it < 384) {
    const int kb = it / 128, r = it % 128, kt = r & 7, nt = r >> 3;
    cvt_tile(((const float*)(const __attribute__((address_space(1))) float*)karg(16)) + ((size_t)l * 3 + kb) * 512 * D, D, kt * 64, nt * 64, nt * 64 + 32, (bf16_t*)(ws + O_WBR) + (size_t)kb * D * 512, 512, nt * 64, smem);
    return;
  }
  it -= 384;
  if (it < 256) {
    const int kt = it & 15, nt = it >> 4;
    cvt_tile(((const float*)(const __attribute__((address_space(1))) float*)karg(17)) + (size_t)l * D * D, D, kt * 64, nt * 64, nt * 64 + 32, (bf16_t*)(ws + O_WOUT), D, nt * 64, smem);
    return;
  }
  it -= 256;
  if (it < 1408) {
    const int kt = it & 15, nt = it >> 4;
    const int tile = nt >> 1, wn = nt & 1;
    const int hid = tile * 64 + wn * 32;
    cvt_tile(((const float*)(const __attribute__((address_space(1))) float*)karg(18)) + (size_t)l * D * GU, GU, kt * 64, hid, FH + hid, (bf16_t*)(ws + O_WGU), D, nt * 64, smem);
    return;
  }
  it -= 1408;
  {
    const int kt = it % 44, nt = it / 44;
    cvt_tile(((const float*)(const __attribute__((address_space(1))) float*)karg(19)) + (size_t)l * FH * D, D, kt * 64, nt * 64, nt * 64 + 32, (bf16_t*)(ws + O_WD), FH, nt * 64, smem);
  }
}
DI void mod_item(const Params& p, int it, unsigned char* smem) {
  float* sc = (float*)smem;
  float* red = sc + 5 * 1024;
  const int tid = tid_();
  const int l = it / 192, cb = it % 192;
  for (int i = tid; i < 5 * 1024; i += 256) {
    const int r = i >> 10, k = i & 1023;
    const float v = (r < 4) ? ((const float*)(const __attribute__((address_space(1))) float*)karg(1))[r * 1024 + k] : ((const float*)(const __attribute__((address_space(1))) float*)karg(3))[k];
    sc[i] = siluf_(v);
  }
  __syncthreads();
  const int c = tid & 31, kg = tid >> 5;
  const int col = cb * 32 + c;
  const float* w = ((const float*)(const __attribute__((address_space(1))) float*)karg(4)) + (size_t)l * D * 6144 + col;
  float a0 = 0, a1 = 0, a2 = 0, a3 = 0, a4 = 0;
#pragma unroll 8
  for (int k = kg * 128; k < kg * 128 + 128; ++k) {
    const float wv = w[(size_t)k * 6144];
    a0 += sc[k] * wv; a1 += sc[1024 + k] * wv; a2 += sc[2048 + k] * wv; a3 += sc[3072 + k] * wv; a4 += sc[4096 + k] * wv;
  }
  red[(kg * 5 + 0) * 32 + c] = a0; red[(kg * 5 + 1) * 32 + c] = a1; red[(kg * 5 + 2) * 32 + c] = a2;
  red[(kg * 5 + 3) * 32 + c] = a3; red[(kg * 5 + 4) * 32 + c] = a4;
  __syncthreads();
  if (tid < 160) {
    const int r = tid >> 5, cc = tid & 31;
    float s = 0;
#pragma unroll
    for (int g = 0; g < 8; ++g) s += red[(g * 5 + r) * 32 + cc];
    const int colo = cb * 32 + cc;
    float* modf = (float*)(((unsigned char*)(__attribute__((address_space(1))) unsigned char*)karg(21)) + O_MOD);
    modf[((size_t)l * 5 + r) * 6144 + colo] = s + ((const float*)(const __attribute__((address_space(1))) float*)karg(5))[l * 6144 + colo];
  }
  __syncthreads();
}

DI const float* xrow_ptr(const Params& p, int l, int stage, int row) {
  const int b = row / PT, q = row % PT;
  if (q < CL) {
    const size_t o = ((size_t)b * CL + q) * D;
    return (l == 0 && stage == 0) ? ((const float*)(const __attribute__((address_space(1))) float*)karg(2)) + o : (const float*)(((unsigned char*)(__attribute__((address_space(1))) unsigned char*)karg(21)) + O_XC) + o;
  }
  const size_t o = ((size_t)b * SEQ + (q - CL)) * D;
  return (l == 0 && stage == 0) ? ((const float*)(const __attribute__((address_space(1))) float*)karg(0)) + o : ((float*)(__attribute__((address_space(1))) float*)karg(20)) + o;
}
DI void norm_row(const Params& p, int l, int stage, int row, const float* __restrict__ nw, int shoff, int scoff) {
  const int lane = tid_() & 63;
  const float* xr = xrow_ptr(p, l, stage, row);
  const int b = row / PT, q = row % PT;
  const float* modf = (const float*)(((unsigned char*)(__attribute__((address_space(1))) unsigned char*)karg(21)) + O_MOD) + ((size_t)l * 5 + (q < CL ? 4 : b)) * 6144;
  float4 v[4];
  float ss = 0.f;
#pragma unroll
  for (int i = 0; i < 4; ++i) {
    v[i] = *(const float4*)(xr + i * 256 + lane * 4);
    ss += v[i].x * v[i].x + v[i].y * v[i].y + v[i].z * v[i].z + v[i].w * v[i].w;
  }
#pragma unroll
  for (int m = 1; m < 64; m <<= 1) ss += shx(ss, m);
  const float rs = rsqrtf(ss * (1.f / 1024.f) + EPS);
  bf16_t* dst = (bf16_t*)(((unsigned char*)(__attribute__((address_space(1))) unsigned char*)karg(21)) + O_UO) + (size_t)row * 1024;
#pragma unroll
  for (int i = 0; i < 4; ++i) {
    const int k = i * 256 + lane * 4;
    const float4 wv = *(const float4*)(nw + k);
    const float4 sc = *(const float4*)(modf + scoff + k);
    const float4 sh = *(const float4*)(modf + shoff + k);
    const float y0 = v[i].x * rs * wv.x * (1.f + sc.x) + sh.x;
    const float y1 = v[i].y * rs * wv.y * (1.f + sc.y) + sh.y;
    const float y2 = v[i].z * rs * wv.z * (1.f + sc.z) + sh.z;
    const float y3 = v[i].w * rs * wv.w * (1.f + sc.w) + sh.w;
    *(uint2*)(dst + k) = make_uint2(pack2(y0, y1), pack2(y2, y3));
  }
}

DI void store4T(bf16_t* base, float a, float b, float c, float d) { *(uint2*)base = make_uint2(pack2(a, b), pack2(c, d)); }

DI void inproj_epilogue(const Params& p, int l, f32x16 (&acc)[2][2], int m0w, int n0w) {
  unsigned char* ws = ((unsigned char*)(__attribute__((address_space(1))) unsigned char*)karg(21));
  const int lane = tid_() & 63, ln = lane & 31, h = lane >> 5;
  if (n0w < 2048) {
    const int dir = n0w >> 10, ch = ((n0w & 1023) >> 6) * 32 + ln;
    float lb = 0.f;
    if (l == 1) {
      const float* lbr = ((const float*)(const __attribute__((address_space(1))) float*)karg(9));
      lb = fminf(sigmoidf_(lbr[(2 + dir) * 512 + ch] - lbr[dir * 512 + ch]), 1.f - 1e-6f);
    }
    bf16_t* qd = (bf16_t*)(ws + (dir ? O_QHB : O_QHF));
    bf16_t* kd = (bf16_t*)(ws + (dir ? O_KTB : O_KTF));
    float* ebl = (float*)(ws + O_EBL) + (size_t)dir * (NT / 32) * 512;
#pragma unroll
    for (int i = 0; i < 2; ++i) {
      const int r0 = m0w + i * 32;
      float kk[16], g2[16], gs[4], gp[4];
#pragma unroll
      for (int r = 0; r < 16; ++r) {
        kk[r] = (1.f - lb) * sigmoidf_(-acc[i][1][r]);
        g2[r] = __log2f(fmaxf(1.f - kk[r], 1e-30f));
      }
#pragma unroll
      for (int rg = 0; rg < 4; ++rg) { gs[rg] = (g2[rg * 4] + g2[rg * 4 + 1]) + (g2[rg * 4 + 2] + g2[rg * 4 + 3]); gp[rg] = shx(gs[rg], 32); }
      const float total = ((gs[0] + gp[0]) + (gs[1] + gp[1])) + ((gs[2] + gp[2]) + (gs[3] + gp[3]));
      float pre = 0.f;
#pragma unroll
      for (int rg = 0; rg < 4; ++rg) {
        float run = pre + (h ? gp[rg] : 0.f);
#pragma unroll
        for (int i4 = 0; i4 < 4; ++i4) {
          const int r = rg * 4 + i4;
          run += g2[r];
          const float bj = dir ? (total - run + g2[r]) : run;
          const size_t o = (size_t)(r0 + rg * 8 + h * 4 + i4) * 512 + ch;
          qd[o] = tobf(acc[i][0][r] * 0.08838834764831845f * __builtin_amdgcn_exp2f(bj));
          kd[o] = tobf(kk[r] * __builtin_amdgcn_exp2f(fminf(-bj, 115.f)));
        }
        pre += gs[rg] + gp[rg];
      }
      if (h == 0) ebl[(size_t)(r0 >> 5) * 512 + ch] = __builtin_amdgcn_exp2f(total);
    }
    return;
  }
  if (n0w < 2560) {
    bf16_t* vt = (bf16_t*)(ws + O_VA);
#pragma unroll
    for (int i = 0; i < 2; ++i)
#pragma unroll
      for (int rg = 0; rg < 4; ++rg) {
        const int row = m0w + i * 32 + rg * 8 + h * 4;
        const int b = row / PT, q = row % PT;
#pragma unroll
        for (int j = 0; j < 2; ++j) {
          const int ch = (n0w & 511) + j * 32 + ln;
          store4T(vt + ((size_t)b * 512 + ch) * PT + q, acc[i][j][rg * 4 + 0], acc[i][j][rg * 4 + 1], acc[i][j][rg * 4 + 2], acc[i][j][rg * 4 + 3]);
        }
      }
    return;
  }
  if (n0w < 3072) {
    bf16_t* dst = (bf16_t*)(ws + O_OG);
    const int cg0 = n0w & 511;
#pragma unroll
    for (int j = 0; j < 2; ++j)
#pragma unroll
      for (int i = 0; i < 2; ++i)
#pragma unroll
        for (int r = 0; r < 16; ++r) {
          const int row = m0w + i * 32 + (r >> 2) * 8 + h * 4 + (r & 3);
          dst[(size_t)row * 512 + cg0 + j * 32 + ln] = tobf(acc[i][j][r]);
        }
    return;
  }
  n0w -= 512;
  int kind, head;
  if (n0w < 3072) { kind = 0; head = (n0w - 2560) >> 6; }
  else if (n0w < 3200) { kind = 1; head = (n0w - 3072) >> 6; }
  else if (n0w < 3328) { kind = 2; head = (n0w - 3200) >> 6; }
  else if (n0w < 3840) { kind = 3; head = (n0w - 3328) >> 6; }
  else if (n0w < 4352) { kind = 4; head = (n0w - 3840) >> 6; }
  else { kind = 5; head = (n0w - 4352) >> 6; }
  if (kind == 2 || kind == 5) {
    bf16_t* vt = (bf16_t*)(ws + (kind == 2 ? O_BVT : O_CVT));
    const int nch = (kind == 2) ? 128 : 512;
#pragma unroll
    for (int i = 0; i < 2; ++i)
#pragma unroll
      for (int rg = 0; rg < 4; ++rg) {
        const int row = m0w + i * 32 + rg * 8 + h * 4;
        const int b = row / PT, q = row % PT;
#pragma unroll
        for (int j = 0; j < 2; ++j) {
          const int ch = head * 64 + j * 32 + ln;
          store4T(vt + ((size_t)b * nch + ch) * PT + q, acc[i][j][rg * 4 + 0], acc[i][j][rg * 4 + 1], acc[i][j][rg * 4 + 2], acc[i][j][rg * 4 + 3]);
        }
      }
    return;
  }
  const float* nwp = (kind == 0 ? ((const float*)(const __attribute__((address_space(1))) float*)karg(11)) : kind == 1 ? ((const float*)(const __attribute__((address_space(1))) float*)karg(12)) : kind == 3 ? ((const float*)(const __attribute__((address_space(1))) float*)karg(13)) : ((const float*)(const __attribute__((address_space(1))) float*)karg(14))) + l * 64;
  const float nw0 = nwp[ln], nw1 = nwp[32 + ln];
  const float qscale = (kind == 0 || kind == 3) ? 0.125f * 1.4426950408889634f : 1.f;
  const bool rope = (kind <= 1);
  const float* ropet = (const float*)(ws + O_ROPE);
  bf16_t* dst; int dstride;
  if (kind == 0) { dst = (bf16_t*)(ws + O_BQ); dstride = 512; }
  else if (kind == 1) { dst = (bf16_t*)(ws + O_BK); dstride = 128; }
  else if (kind == 3) { dst = (bf16_t*)(ws + O_CQ); dstride = 512; }
  else { dst = (bf16_t*)(ws + O_CK); dstride = 512; }
#pragma unroll
  for (int i = 0; i < 2; ++i)
#pragma unroll
    for (int r = 0; r < 16; ++r) {
      const int row = m0w + i * 32 + (r >> 2) * 8 + h * 4 + (r & 3);
      float v0 = acc[i][0][r], v1 = acc[i][1][r];
      float ss = v0 * v0 + v1 * v1;
      ss += shx(ss, 1); ss += shx(ss, 2); ss += shx(ss, 4); ss += shx(ss, 8); ss += shx(ss, 16);
      const float rs = rsqrtf(ss * (1.f / 64.f) + EPS);
      v0 = v0 * rs * nw0; v1 = v1 * rs * nw1;
      if (rope) {
        const int q = row % PT;
        const float p0 = shx(v0, 1), p1 = shx(v1, 1);
        if (q >= CL) {
          const int t = q - CL, gr = t >> 6, gc = t & 63;
          const int fj = ln >> 1;
          const float2 cs0 = *(const float2*)(ropet + (gr * 16 + fj) * 2);
          const float2 cs1 = *(const float2*)(ropet + (gc * 16 + fj) * 2);
          if (ln & 1) { v0 = p0 * cs0.y + v0 * cs0.x; v1 = p1 * cs1.y + v1 * cs1.x; }
          else { v0 = v0 * cs0.x - p0 * cs0.y; v1 = v1 * cs1.x - p1 * cs1.y; }
        }
      }
      dst[(size_t)row * dstride + head * 64 + ln] = tobf(v0 * qscale);
      dst[(size_t)row * dstride + head * 64 + 32 + ln] = tobf(v1 * qscale);
    }
}

constexpr int AQS = 136, ATS = 40;
constexpr int A_QH = 0, A_KT = A_QH + 32 * AQS * 2, A_KBT = A_KT + 32 * AQS * 2, A_VT = A_KBT + 128 * ATS * 2, A_EBL = A_VT + 128 * ATS * 2;
DI bf16x8 pack8(const f32x16& x, int o) {
  return __builtin_bit_cast(bf16x8, make_uint4(pack2(x[o + 0], x[o + 1]), pack2(x[o + 2], x[o + 3]), pack2(x[o + 4], x[o + 5]), pack2(x[o + 6], x[o + 7])));
}
template <int DIR> DI int ac_tb(int c) {
  const int s = c * 32;
  return DIR == 0 ? s : (s < CL ? (CL - 32 - s) : (PT + CL - 32 - s));
}
constexpr int A_VT2 = A_EBL + 512, A_EBL2 = A_VT2 + 128 * ATS * 2;
template <int DIR> DI void a_chunk_run(unsigned char* ws, int b, int hd, unsigned char* smem) {
  const int tid = tid_(), lane = tid & 63, w = tid >> 6, ln = lane & 31, hh = lane >> 5;
  const int kc = tid >> 1, half = tid & 1;
  const int sj = tid >> 3, cg = tid & 7;
  const size_t rb = (size_t)b * PT;
  const bf16_t* qg = (const bf16_t*)(ws + (DIR ? O_QHB : O_QHF)) + (rb + sj) * 512 + hd * 128 + cg * 16;
  const bf16_t* kg = (const bf16_t*)(ws + (DIR ? O_KTB : O_KTF)) + (rb + sj) * 512 + hd * 128 + cg * 16;
  const bf16_t* vg = (const bf16_t*)(ws + O_VA) + ((size_t)b * 512 + hd * 128 + kc) * PT + half * 16;
  const float* eg = (const float*)(ws + O_EBL) + (size_t)DIR * (NT / 32) * 512 + hd * 128 + kc;
  bf16_t* og = (bf16_t*)(ws + (DIR ? O_QHB : O_QHF)) + rb * 512 + hd * 128 + w * 32 + ln;
  bf16_t* Qh = (bf16_t*)(smem + A_QH); bf16_t* Kt = (bf16_t*)(smem + A_KT);
  bf16_t* KtT = (bf16_t*)(smem + A_KBT);
  f32x16 S0, S1, S2, S3;
#pragma unroll
  for (int r = 0; r < 16; ++r) { S0[r] = 0.f; S1[r] = 0.f; S2[r] = 0.f; S3[r] = 0.f; }
  uint4 q0, q1, k0, k1, v0, v1;
  float pe;
#define A_PREFETCH(cc) { const int tb_ = ac_tb<DIR>(cc); \
    q0 = *(const uint4*)(qg + (size_t)tb_ * 512); q1 = *(const uint4*)(qg + (size_t)tb_ * 512 + 8); \
    k0 = *(const uint4*)(kg + (size_t)tb_ * 512); k1 = *(const uint4*)(kg + (size_t)tb_ * 512 + 8); \
    v0 = *(const uint4*)(vg + tb_); v1 = *(const uint4*)(vg + tb_ + 8); \
    pe = eg[(size_t)((rb + tb_) >> 5) * 512]; }
  A_PREFETCH(0)
#pragma unroll 1
  for (int c = 0; c < PT / 32; ++c) {
    bf16_t* Vt = (bf16_t*)(smem + ((c & 1) ? A_VT2 : A_VT));
    float* ebl = (float*)(smem + ((c & 1) ? A_EBL2 : A_EBL));
    *(uint4*)(Qh + sj * AQS + cg * 16) = q0; *(uint4*)(Qh + sj * AQS + cg * 16 + 8) = q1;
    *(uint4*)(Kt + sj * AQS + cg * 16) = k0; *(uint4*)(Kt + sj * AQS + cg * 16 + 8) = k1;
    *(uint4*)(Vt + kc * ATS + half * 16) = v0; *(uint4*)(Vt + kc * ATS + half * 16 + 8) = v1;
    if (half == 0) ebl[kc] = pe;
    __syncthreads();
    A_PREFETCH(min(c + 1, PT / 32 - 1))
    unsigned short kt16[16];
#pragma unroll
    for (int jj = 0; jj < 16; ++jj) kt16[jj] = Kt[(half * 16 + jj) * AQS + kc];
    bf16x8 fa[8], fq[8], qi[8], vi[2], vs[2];
#pragma unroll
    for (int ks = 0; ks < 8; ++ks) {
      fa[ks] = *(const bf16x8*)(Kt + ln * AQS + ks * 16 + hh * 8);
      fq[ks] = *(const bf16x8*)(Qh + ln * AQS + ks * 16 + hh * 8);
    }
    __builtin_amdgcn_sched_barrier(0);
    f32x16 at, o;
#pragma unroll
    for (int r = 0; r < 16; ++r) { at[r] = 0.f; o[r] = 0.f; }
#pragma unroll
    for (int ks = 0; ks < 8; ++ks) at = MFMA(fa[ks], fq[ks], at);
#pragma unroll
    for (int i = 0; i < 8; ++i) {
      const s16x4 lo = *(const s16x4*)(Qh + ln * AQS + (i >> 1) * 32 + 16 * (i & 1) + 4 * hh);
      const s16x4 hi = *(const s16x4*)(Qh + ln * AQS + (i >> 1) * 32 + 16 * (i & 1) + 4 * hh + 8);
      qi[i] = __builtin_shufflevector(lo, hi, 0, 1, 2, 3, 4, 5, 6, 7);
    }
#pragma unroll
    for (int st = 0; st < 2; ++st) {
      const s16x4 lo = *(const s16x4*)(Vt + (w * 32 + ln) * ATS + 16 * st + 4 * hh);
      const s16x4 hi = *(const s16x4*)(Vt + (w * 32 + ln) * ATS + 16 * st + 4 * hh + 8);
      vi[st] = __builtin_shufflevector(lo, hi, 0, 1, 2, 3, 4, 5, 6, 7);
      vs[st] = *(const bf16x8*)(Vt + (w * 32 + ln) * ATS + st * 16 + hh * 8);
    }
    __builtin_amdgcn_sched_barrier(0);
    o = MFMA(qi[0], pack8(S0, 0), o); o = MFMA(qi[1], pack8(S0, 8), o);
    o = MFMA(qi[2], pack8(S1, 0), o); o = MFMA(qi[3], pack8(S1, 8), o);
    o = MFMA(qi[4], pack8(S2, 0), o); o = MFMA(qi[5], pack8(S2, 8), o);
    o = MFMA(qi[6], pack8(S3, 0), o); o = MFMA(qi[7], pack8(S3, 8), o);
#pragma unroll
    for (int r = 0; r < 16; ++r) {
      const int s_ = (r >> 2) * 8 + hh * 4 + (r & 3);
      at[r] = (DIR == 0 ? (s_ <= ln) : (s_ >= ln)) ? at[r] : 0.f;
    }
    o = MFMA(pack8(at, 0), vi[0], o);
    o = MFMA(pack8(at, 8), vi[1], o);
    {
      unsigned kkp[8];
#pragma unroll
      for (int i = 0; i < 8; ++i) kkp[i] = (unsigned)kt16[2 * i] | ((unsigned)kt16[2 * i + 1] << 16);
      *(uint4*)(KtT + kc * ATS + half * 16) = make_uint4(kkp[0], kkp[1], kkp[2], kkp[3]);
      *(uint4*)(KtT + kc * ATS + half * 16 + 8) = make_uint4(kkp[4], kkp[5], kkp[6], kkp[7]);
    }
    {
      bf16_t* oc = og + (size_t)ac_tb<DIR>(c) * 512;
#pragma unroll
      for (int r = 0; r < 16; ++r) { const int t = (r >> 2) * 8 + hh * 4 + (r & 3); oc[t * 512] = tobf(o[r]); }
    }
    __syncthreads();
    bf16x8 ka[8];
    float4 ev[16];
#pragma unroll
    for (int i = 0; i < 8; ++i) ka[i] = *(const bf16x8*)(KtT + ((i >> 1) * 32 + ln) * ATS + (i & 1) * 16 + hh * 8);
#pragma unroll
    for (int i = 0; i < 16; ++i) ev[i] = *(const float4*)(ebl + (i >> 2) * 32 + (i & 3) * 8 + hh * 4);
    __builtin_amdgcn_sched_barrier(0);
    S0 = MFMA(ka[0], vs[0], S0); S1 = MFMA(ka[2], vs[0], S1); S2 = MFMA(ka[4], vs[0], S2); S3 = MFMA(ka[6], vs[0], S3);
    S0 = MFMA(ka[1], vs[1], S0); S1 = MFMA(ka[3], vs[1], S1); S2 = MFMA(ka[5], vs[1], S2); S3 = MFMA(ka[7], vs[1], S3);
#define A_SCALE(SK, kb) { \
      _Pragma("unroll") for (int rg = 0; rg < 4; ++rg) { \
        const float4 e = ev[(kb) * 4 + rg]; \
        SK[rg * 4 + 0] *= e.x; SK[rg * 4 + 1] *= e.y; SK[rg * 4 + 2] *= e.z; SK[rg * 4 + 3] *= e.w; } }
    A_SCALE(S0, 0) A_SCALE(S1, 1) A_SCALE(S2, 2) A_SCALE(S3, 3)
  }
  __syncthreads();
}
DI void a_chunk_item(unsigned char* ws, int it, unsigned char* smem) {
  const int dir = it & 1, hd = (it >> 1) & 3, b = it >> 3;
  __builtin_amdgcn_s_setprio(2);
  if (dir == 0) a_chunk_run<0>(ws, b, hd, smem); else a_chunk_run<1>(ws, b, hd, smem);
  __builtin_amdgcn_s_setprio(0);
}

struct AttnArgs {
  float m0;
  bf16_t* q;
  const bf16_t* k; int kstride;
  const bf16_t* vt;
  int kbase_row;
  int qrow;
  int ntiles, nwin, win_p0;
  int mode;
  int gr, r0w, cb, krow0;
  const float* bias;
};
DI void attn_run(const AttnArgs& a, unsigned char* smem) {
  const int tid = tid_(), lane = tid & 63, ln = lane & 31, h = lane >> 5;
  bf16_t* sk = (bf16_t*)smem;
  bf16_t* sv = sk + 2 * 64 * LSTR;
  bf16x8 qf[4];
  {
    const bf16_t* qp = a.q + (size_t)(a.qrow + ln) * 512 + h * 8;
#pragma unroll
    for (int ks = 0; ks < 4; ++ks) qf[ks] = *(const bf16x8*)(qp + ks * 16);
  }
  f32x16 o0, o1;
#pragma unroll
  for (int r = 0; r < 16; ++r) { o0[r] = 0.f; o1[r] = 0.f; }
  float lrun = 0.f;
  const int lrow = tid >> 3, lc = (tid & 7) * 8;
  uint4 rk0, rk1, rv0, rv1;
#define TILE_P0(i) ((i) < a.nwin ? a.win_p0 + (i) * 64 : ((i) - a.nwin) * 64)
#define GLOAD(i) { const int p0_ = TILE_P0(i); \
    rk0 = *(const uint4*)(a.k + (size_t)(a.kbase_row + p0_ + lrow) * a.kstride + lc); \
    rk1 = *(const uint4*)(a.k + (size_t)(a.kbase_row + p0_ + lrow + 32) * a.kstride + lc); \
    rv0 = *(const uint4*)(a.vt + (size_t)(lrow) * PT + p0_ + lc); \
    rv1 = *(const uint4*)(a.vt + (size_t)(lrow + 32) * PT + p0_ + lc); }
#define SSTORE(buf_) { \
    *(uint4*)(sk + (buf_) * 64 * LSTR + (lrow) * LSTR + lc) = rk0; \
    *(uint4*)(sk + (buf_) * 64 * LSTR + (lrow + 32) * LSTR + lc) = rk1; \
    *(uint4*)(sv + (buf_) * 64 * LSTR + (lrow) * LSTR + lc) = rv0; \
    *(uint4*)(sv + (buf_) * 64 * LSTR + (lrow + 32) * LSTR + lc) = rv1; }
  GLOAD(0);
  SSTORE(0);
  __syncthreads();
  for (int it = 0; it < a.ntiles; ++it) {
    const int buf = it & 1;
    GLOAD(min(it + 1, a.ntiles - 1));
    asm volatile("" ::: "memory");
    __builtin_amdgcn_sched_barrier(0);
    bool active = true;
    int krow = 0;
    const bool win = (a.mode == 1 && it < a.nwin);
    if (win) { krow = a.krow0 + it; active = (krow >= a.r0w && krow < a.r0w + 8); }
    if (active) {
      const bf16_t* ks_ = sk + buf * 64 * LSTR + ln * LSTR + h * 8;
      f32x16 s0, s1;
#pragma unroll
      for (int r = 0; r < 16; ++r) { s0[r] = -a.m0; s1[r] = -a.m0; }
#pragma unroll
      for (int ks = 0; ks < 4; ++ks) {
        bf16x8 a0 = *(const bf16x8*)(ks_ + ks * 16);
        bf16x8 a1 = *(const bf16x8*)(ks_ + 32 * LSTR + ks * 16);
        s0 = MFMA(a0, qf[ks], s0);
        s1 = MFMA(a1, qf[ks], s1);
      }
      if (win) {
        const int qc = a.cb + ln;
        const int c0 = min(max(qc - 8, 0), 48);
        const float* brow = a.bias + (krow - a.gr + 7) * 31 + 15 - qc;
#pragma unroll
        for (int r = 0; r < 16; ++r) {
          const int kc0 = (r >> 2) * 8 + h * 4 + (r & 3);
          const int kc1 = kc0 + 32;
          s0[r] = (kc0 >= c0 && kc0 < c0 + 16) ? s0[r] + brow[kc0] : -1e30f;
          s1[r] = (kc1 >= c0 && kc1 < c0 + 16) ? s1[r] + brow[kc1] : -1e30f;
        }
      }
#pragma unroll
      for (int r = 0; r < 16; ++r) { s0[r] = __builtin_amdgcn_exp2f(s0[r]); lrun += s0[r]; }
#pragma unroll
      for (int r = 0; r < 16; ++r) { s1[r] = __builtin_amdgcn_exp2f(s1[r]); lrun += s1[r]; }
      const bf16_t* vs_ = sv + buf * 64 * LSTR + ln * LSTR + h * 4;
#pragma unroll
      for (int j = 0; j < 4; ++j) {
        bf16x8 pb;
        {
          unsigned u0, u1, u2, u3;
          if (j < 2) {
            const int b8 = 8 * j;
            u0 = pack2(s0[b8 + 0], s0[b8 + 1]); u1 = pack2(s0[b8 + 2], s0[b8 + 3]);
            u2 = pack2(s0[b8 + 4], s0[b8 + 5]); u3 = pack2(s0[b8 + 6], s0[b8 + 7]);
          } else {
            const int b8 = 8 * (j - 2);
            u0 = pack2(s1[b8 + 0], s1[b8 + 1]); u1 = pack2(s1[b8 + 2], s1[b8 + 3]);
            u2 = pack2(s1[b8 + 4], s1[b8 + 5]); u3 = pack2(s1[b8 + 6], s1[b8 + 7]);
          }
          pb = __builtin_bit_cast(bf16x8, make_uint4(u0, u1, u2, u3));
        }
        const s16x4 lo0 = *(const s16x4*)(vs_ + j * 16);
        const s16x4 hi0 = *(const s16x4*)(vs_ + j * 16 + 8);
        const s16x4 lo1 = *(const s16x4*)(vs_ + 32 * LSTR + j * 16);
        const s16x4 hi1 = *(const s16x4*)(vs_ + 32 * LSTR + j * 16 + 8);
        const bf16x8 av0 = __builtin_shufflevector(lo0, hi0, 0, 1, 2, 3, 4, 5, 6, 7);
        const bf16x8 av1 = __builtin_shufflevector(lo1, hi1, 0, 1, 2, 3, 4, 5, 6, 7);
        o0 = MFMA(av0, pb, o0);
        o1 = MFMA(av1, pb, o1);
      }
    }
    SSTORE(buf ^ 1);
    __syncthreads();
  }
  lrun += shx(lrun, 32);
  const float inv = 1.f / lrun;
  bf16_t* op = a.q + (size_t)(a.qrow + ln) * 512;
#pragma unroll
  for (int rg = 0; rg < 4; ++rg) {
    const int d = rg * 8 + h * 4;
    *(uint2*)(op + d) = make_uint2(pack2(o0[rg * 4 + 0] * inv, o0[rg * 4 + 1] * inv), pack2(o0[rg * 4 + 2] * inv, o0[rg * 4 + 3] * inv));
    *(uint2*)(op + 32 + d) = make_uint2(pack2(o1[rg * 4 + 0] * inv, o1[rg * 4 + 1] * inv), pack2(o1[rg * 4 + 2] * inv, o1[rg * 4 + 3] * inv));
  }
}

DI float wave_max(float v) {
#pragma unroll
  for (int m = 32; m >= 1; m >>= 1) v = fmaxf(v, shx(v, m));
  return v;
}
DI float attn_m0(int qi, int ki, int l) {
  const int lane = tid_() & 63;
  const float* qn = ((const float*)(const __attribute__((address_space(1))) float*)karg(qi)) + l * 64;
  const float* kn = ((const float*)(const __attribute__((address_space(1))) float*)karg(ki)) + l * 64;
  return 8.f * 1.4426950408889634f * 1.02f * wave_max(fabsf(qn[lane])) * wave_max(fabsf(kn[lane]));
}
constexpr int N_A = 32, N_B = 1024, N_C = 1024, N_CTX = 128;
DI void mixer_item(const Params& p, int l, int it, unsigned char* smem) {
  const int w = tid_() >> 6;
  unsigned char* ws = ((unsigned char*)(__attribute__((address_space(1))) unsigned char*)karg(21));
  if (it < N_A) { a_chunk_item(ws, it, smem); return; }
  it -= N_A;
  AttnArgs a;
  a.bias = (const float*)(smem + 4 * 64 * LSTR * 2);
  a.mode = 0; a.gr = 0; a.r0w = 0; a.cb = 0; a.krow0 = 0;
  if (it < N_B) {
    const int hd = it & 7, qb = (it >> 3) & 31, b = it >> 8;
    a.q = (bf16_t*)(ws + O_BQ) + hd * 64;
    a.k = (const bf16_t*)(ws + O_BK) + (hd >> 2) * 64; a.kstride = 128;
    a.vt = (const bf16_t*)(ws + O_BVT) + ((size_t)b * 128 + (hd >> 2) * 64) * PT;
    a.kbase_row = b * PT; a.qrow = b * PT + CL + qb * 128 + w * 32;
    a.ntiles = 68; a.nwin = 68; a.win_p0 = 0;
    a.m0 = attn_m0(11, 12, l);
    attn_run(a, smem);
    return;
  }
  it -= N_B;
  if (it < N_C) {
    const int hd = it & 7, rp = (it >> 3) & 31, b = it >> 8;
    const int g0 = 2 * rp, g1 = 2 * rp + 1;
    const int r00 = min(max(g0 - 4, 0), 56), r01 = min(max(g1 - 4, 0), 56);
    float* bt = (float*)(smem + 4 * 64 * LSTR * 2);
    for (int i = tid_(); i < 465; i += 256) bt[i] = 1.4426950408889634f * ((const float*)(const __attribute__((address_space(1))) float*)karg(15))[((size_t)l * 8 + hd) * 465 + i];
    __syncthreads();
    a.q = (bf16_t*)(ws + O_CQ) + hd * 64;
    a.k = (const bf16_t*)(ws + O_CK) + hd * 64; a.kstride = 512;
    a.vt = (const bf16_t*)(ws + O_CVT) + ((size_t)b * 512 + hd * 64) * PT;
    a.kbase_row = b * PT;
    a.gr = g0 + (w >> 1); a.cb = (w & 1) * 32; a.r0w = (w >> 1) ? r01 : r00; a.krow0 = r00;
    a.qrow = b * PT + CL + a.gr * 64 + a.cb;
    a.nwin = r01 + 8 - r00; a.ntiles = a.nwin + 4; a.win_p0 = CL + r00 * 64;
    a.mode = 1;
    {
      const int lane = tid_() & 63;
      float bm = 0.f;
#pragma unroll
      for (int i = 0; i < 8; ++i) { const int ix = lane + 64 * i; if (ix < 465) bm = fmaxf(bm, fabsf(bt[ix])); }
      a.m0 = attn_m0(13, 14, l) + wave_max(bm);
    }
    attn_run(a, smem);
    return;
  }
  it -= N_C;
  {
    const int hd = it & 7, qb = (it >> 3) & 1, b = (it >> 4) & 3, kc = it >> 6;
    if (kc == 0) {
      a.q = (bf16_t*)(ws + O_BQ) + hd * 64;
      a.k = (const bf16_t*)(ws + O_BK) + (hd >> 2) * 64; a.kstride = 128;
      a.vt = (const bf16_t*)(ws + O_BVT) + ((size_t)b * 128 + (hd >> 2) * 64) * PT;
    } else {
      a.q = (bf16_t*)(ws + O_CQ) + hd * 64;
      a.k = (const bf16_t*)(ws + O_CK) + hd * 64; a.kstride = 512;
      a.vt = (const bf16_t*)(ws + O_CVT) + ((size_t)b * 512 + hd * 64) * PT;
    }
    a.kbase_row = b * PT; a.qrow = b * PT + qb * 128 + w * 32;
    a.ntiles = 4; a.nwin = 4; a.win_p0 = 0;
    a.m0 = (kc == 0) ? attn_m0(11, 12, l) : attn_m0(13, 14, l);
    attn_run(a, smem);
  }
}

DI void readout_row(const Params& p, int l, int row) {
  const int lane = tid_() & 63;
  unsigned char* ws = ((unsigned char*)(__attribute__((address_space(1))) unsigned char*)karg(21));
  bf16_t* og = (bf16_t*)(ws + O_OG) + (size_t)row * 512;
  const uint4 f4 = *(const uint4*)((const bf16_t*)(ws + O_QHF) + (size_t)row * 512 + lane * 8);
  const uint4 b4 = *(const uint4*)((const bf16_t*)(ws + O_QHB) + (size_t)row * 512 + lane * 8);
  const uint4 g4 = *(const uint4*)(og + lane * 8);
  const unsigned ff[4] = {f4.x, f4.y, f4.z, f4.w}, bb[4] = {b4.x, b4.y, b4.z, b4.w}, gg[4] = {g4.x, g4.y, g4.z, g4.w};
  float o[8];
  float ss = 0.f;
#pragma unroll
  for (int i = 0; i < 4; ++i) {
    o[2 * i] = bflo(ff[i]) + bflo(bb[i]);
    o[2 * i + 1] = bfhi(ff[i]) + bfhi(bb[i]);
    ss += o[2 * i] * o[2 * i] + o[2 * i + 1] * o[2 * i + 1];
  }
  ss += shx(ss, 1); ss += shx(ss, 2); ss += shx(ss, 4); ss += shx(ss, 8);
  const float rs = rsqrtf(ss * (1.f / 128.f) + EPS);
  const float* gn = ((const float*)(const __attribute__((address_space(1))) float*)karg(10)) + l * 128 + (lane & 15) * 8;
  unsigned outp[4];
#pragma unroll
  for (int i = 0; i < 4; ++i) {
    const float g0 = bflo(gg[i]), g1 = bfhi(gg[i]);
    outp[i] = pack2(o[2 * i] * rs * gn[2 * i] * siluf_(g0), o[2 * i + 1] * rs * gn[2 * i + 1] * siluf_(g1));
  }
  *(uint4*)(og + lane * 8) = make_uint4(outp[0], outp[1], outp[2], outp[3]);
}

DI bool xcd_tile(int seq, int bid, int nblk, int MX, int NX, int& mt, int& nt) {
  const int per = nblk >> 3, li = bid >> 3, x = bid & 7;
  const int u = li + seq * per;
  if (u >= MX * NX) return false;
  const int FM = MX >> 3, fullsz = 8 * NX;
  int mgi, r, gm;
  if (u < FM * fullsz) { mgi = u / fullsz; r = u - mgi * fullsz; gm = 8; }
  else { mgi = FM; r = u - FM * fullsz; gm = MX & 7; }
  const int ngi = r / (gm * 8), r2 = r - ngi * gm * 8;
  const int nj = r2 / gm, mi = r2 - nj * gm;
  mt = x * MX + mgi * 8 + mi;
  nt = ngi * 8 + nj;
  return true;
}
DI int mtile_row0(int l, int mt) { return l == 0 ? mt * 128 : ((mt >> 5) * PT + CL + (mt & 31) * 128); }

#ifndef SKIPM
#define SKIPM 0
#endif
#ifdef PROBE_REP
__device__ const unsigned char PSEQ[] = {0, 1, 2, PROBE_R(2) 3, 4, 5, PROBE_R(5) 6, 7, 8, PROBE_R(8) 9, 10, 11, PROBE_R(11) 12, 13, 14, PROBE_R(14) 15, 16, 17, PROBE_R(17) 18};
#else
__device__ const unsigned char PSEQ[] = {0, 1, 2, 3, 4, 5, 6, 7, 8, 9, 10, 11, 12, 13, 14, 15, 16, 17, 18};
#endif
constexpr int NSEQ = sizeof(PSEQ);
#define OPAQUE_S(x) asm volatile("" : "+s"(x))
__global__ void __launch_bounds__(256, 2) fwd_megakernel(Params p) {
  extern __shared__ __attribute__((aligned(16))) unsigned char smem[];
  __shared__ __attribute__((aligned(16))) unsigned sh_words[8];
#define s_item (((int*)sh_words)[4])
#define s_key (((int*)sh_words)[5])
  cg::grid_group grid = cg::this_grid();
  const int nblk = gridDim.x, bid = blockIdx.x;
  if (threadIdx.x == 0) { sh_words[0] = 0u; sh_words[1] = 0u; sh_words[2] = 0u; sh_words[3] = 0u; }
  __syncthreads();
  (void)xcd_barrier_post((unsigned*)(((unsigned char*)(__attribute__((address_space(1))) unsigned char*)karg(21)) + O_BAR), (volatile LAS unsigned*)sh_words);

  for (int pi = 0; pi < NSEQ; ++pi) {
    const int ph = PSEQ[pi];
    const int tid = tid_(), lane = tid & 63, w = tid >> 6, wm = w >> 1, wn = w & 1;
    unsigned char* ws = ((unsigned char*)(__attribute__((address_space(1))) unsigned char*)karg(21));
    const int l = (ph - 1) / 9, k = (ph == 0) ? -1 : (ph - 1) % 9;
    const int nmt = (l == 0) ? 136 : 128;
    if (k == -1 && !(SKIPM & 1)) {
      int* ctr = (int*)(ws + O_CTR);
      for (int i = bid * 256 + tid; i < 64 + 4 * 4096; i += nblk * 256) ctr[i] = 0;
      if (bid == 1 || nblk == 1) {
        float* ropet = (float*)(ws + O_ROPE);
        for (int i = tid; i < 1024; i += 256) {
          const int pos = i >> 4, j = i & 15;
          const float inv = exp2f(-(float)j * (13.287712379549449f / 16.f));
          const float ang = (float)pos * inv;
          ropet[i * 2] = __cosf(ang); ropet[i * 2 + 1] = __sinf(ang);
        }
      }
      for (int it = bid; it < 384 + CVT_ITEMS; it += nblk) {
        if (it < 384) mod_item(p, it, smem); else cvt_item(p, 0, it - 384, smem);
      }
    } else if (k == 0 && !(SKIPM & 2)) {
      if (l == 1) for (int it = bid; it < CVT_ITEMS; it += nblk) cvt_item(p, 1, it, smem);
      for (int row = bid * 4 + w; row < NT; row += nblk * 4) norm_row(p, l, 0, row, ((const float*)(const __attribute__((address_space(1))) float*)karg(6)) + l * 1024, 0, 1024);
    } else if (k == 1 && !(SKIPM & 4)) {
      for (int sq = 0;; ++sq) {
        int mt, nt;
        if (!xcd_tile(sq, bid, nblk, 17, 42, mt, nt)) break;
        f32x16 acc[2][2];
        zero_acc(acc);
        gemm_tile((const bf16_t*)(ws + O_UO) + (size_t)mt * 128 * 1024, 1024, (const bf16_t*)(ws + O_WIN) + (size_t)nt * 128 * 1024, 1024, 1024, acc, smem);
        inproj_epilogue(p, l, acc, mt * 128 + wm * 64, nt * 128 + wn * 64);
      }
    } else if (k == 2 && !(SKIPM & 8)) {
      int* ctr = (int*)(ws + O_CTR);
      const int nattn = N_B + N_C + (l == 0 ? N_CTX : 0);
      if (tid == 0) {
        const unsigned hw = __builtin_amdgcn_s_getreg(4 | (31 << 11));
        const unsigned xcc = __builtin_amdgcn_s_getreg(20 | (31 << 11));
        const int key = (int)(((xcc & 15u) << 8) | ((hw >> 8) & 255u));
        int* cuflag = ctr + 64 + 2 * 4096 + l * 4096 + key;
        const int r = atomicAdd(ctr + 64 + l * 4096 + key, 1);
        int item = -1;
        if (r == 0) {
          const int it = atomicAdd(ctr + l * 2 + 0, 1);
          if (it < N_A) { item = it; atomicExch(cuflag, 1); } else atomicExch(cuflag, 2);
        } else {
          for (int spin = 0; spin < (1 << 20); ++spin) {
            const int v = atomicAdd(cuflag, 0);
            if (v >= 2) break;
            __builtin_amdgcn_s_sleep(32);
          }
        }
        s_item = item; s_key = key;
      }
      __syncthreads();
      const int myitem = s_item, mykey = s_key;
      __syncthreads();
      if (myitem >= 0) {
        mixer_item(p, l, myitem, smem);
        __syncthreads();
        if (tid == 0) atomicExch(ctr + 64 + 2 * 4096 + l * 4096 + mykey, 3);
      }
      for (int pass = 0; pass < 2; ++pass) {
        const int q = 1 ^ pass;
        const int total = (q == 0) ? N_A : nattn;
        for (;;) {
          if (tid == 0) s_item = atomicAdd(ctr + l * 2 + q, 1);
          __syncthreads();
          const int it = s_item;
          __syncthreads();
          if (it >= total) break;
          mixer_item(p, l, q == 0 ? it : N_A + it, smem);
        }
      }
    } else if (k == 3 && !(SKIPM & 16)) {
      for (int i = bid * 4 + w; i < nmt * 128; i += nblk * 4) {
        const int row = (l == 0) ? i : ((i >> 12) * PT + CL + (i & 4095));
        readout_row(p, l, row);
      }
    } else if (k == 4 && !(SKIPM & 32)) {
      float4* msc = (float4*)(ws + O_CK) + (size_t)bid * 4096 + tid;
      for (int sq = 0;; ++sq) {
        int mt, nt;
        if (!xcd_tile(sq, bid, nblk, nmt >> 3, 8, mt, nt)) break;
        const int m0 = mtile_row0(l, mt), n0 = nt * 128;
#pragma unroll 1
        for (int kb = 0; kb < 3; ++kb) {
          f32x16 acc[2][2];
          zero_acc(acc);
          gemm_tile((const bf16_t*)(ws + O_UO) + (size_t)m0 * 1024, 1024, (const bf16_t*)(ws + O_WIN) + (size_t)(PW + kb * 1024 + n0) * 1024, 1024, 1024, acc, smem);
          uint4* gsc = (uint4*)(ws + O_QHF) + (size_t)bid * 2048 + tid;
#pragma unroll
          for (int i = 0; i < 2; ++i)
#pragma unroll
            for (int j = 0; j < 2; ++j) {
              unsigned g8[8];
#pragma unroll
              for (int r = 0; r < 8; ++r) g8[r] = pack2(sigmoidf_(acc[i][j][2 * r]), sigmoidf_(acc[i][j][2 * r + 1]));
              gsc[((i * 2 + j) * 2 + 0) * 256] = make_uint4(g8[0], g8[1], g8[2], g8[3]);
              gsc[((i * 2 + j) * 2 + 1) * 256] = make_uint4(g8[4], g8[5], g8[6], g8[7]);
            }
          zero_acc(acc);
          const size_t yo = (kb == 0) ? O_OG : (kb == 1 ? O_BQ : O_CQ);
          gemm_tile((const bf16_t*)(ws + yo) + (size_t)m0 * 512, 512, (const bf16_t*)(ws + O_WBR) + ((size_t)kb * 1024 + n0) * 512, 512, 512, acc, smem);
          const int h = lane >> 5, ln = lane & 31;
          int mso = 0, rowb = m0 + wm * 64 + h * 4, colb = n0 + wn * 64 + ln;
          asm volatile("" : "+v"(mso), "+v"(rowb), "+v"(colb));
#pragma unroll
          for (int i = 0; i < 2; ++i)
#pragma unroll
            for (int j = 0; j < 2; ++j) {
              const uint4 ga = gsc[mso + ((i * 2 + j) * 2 + 0) * 256], gb = gsc[mso + ((i * 2 + j) * 2 + 1) * 256];
              const unsigned g8[8] = {ga.x, ga.y, ga.z, ga.w, gb.x, gb.y, gb.z, gb.w};
#pragma unroll
              for (int rg = 0; rg < 4; ++rg) {
                float4 v;
                v.x = bflo(g8[rg * 2]) * acc[i][j][rg * 4 + 0];
                v.y = bfhi(g8[rg * 2]) * acc[i][j][rg * 4 + 1];
                v.z = bflo(g8[rg * 2 + 1]) * acc[i][j][rg * 4 + 2];
                v.w = bfhi(g8[rg * 2 + 1]) * acc[i][j][rg * 4 + 3];
                float4* sp = msc + mso + ((i * 2 + j) * 4 + rg) * 256;
                if (kb > 0) { const float4 o = *sp; v.x += o.x; v.y += o.y; v.z += o.z; v.w += o.w; }
                if (kb < 2) *sp = v;
                else {
                  bf16_t* mo = (bf16_t*)(ws + O_M);
                  const int row = rowb + i * 32 + rg * 8;
                  const int col = colb + j * 32;
                  mo[(size_t)row * 1024 + col] = tobf(v.x);
                  mo[(size_t)(row + 1) * 1024 + col] = tobf(v.y);
                  mo[(size_t)(row + 2) * 1024 + col] = tobf(v.z);
                  mo[(size_t)(row + 3) * 1024 + col] = tobf(v.w);
                }
                __builtin_amdgcn_sched_barrier(0);
              }
            }
        }
      }
    } else if (k == 5 && !(SKIPM & 64)) {
      for (int sq = 0;; ++sq) {
        int mt, nt;
        if (!xcd_tile(sq, bid, nblk, nmt >> 3, 8, mt, nt)) break;
        const int m0 = mtile_row0(l, mt), n0 = nt * 128;
        f32x16 acc[2][2];
        zero_acc(acc);
        gemm_tile((const bf16_t*)(ws + O_M) + (size_t)m0 * 1024, 1024, (const bf16_t*)(ws + O_WOUT) + (size_t)n0 * 1024, 1024, 1024, acc, smem);
        const int h = lane >> 5, ln = lane & 31;
#pragma unroll
        for (int i = 0; i < 2; ++i)
#pragma unroll
          for (int r = 0; r < 16; ++r) {
            const int row = m0 + wm * 64 + i * 32 + (r >> 2) * 8 + h * 4 + (r & 3);
            const int b = row / PT, q = row % PT;
            const float* xin = xrow_ptr(p, l, 0, row);
            float* xo = (q < CL) ? (float*)(ws + O_XC) + ((size_t)b * CL + q) * D : ((float*)(__attribute__((address_space(1))) float*)karg(20)) + ((size_t)b * SEQ + (q - CL)) * D;
            const float* modf = (const float*)(ws + O_MOD) + ((size_t)l * 5 + (q < CL ? 4 : b)) * 6144 + 2048;
#pragma unroll
            for (int j = 0; j < 2; ++j) {
              const int col = n0 + wn * 64 + j * 32 + ln;
              xo[col] = xin[col] + modf[col] * acc[i][j][r];
            }
          }
      }
    } else if (k == 6 && !(SKIPM & 128)) {
      for (int i = bid * 4 + w; i < nmt * 128; i += nblk * 4) {
        const int row = (l == 0) ? i : ((i >> 12) * PT + CL + (i & 4095));
        norm_row(p, l, 1, row, ((const float*)(const __attribute__((address_space(1))) float*)karg(7)) + l * 1024, 3072, 4096);
      }
    } else if (k == 7 && !(SKIPM & 256)) {
      for (int sq = 0;; ++sq) {
        int mt, nt;
        if (!xcd_tile(sq, bid, nblk, nmt >> 3, 44, mt, nt)) break;
        const int m0 = mtile_row0(l, mt);
        f32x16 acc[2][2];
        zero_acc(acc);
        gemm_tile((const bf16_t*)(ws + O_UO) + (size_t)m0 * 1024, 1024, (const bf16_t*)(ws + O_WGU) + (size_t)nt * 128 * 1024, 1024, 1024, acc, smem);
        bf16_t* ao = (bf16_t*)(ws + O_ACT);
        const int h = lane >> 5, ln = lane & 31;
#pragma unroll
        for (int i = 0; i < 2; ++i)
#pragma unroll
          for (int r = 0; r < 16; ++r) {
            const int row = m0 + wm * 64 + i * 32 + (r >> 2) * 8 + h * 4 + (r & 3);
            ao[(size_t)row * FH + nt * 64 + wn * 32 + ln] = tobf(siluf_(acc[i][0][r]) * acc[i][1][r]);
          }
      }
    } else if (!(SKIPM & 512)) {
      for (int sq = 0;; ++sq) {
        int mt, nt;
        if (!xcd_tile(sq, bid, nblk, nmt >> 3, 8, mt, nt)) break;
        const int m0 = mtile_row0(l, mt), n0 = nt * 128;
        f32x16 acc[2][2];
        zero_acc(acc);
        gemm_tile((const bf16_t*)(ws + O_ACT) + (size_t)m0 * FH, FH, (const bf16_t*)(ws + O_WD) + (size_t)n0 * FH, FH, FH, acc, smem);
        const int h = lane >> 5, ln = lane & 31;
#pragma unroll
        for (int i = 0; i < 2; ++i)
#pragma unroll
          for (int r = 0; r < 16; ++r) {
            const int row = m0 + wm * 64 + i * 32 + (r >> 2) * 8 + h * 4 + (r & 3);
            const int b = row / PT, q = row % PT;
            float* xo = (q < CL) ? (float*)(ws + O_XC) + ((size_t)b * CL + q) * D : ((float*)(__attribute__((address_space(1))) float*)karg(20)) + ((size_t)b * SEQ + (q - CL)) * D;
            const float* modf = (const float*)(ws + O_MOD) + ((size_t)l * 5 + (q < CL ? 4 : b)) * 6144 + 5120;
#pragma unroll
            for (int j = 0; j < 2; ++j) {
              const int col = n0 + wn * 64 + j * 32 + ln;
              xo[col] = xo[col] + modf[col] * acc[i][j][r];
            }
          }
      }
    }
    if (nblk > (1 << 30)) grid.sync();
    else if (pi < NSEQ - 1) {
      XcdBarrier xb; xb.bar = (unsigned*)(ws + O_BAR); xb.x = xb_xcc_id(); xb.st = (volatile LAS unsigned*)sh_words;
      xcd_barrier(xb);
    }
  }
}

extern "C" void kernel_launch(void* const* d_in, const int* in_sizes, int n_in, void* d_out, int out_size, void* d_ws, size_t ws_size,
                              hipStream_t stream) {
  static int grid_blocks = 0;
  if (grid_blocks == 0) {
    if (ws_size < WS_END) { fprintf(stderr, "kernel_launch: workspace too small: %zu < %zu\n", ws_size, (size_t)WS_END); grid_blocks = -1; return; }
    int dev = 0, cus = 0, per_cu = 0;
    hipGetDevice(&dev);
    hipDeviceGetAttribute(&cus, hipDeviceAttributeMultiprocessorCount, dev);
    hipFuncSetAttribute((const void*)fwd_megakernel, hipFuncAttributeMaxDynamicSharedMemorySize, LDS_BYTES);
    hipOccupancyMaxActiveBlocksPerMultiprocessor(&per_cu, (const void*)fwd_megakernel, 256, LDS_BYTES);
    if (per_cu < 1) { fprintf(stderr, "kernel_launch: occupancy query returned %d\n", per_cu); grid_blocks = -1; return; }
    if (per_cu > 2) per_cu = 2;
    grid_blocks = cus * per_cu;
  }
  if (grid_blocks < 0) return;
  Params p{};
  p.x = (const float*)d_in[0]; p.c = (const float*)d_in[1]; p.ctx = (const float*)d_in[2]; p.c_ctx = (const float*)d_in[3];
  p.w_mod = (const float*)d_in[4]; p.b_mod = (const float*)d_in[5]; p.norm_mix = (const float*)d_in[6]; p.norm_ffn = (const float*)d_in[7];
  p.w_in = (const float*)d_in[8]; p.lb_raw = (const float*)d_in[9]; p.gn_a = (const float*)d_in[10]; p.qn_b = (const float*)d_in[11];
  p.kn_b = (const float*)d_in[12]; p.qn_c = (const float*)d_in[13]; p.kn_c = (const float*)d_in[14]; p.rel_bias = (const float*)d_in[15];
  p.w_branch = (const float*)d_in[16]; p.w_out = (const float*)d_in[17]; p.w_gate_up = (const float*)d_in[18]; p.w_down = (const float*)d_in[19];
  p.out = (float*)d_out; p.ws = (unsigned char*)d_ws;
  if (hipMemsetAsync((unsigned char*)d_ws + O_BAR, 0, 16384, stream) != hipSuccess) { fprintf(stderr, "kernel_launch: hipMemsetAsync of the barrier words failed\n"); return; }
  void* args[] = {&p};
  hipError_t e = hipLaunchCooperativeKernel((const void*)fwd_megakernel, dim3(grid_blocks), dim3(256), args, LDS_BYTES, stream);
  if (e != hipSuccess) fprintf(stderr, "cooperative launch failed: %s (grid %d)\n", hipGetErrorString(e), grid_blocks);
}
```

```cpp
#include <hip/hip_runtime.h>
#include <hip/hip_cooperative_groups.h>
#include <cstdio>
namespace cg = cooperative_groups;

typedef short bf16x8 __attribute__((ext_vector_type(8)));
typedef short s16x4 __attribute__((ext_vector_type(4)));
typedef float f32x16 __attribute__((ext_vector_type(16)));
typedef float f32x2 __attribute__((ext_vector_type(2)));
typedef __bf16 bf16x2_t __attribute__((ext_vector_type(2)));
typedef unsigned short bf16_t;
#define DI __device__ __forceinline__
#define MFMA(a, b, c) __builtin_amdgcn_mfma_f32_32x32x16_bf16((a), (b), (c), 0, 0, 0)

constexpr int D = 1024, NB = 4, SEQ = 4096, CL = 256, PT = 4352, NT = NB * PT;
constexpr int INW = 7936, INW2 = 8448, PW = 5376, FH = 2816, GU = 5632;
constexpr float EPS = 1e-6f;

constexpr size_t SZ512 = (size_t)NT * 512 * 2;
constexpr size_t SZ128 = (size_t)NT * 128 * 2;
constexpr size_t O_WIN = 0;
constexpr size_t O_WBR = O_WIN + (size_t)INW2 * D * 2;
constexpr size_t O_WOUT = O_WBR + (size_t)3 * D * 512 * 2;
constexpr size_t O_WGU = O_WOUT + (size_t)D * D * 2;
constexpr size_t O_WD = O_WGU + (size_t)GU * D * 2;
constexpr size_t O_UO = O_WD + (size_t)D * FH * 2;
constexpr size_t O_P = O_UO + (size_t)NT * 1024 * 2;
constexpr size_t O_QHF = O_P;
constexpr size_t O_KTF = O_QHF + SZ512;
constexpr size_t O_QHB = O_KTF + SZ512;
constexpr size_t O_KTB = O_QHB + SZ512;
constexpr size_t O_VA = O_KTB + SZ512;
constexpr size_t O_OG = O_VA + SZ512;
constexpr size_t O_BQ = O_OG + SZ512;
constexpr size_t O_CQ = O_BQ + SZ512;
constexpr size_t O_CK = O_CQ + SZ512;
constexpr size_t O_CVT = O_CK + SZ512;
constexpr size_t O_BK = O_CVT + SZ512;
constexpr size_t O_BVT = O_BK + SZ128;
constexpr size_t O_EBL = O_BVT + SZ128;
constexpr size_t O_XC = O_EBL + (size_t)2 * (NT / 32) * 512 * 4;
constexpr size_t O_MOD = O_XC + (size_t)NB * CL * D * 4;
constexpr size_t O_ROPE = O_MOD + (size_t)2 * 5 * 6144 * 4;
constexpr size_t O_CTR = O_ROPE + 64 * 16 * 2 * 4;
constexpr size_t O_BAR = O_CTR + (64 + 4 * 4096) * 4;
constexpr size_t WS_END = O_BAR + 16384;
constexpr size_t O_M = O_QHB;
constexpr size_t O_ACT = O_P;

constexpr int LDS_BYTES = 73728;
constexpr int LSTR = 72;

struct Params {
  const float* x; const float* c; const float* ctx; const float* c_ctx; const float* w_mod; const float* b_mod;
  const float* norm_mix; const float* norm_ffn; const float* w_in; const float* lb_raw; const float* gn_a;
  const float* qn_b; const float* kn_b; const float* qn_c; const float* kn_c; const float* rel_bias;
  const float* w_branch; const float* w_out; const float* w_gate_up; const float* w_down;
  float* out; unsigned char* ws;
};


typedef const unsigned long long __attribute__((address_space(4))) karg_t;
DI unsigned long long karg(int i) { return *(volatile karg_t*)((karg_t*)__builtin_amdgcn_kernarg_segment_ptr() + i); }
DI int tid_() { int t = threadIdx.x; asm volatile("" : "+v"(t)); return t; }
DI unsigned pack2(float a, float b) {
  f32x2 v = {a, b};
  bf16x2_t r = __builtin_convertvector(v, bf16x2_t);
  return __builtin_bit_cast(unsigned, r);
}
DI bf16_t tobf(float a) { return (bf16_t)(pack2(a, 0.f) & 0xffffu); }
DI float bflo(unsigned u) { return __uint_as_float(u << 16); }
DI float bfhi(unsigned u) { return __uint_as_float(u & 0xffff0000u); }
DI float sigmoidf_(float x) { return __builtin_amdgcn_rcpf(1.f + __builtin_amdgcn_exp2f(-1.4426950408889634f * x)); }
DI float siluf_(float x) { return x * __builtin_amdgcn_rcpf(1.f + __builtin_amdgcn_exp2f(-1.4426950408889634f * x)); }
DI float shx(float v, int m) { return __shfl_xor(v, m); }

#define XB_TMO      128
#define XB_XCNT(j)  (256  + 64 * (j))
#define XB_XSUB(j)  (1280 + 64 * (j))
#define XB_XGEN(j)  (2304 + 64 * (j))
#define XB_TOP      3328
#define XB_TOPGEN   3392
#define XCD_BAR_WORDS 3456
#define XB_SPIN_CAP (1u << 18)
#define LAS __attribute__((address_space(3)))
DI unsigned xb_ld(unsigned* p)              { return __hip_atomic_load(p, __ATOMIC_RELAXED, __HIP_MEMORY_SCOPE_AGENT); }
DI unsigned xb_add(unsigned* p, unsigned v) { return __hip_atomic_fetch_add(p, v, __ATOMIC_RELAXED, __HIP_MEMORY_SCOPE_AGENT); }
DI unsigned xb_xcc_id() { return (unsigned)__builtin_amdgcn_s_getreg((3 << 11) | 20) & 0xFu; }
#define XB_SPIN(cond, bar) do { unsigned _sp = 0; while (cond) { __builtin_amdgcn_s_sleep(1); \
    if ((++_sp & 255u) == 0u) { if (xb_ld(&(bar)[XB_TMO])) break; if (_sp > XB_SPIN_CAP) { atomicAdd(&(bar)[XB_TMO], 1u); break; } } } } while (0)
struct XcdBarrier { unsigned* bar; unsigned x; volatile LAS unsigned* st; };
DI XcdBarrier xcd_barrier_post(unsigned* bar, volatile LAS unsigned* st) {
  XcdBarrier b; b.bar = bar; b.x = xb_xcc_id(); b.st = st;
  if (threadIdx.x == 0) (void)xb_add(&bar[XB_XCNT(b.x)], 1u);
  return b;
}
DI void xcd_barrier_complete(unsigned* bar, unsigned x, unsigned& nloc, unsigned& nx) {
  const unsigned G = gridDim.x * gridDim.y * gridDim.z;
  unsigned sum, cnt, mine, sp = 0u;
  for (;;) {
    sum = 0u; cnt = 0u; mine = 0u;
#pragma unroll
    for (unsigned j = 0; j < 16; ++j) { const unsigned c = xb_ld(&bar[XB_XCNT(j)]); sum += c; cnt += (c > 0u) ? 1u : 0u; mine = (j == x) ? c : mine; }
    if (sum == G) break;
    __builtin_amdgcn_s_sleep(1);
    if ((++sp & 255u) == 0u) { if (xb_ld(&bar[XB_TMO])) break; if (sp > XB_SPIN_CAP) { atomicAdd(&bar[XB_TMO], 1u); break; } }
  }
  nloc = mine > 0u ? mine : 1u; nx = cnt > 0u ? cnt : 1u;
}
DI void xcd_barrier(const XcdBarrier& b) {
  asm volatile("s_waitcnt vmcnt(0)" ::: "memory");
  __syncthreads();
  if (threadIdx.x == 0) {
    unsigned* bar = b.bar;
    __builtin_amdgcn_s_waitcnt(0);
    unsigned nloc = b.st[0], nx = b.st[1];
    if (nloc == 0u) { xcd_barrier_complete(bar, b.x, nloc, nx); b.st[0] = nloc; b.st[1] = nx; }
    const unsigned old = xb_add(&bar[XB_XSUB(b.x)], 1u);
    const unsigned gen = old / nloc;
    if (old + 1u == (gen + 1u) * nloc) {
      __builtin_amdgcn_fence(__ATOMIC_RELEASE, "agent");
      asm volatile("s_waitcnt vmcnt(0)" ::: "memory");
      const unsigned og = xb_add(&bar[XB_TOP], 1u);
      const unsigned tg = og / nx;
      if (og + 1u == (tg + 1u) * nx) xb_add(&bar[XB_TOPGEN], 1u);
      else XB_SPIN(xb_ld(&bar[XB_TOPGEN]) == tg, bar);
      __builtin_amdgcn_fence(__ATOMIC_ACQUIRE, "agent");
      xb_add(&bar[XB_XGEN(b.x)], 1u);
      asm volatile("s_waitcnt vmcnt(0)" ::: "memory");
    } else {
      XB_SPIN(xb_ld(&bar[XB_XGEN(b.x)]) == gen, bar);
      __builtin_amdgcn_fence(__ATOMIC_ACQUIRE, "agent");
      asm volatile("s_waitcnt vmcnt(0)" ::: "memory");
    }
  }
  __syncthreads();
}

template <bool TR> DI void gemm_tile(const bf16_t* A, int lda, const bf16_t* Bt, int ldb, int K,
                  f32x16 (&acc)[2][2], unsigned char* smem) {
  const int tid = tid_(), lane = tid & 63, w = tid >> 6, wm = w >> 1, wn = w & 1;
  bf16_t* sa = (bf16_t*)smem;
  bf16_t* sb = sa + 2 * 128 * LSTR;
  const int lrow = tid >> 3, lkc = (tid & 7) * 8;
  const bf16_t* ga = A + (size_t)lrow * lda + lkc;
  const bf16_t* gb = Bt + (size_t)lrow * ldb + lkc;
  uint4 pa0, pa1, pa2, pa3, pb0, pb1, pb2, pb3;
  uint4 qa0, qa1, qa2, qa3, qb0, qb1, qb2, qb3;
#define GT_LOAD(S, koff) { \
    S##a0 = *(const uint4*)(ga + (koff)); S##a1 = *(const uint4*)(ga + (size_t)32 * lda + (koff)); \
    S##a2 = *(const uint4*)(ga + (size_t)64 * lda + (koff)); S##a3 = *(const uint4*)(ga + (size_t)96 * lda + (koff)); \
    S##b0 = *(const uint4*)(gb + (koff)); S##b1 = *(const uint4*)(gb + (size_t)32 * ldb + (koff)); \
    S##b2 = *(const uint4*)(gb + (size_t)64 * ldb + (koff)); S##b3 = *(const uint4*)(gb + (size_t)96 * ldb + (koff)); \
    asm volatile("" ::: "memory"); __builtin_amdgcn_sched_barrier(0); }
#define GT_STORE(S, bufi) { \
    bf16_t* da_ = sa + (bufi) * 128 * LSTR + lrow * LSTR + lkc; bf16_t* db_ = sb + (bufi) * 128 * LSTR + lrow * LSTR + lkc; \
    *(uint4*)(da_) = S##a0; *(uint4*)(da_ + 32 * LSTR) = S##a1; *(uint4*)(da_ + 64 * LSTR) = S##a2; *(uint4*)(da_ + 96 * LSTR) = S##a3; \
    *(uint4*)(db_) = S##b0; *(uint4*)(db_ + 32 * LSTR) = S##b1; *(uint4*)(db_ + 64 * LSTR) = S##b2; *(uint4*)(db_ + 96 * LSTR) = S##b3; }
#define GT_FRAGS(F0, F1, G0, G1, KS) \
    F0 = *(const bf16x8*)(as + (KS) * 16); F1 = *(const bf16x8*)(as + 32 * LSTR + (KS) * 16); \
    G0 = *(const bf16x8*)(bs + (KS) * 16); G1 = *(const bf16x8*)(bs + 32 * LSTR + (KS) * 16);
#define MMA_(a_, b_, c_) (TR ? MFMA(b_, a_, c_) : MFMA(a_, b_, c_))
#define GEMM_STEP(A0, A1, B0, B1, PRE, ST0, ST1) \
    PRE \
    acc[0][0] = MMA_(A0, B0, acc[0][0]); acc[0][1] = MMA_(A0, B1, acc[0][1]); \
    ST0; ST1; \
    acc[1][0] = MMA_(A1, B0, acc[1][0]); acc[1][1] = MMA_(A1, B1, acc[1][1]); \
    __builtin_amdgcn_sched_barrier(0);
#define GT_COMPUTE(bufi, S, sbuf) { \
    const bf16_t* as = sa + (bufi) * 128 * LSTR + wm * 64 * LSTR + fo; \
    const bf16_t* bs = sb + (bufi) * 128 * LSTR + wn * 64 * LSTR + fo; \
    bf16_t* da_ = sa + (sbuf) * 128 * LSTR + lrow * LSTR + lkc; bf16_t* db_ = sb + (sbuf) * 128 * LSTR + lrow * LSTR + lkc; \
    bf16x8 a0, a1, b0, b1, c0, c1, d0, d1, e0, e1, f0, f1; \
    GT_FRAGS(a0, a1, b0, b1, 0) GT_FRAGS(c0, c1, d0, d1, 1) \
    GEMM_STEP(a0, a1, b0, b1, GT_FRAGS(e0, e1, f0, f1, 2), *(uint4*)(da_) = S##a0, *(uint4*)(db_) = S##b0) \
    GEMM_STEP(c0, c1, d0, d1, GT_FRAGS(a0, a1, b0, b1, 3), *(uint4*)(da_ + 32 * LSTR) = S##a1, *(uint4*)(db_ + 32 * LSTR) = S##b1) \
    GEMM_STEP(e0, e1, f0, f1, , *(uint4*)(da_ + 64 * LSTR) = S##a2, *(uint4*)(db_ + 64 * LSTR) = S##b2) \
    GEMM_STEP(a0, a1, b0, b1, , *(uint4*)(da_ + 96 * LSTR) = S##a3, *(uint4*)(db_ + 96 * LSTR) = S##b3) }
  const int nk = K >> 6;
  const int fo = (lane & 31) * LSTR + (lane >> 5) * 8;
  GT_LOAD(p, 0)
  GT_LOAD(q, 64)
  GT_STORE(p, 0)
  __syncthreads();
  for (int kt = 0; kt < nk; kt += 2) {
    GT_LOAD(p, min(kt + 2, nk - 1) * 64)
    GT_COMPUTE(0, q, 1)
    __syncthreads();
    GT_LOAD(q, min(kt + 3, nk - 1) * 64)
    GT_COMPUTE(1, p, 0)
    __syncthreads();
  }
}
DI void zero_acc(f32x16 (&acc)[2][2]) {
#pragma unroll
  for (int i = 0; i < 2; ++i)
#pragma unroll
    for (int j = 0; j < 2; ++j)
#pragma unroll
      for (int r = 0; r < 16; ++r) acc[i][j][r] = 0.f;
}

DI void cvt_tile(const float* __restrict__ src, int ldsrc, int k0, int scol0a, int scol0b, bf16_t* __restrict__ dst, int K, int n0,
                 unsigned char* smem) {
  float* t = (float*)smem;
  const int tid = tid_();
  {
    const int kk = tid >> 4, c4 = (tid & 15) * 4;
    const int sc = (c4 < 32) ? (scol0a + c4) : (scol0b + c4 - 32);
#pragma unroll
    for (int i = 0; i < 4; ++i) {
      const int k = kk + i * 16;
      float4 v = *(const float4*)(src + (size_t)(k0 + k) * ldsrc + sc);
      t[k * 65 + c4 + 0] = v.x; t[k * 65 + c4 + 1] = v.y; t[k * 65 + c4 + 2] = v.z; t[k * 65 + c4 + 3] = v.w;
    }
  }
  __syncthreads();
  {
    const int n = tid >> 2, kq = (tid & 3) * 16;
    unsigned o[8];
#pragma unroll
    for (int j = 0; j < 8; ++j) o[j] = pack2(t[(kq + 2 * j) * 65 + n], t[(kq + 2 * j + 1) * 65 + n]);
    bf16_t* d = dst + (size_t)(n0 + n) * K + k0 + kq;
    *(uint4*)d = make_uint4(o[0], o[1], o[2], o[3]);
    *(uint4*)(d + 8) = make_uint4(o[4], o[5], o[6], o[7]);
  }
  __syncthreads();
}
constexpr int CVT_ITEMS = 2112 + 384 + 256 + 1408 + 704;
DI void cvt_item(const Params& p, int l, int it, unsigned char* smem) {
  unsigned char* ws = ((unsigned char*)(__attribute__((address_space(1))) unsigned char*)karg(21));
  if (it < 2112) {
    const int kt = it & 15, nt = it >> 4;
    int ca, cb;
    if (nt < 16) { ca = 32 * nt; cb = 512 + 32 * nt; }
    else if (nt < 32) { ca = 32 * (nt - 16); cb = 1024 + 32 * (nt - 16); }
    else { ca = 64 * (nt - 32) + 1536; cb = ca + 32; }
    cvt_tile(((const float*)(const __attribute__((address_space(1))) float*)karg(8)) + (size_t)l * D * INW, INW, kt * 64, ca, cb, (bf16_t*)(ws + O_WIN), D, nt * 64, smem);
    return;
  }
  it -= 2112;
  if (it < 384) {
    const int kb = it / 128, r = it % 128, kt = r & 7, nt = r >> 3;
    cvt_tile(((const float*)(const __attribute__((address_space(1))) float*)karg(16)) + ((size_t)l * 3 + kb) * 512 * D, D, kt * 64, nt * 64, nt * 64 + 32, (bf16_t*)(ws + O_WBR) + (size_t)kb * D * 512, 512, nt * 64, smem);
    return;
  }
  it -= 384;
  if (it < 256) {
    const int kt = it & 15, nt = it >> 4;
    cvt_tile(((const float*)(const __attribute__((address_space(1))) float*)karg(17)) + (size_t)l * D * D, D, kt * 64, nt * 64, nt * 64 + 32, (bf16_t*)(ws + O_WOUT), D, nt * 64, smem);
    return;
  }
  it -= 256;
  if (it < 1408) {
    const int kt = it & 15, nt = it >> 4;
    const int tile = nt >> 1, wn = nt & 1;
    const int hid = tile * 64 + wn * 32;
    cvt_tile(((const float*)(const __attribute__((address_space(1))) float*)karg(18)) + (size_t)l * D * GU, GU, kt * 64, hid, FH + hid, (bf16_t*)(ws + O_WGU), D, nt * 64, smem);
    return;
  }
  it -= 1408;
  {
    const int kt = it % 44, nt = it / 44;
    cvt_tile(((const float*)(const __attribute__((address_space(1))) float*)karg(19)) + (size_t)l * FH * D, D, kt * 64, nt * 64, nt * 64 + 32, (bf16_t*)(ws + O_WD), FH, nt * 64, smem);
  }
}
DI void mod_item(const Params& p, int it, unsigned char* smem) {
  float* sc = (float*)smem;
  float* red = sc + 5 * 1024;
  const int tid = tid_();
  const int l = it / 192, cb = it % 192;
  for (int i = tid; i < 5 * 1024; i += 256) {
    const int r = i >> 10, k = i & 1023;
    const float v = (r < 4) ? ((const float*)(const __attribute__((address_space(1))) float*)karg(1))[r * 1024 + k] : ((const float*)(const __attribute__((address_space(1))) float*)karg(3))[k];
    sc[i] = siluf_(v);
  }
  __syncthreads();
  const int c = tid & 31, kg = tid >> 5;
  const int col = cb * 32 + c;
  const float* w = ((const float*)(const __attribute__((address_space(1))) float*)karg(4)) + (size_t)l * D * 6144 + col;
  float a0 = 0, a1 = 0, a2 = 0, a3 = 0, a4 = 0;
#pragma unroll 8
  for (int k = kg * 128; k < kg * 128 + 128; ++k) {
    const float wv = w[(size_t)k * 6144];
    a0 += sc[k] * wv; a1 += sc[1024 + k] * wv; a2 += sc[2048 + k] * wv; a3 += sc[3072 + k] * wv; a4 += sc[4096 + k] * wv;
  }
  red[(kg * 5 + 0) * 32 + c] = a0; red[(kg * 5 + 1) * 32 + c] = a1; red[(kg * 5 + 2) * 32 + c] = a2;
  red[(kg * 5 + 3) * 32 + c] = a3; red[(kg * 5 + 4) * 32 + c] = a4;
  __syncthreads();
  if (tid < 160) {
    const int r = tid >> 5, cc = tid & 31;
    float s = 0;
#pragma unroll
    for (int g = 0; g < 8; ++g) s += red[(g * 5 + r) * 32 + cc];
    const int colo = cb * 32 + cc;
    float* modf = (float*)(((unsigned char*)(__attribute__((address_space(1))) unsigned char*)karg(21)) + O_MOD);
    modf[((size_t)l * 5 + r) * 6144 + colo] = s + ((const float*)(const __attribute__((address_space(1))) float*)karg(5))[l * 6144 + colo];
  }
  __syncthreads();
}

DI const float* xrow_ptr(const Params& p, int l, int stage, int row) {
  const int b = row / PT, q = row % PT;
  if (q < CL) {
    const size_t o = ((size_t)b * CL + q) * D;
    return (l == 0 && stage == 0) ? ((const float*)(const __attribute__((address_space(1))) float*)karg(2)) + o : (const float*)(((unsigned char*)(__attribute__((address_space(1))) unsigned char*)karg(21)) + O_XC) + o;
  }
  const size_t o = ((size_t)b * SEQ + (q - CL)) * D;
  return (l == 0 && stage == 0) ? ((const float*)(const __attribute__((address_space(1))) float*)karg(0)) + o : ((float*)(__attribute__((address_space(1))) float*)karg(20)) + o;
}
DI void norm_row(const Params& p, int l, int stage, int row, const float* __restrict__ nw, int shoff, int scoff) {
  const int lane = tid_() & 63;
  const float* xr = xrow_ptr(p, l, stage, row);
  const int b = row / PT, q = row % PT;
  const float* modf = (const float*)(((unsigned char*)(__attribute__((address_space(1))) unsigned char*)karg(21)) + O_MOD) + ((size_t)l * 5 + (q < CL ? 4 : b)) * 6144;
  float4 v[4];
  float ss = 0.f;
#pragma unroll
  for (int i = 0; i < 4; ++i) {
    v[i] = *(const float4*)(xr + i * 256 + lane * 4);
    ss += v[i].x * v[i].x + v[i].y * v[i].y + v[i].z * v[i].z + v[i].w * v[i].w;
  }
#pragma unroll
  for (int m = 1; m < 64; m <<= 1) ss += shx(ss, m);
  const float rs = rsqrtf(ss * (1.f / 1024.f) + EPS);
  bf16_t* dst = (bf16_t*)(((unsigned char*)(__attribute__((address_space(1))) unsigned char*)karg(21)) + O_UO) + (size_t)row * 1024;
#pragma unroll
  for (int i = 0; i < 4; ++i) {
    const int k = i * 256 + lane * 4;
    const float4 wv = *(const float4*)(nw + k);
    const float4 sc = *(const float4*)(modf + scoff + k);
    const float4 sh = *(const float4*)(modf + shoff + k);
    const float y0 = v[i].x * rs * wv.x * (1.f + sc.x) + sh.x;
    const float y1 = v[i].y * rs * wv.y * (1.f + sc.y) + sh.y;
    const float y2 = v[i].z * rs * wv.z * (1.f + sc.z) + sh.z;
    const float y3 = v[i].w * rs * wv.w * (1.f + sc.w) + sh.w;
    *(uint2*)(dst + k) = make_uint2(pack2(y0, y1), pack2(y2, y3));
  }
}

DI void store4T(bf16_t* base, float a, float b, float c, float d) { *(uint2*)base = make_uint2(pack2(a, b), pack2(c, d)); }

DI void inproj_epilogue(const Params& p, int l, f32x16 (&acc)[2][2], int m0w, int n0w) {
  unsigned char* ws = ((unsigned char*)(__attribute__((address_space(1))) unsigned char*)karg(21));
  const int lane = tid_() & 63, ln = lane & 31, h = lane >> 5;
  if (n0w < 2048) {
    const int dir = n0w >> 10, ch = ((n0w & 1023) >> 6) * 32 + ln;
    float lb = 0.f;
    if (l == 1) {
      const float* lbr = ((const float*)(const __attribute__((address_space(1))) float*)karg(9));
      lb = fminf(sigmoidf_(lbr[(2 + dir) * 512 + ch] - lbr[dir * 512 + ch]), 1.f - 1e-6f);
    }
    bf16_t* qd = (bf16_t*)(ws + (dir ? O_QHB : O_QHF));
    bf16_t* kd = (bf16_t*)(ws + (dir ? O_KTB : O_KTF));
    float* ebl = (float*)(ws + O_EBL) + (size_t)dir * (NT / 32) * 512;
#pragma unroll
    for (int i = 0; i < 2; ++i) {
      const int r0 = m0w + i * 32;
      float kk[16], g2[16], gs[4], gp[4];
#pragma unroll
      for (int r = 0; r < 16; ++r) {
        kk[r] = (1.f - lb) * sigmoidf_(-acc[i][1][r]);
        g2[r] = __log2f(fmaxf(1.f - kk[r], 1e-30f));
      }
#pragma unroll
      for (int rg = 0; rg < 4; ++rg) { gs[rg] = (g2[rg * 4] + g2[rg * 4 + 1]) + (g2[rg * 4 + 2] + g2[rg * 4 + 3]); gp[rg] = shx(gs[rg], 32); }
      const float total = ((gs[0] + gp[0]) + (gs[1] + gp[1])) + ((gs[2] + gp[2]) + (gs[3] + gp[3]));
      float pre = 0.f;
#pragma unroll
      for (int rg = 0; rg < 4; ++rg) {
        float run = pre + (h ? gp[rg] : 0.f);
#pragma unroll
        for (int i4 = 0; i4 < 4; ++i4) {
          const int r = rg * 4 + i4;
          run += g2[r];
          const float bj = dir ? (total - run + g2[r]) : run;
          const size_t o = (size_t)(r0 + rg * 8 + h * 4 + i4) * 512 + ch;
          qd[o] = tobf(acc[i][0][r] * 0.08838834764831845f * __builtin_amdgcn_exp2f(bj));
          kd[o] = tobf(kk[r] * __builtin_amdgcn_exp2f(fminf(-bj, 115.f)));
        }
        pre += gs[rg] + gp[rg];
      }
      if (h == 0) ebl[(size_t)(r0 >> 5) * 512 + ch] = __builtin_amdgcn_exp2f(total);
    }
    return;
  }
  if (n0w < 2560) {
    bf16_t* vt = (bf16_t*)(ws + O_VA);
#pragma unroll
    for (int i = 0; i < 2; ++i)
#pragma unroll
      for (int rg = 0; rg < 4; ++rg) {
        const int row = m0w + i * 32 + rg * 8 + h * 4;
        const int b = row / PT, q = row % PT;
#pragma unroll
        for (int j = 0; j < 2; ++j) {
          const int ch = (n0w & 511) + j * 32 + ln;
          store4T(vt + ((size_t)b * 512 + ch) * PT + q, acc[i][j][rg * 4 + 0], acc[i][j][rg * 4 + 1], acc[i][j][rg * 4 + 2], acc[i][j][rg * 4 + 3]);
        }
      }
    return;
  }
  if (n0w < 3072) {
    bf16_t* dst = (bf16_t*)(ws + O_OG);
    const int cg0 = n0w & 511;
#pragma unroll
    for (int j = 0; j < 2; ++j)
#pragma unroll
      for (int i = 0; i < 2; ++i)
#pragma unroll
        for (int r = 0; r < 16; ++r) {
          const int row = m0w + i * 32 + (r >> 2) * 8 + h * 4 + (r & 3);
          dst[(size_t)row * 512 + cg0 + j * 32 + ln] = tobf(acc[i][j][r]);
        }
    return;
  }
  n0w -= 512;
  int kind, head;
  if (n0w < 3072) { kind = 0; head = (n0w - 2560) >> 6; }
  else if (n0w < 3200) { kind = 1; head = (n0w - 3072) >> 6; }
  else if (n0w < 3328) { kind = 2; head = (n0w - 3200) >> 6; }
  else if (n0w < 3840) { kind = 3; head = (n0w - 3328) >> 6; }
  else if (n0w < 4352) { kind = 4; head = (n0w - 3840) >> 6; }
  else { kind = 5; head = (n0w - 4352) >> 6; }
  if (kind == 2 || kind == 5) {
    bf16_t* vt = (bf16_t*)(ws + (kind == 2 ? O_BVT : O_CVT));
    const int nch = (kind == 2) ? 128 : 512;
#pragma unroll
    for (int i = 0; i < 2; ++i)
#pragma unroll
      for (int rg = 0; rg < 4; ++rg) {
        const int row = m0w + i * 32 + rg * 8 + h * 4;
        const int b = row / PT, q = row % PT;
#pragma unroll
        for (int j = 0; j < 2; ++j) {
          const int ch = head * 64 + j * 32 + ln;
          store4T(vt + ((size_t)b * nch + ch) * PT + q, acc[i][j][rg * 4 + 0], acc[i][j][rg * 4 + 1], acc[i][j][rg * 4 + 2], acc[i][j][rg * 4 + 3]);
        }
      }
    return;
  }
  const float* nwp = (kind == 0 ? ((const float*)(const __attribute__((address_space(1))) float*)karg(11)) : kind == 1 ? ((const float*)(const __attribute__((address_space(1))) float*)karg(12)) : kind == 3 ? ((const float*)(const __attribute__((address_space(1))) float*)karg(13)) : ((const float*)(const __attribute__((address_space(1))) float*)karg(14))) + l * 64;
  const float nw0 = nwp[ln], nw1 = nwp[32 + ln];
  const float qscale = (kind == 0 || kind == 3) ? 0.125f * 1.4426950408889634f : 1.f;
  const bool rope = (kind <= 1);
  const float* ropet = (const float*)(ws + O_ROPE);
  bf16_t* dst; int dstride;
  if (kind == 0) { dst = (bf16_t*)(ws + O_BQ); dstride = 512; }
  else if (kind == 1) { dst = (bf16_t*)(ws + O_BK); dstride = 128; }
  else if (kind == 3) { dst = (bf16_t*)(ws + O_CQ); dstride = 512; }
  else { dst = (bf16_t*)(ws + O_CK); dstride = 512; }
#pragma unroll
  for (int i = 0; i < 2; ++i)
#pragma unroll
    for (int r = 0; r < 16; ++r) {
      const int row = m0w + i * 32 + (r >> 2) * 8 + h * 4 + (r & 3);
      float v0 = acc[i][0][r], v1 = acc[i][1][r];
      float ss = v0 * v0 + v1 * v1;
      ss += shx(ss, 1); ss += shx(ss, 2); ss += shx(ss, 4); ss += shx(ss, 8); ss += shx(ss, 16);
      const float rs = rsqrtf(ss * (1.f / 64.f) + EPS);
      v0 = v0 * rs * nw0; v1 = v1 * rs * nw1;
      if (rope) {
        const int q = row % PT;
        const float p0 = shx(v0, 1), p1 = shx(v1, 1);
        if (q >= CL) {
          const int t = q - CL, gr = t >> 6, gc = t & 63;
          const int fj = ln >> 1;
          const float2 cs0 = *(const float2*)(ropet + (gr * 16 + fj) * 2);
          const float2 cs1 = *(const float2*)(ropet + (gc * 16 + fj) * 2);
          if (ln & 1) { v0 = p0 * cs0.y + v0 * cs0.x; v1 = p1 * cs1.y + v1 * cs1.x; }
          else { v0 = v0 * cs0.x - p0 * cs0.y; v1 = v1 * cs1.x - p1 * cs1.y; }
        }
      }
      dst[(size_t)row * dstride + head * 64 + ln] = tobf(v0 * qscale);
      dst[(size_t)row * dstride + head * 64 + 32 + ln] = tobf(v1 * qscale);
    }
}

constexpr int AQS = 136, ATS = 40;
constexpr int A_QH = 0, A_KT = A_QH + 32 * AQS * 2, A_KBT = A_KT + 32 * AQS * 2, A_VT = A_KBT + 128 * ATS * 2, A_EBL = A_VT + 128 * ATS * 2;
DI bf16x8 pack8(const f32x16& x, int o) {
  return __builtin_bit_cast(bf16x8, make_uint4(pack2(x[o + 0], x[o + 1]), pack2(x[o + 2], x[o + 3]), pack2(x[o + 4], x[o + 5]), pack2(x[o + 6], x[o + 7])));
}
template <int DIR> DI int ac_tb(int c) {
  const int s = c * 32;
  return DIR == 0 ? s : (s < CL ? (CL - 32 - s) : (PT + CL - 32 - s));
}
constexpr int A_VT2 = A_EBL + 512, A_EBL2 = A_VT2 + 128 * ATS * 2;
template <int DIR> DI void a_chunk_run(unsigned char* ws, int b, int hd, unsigned char* smem) {
  const int tid = tid_(), lane = tid & 63, w = tid >> 6, ln = lane & 31, hh = lane >> 5;
  const int kc = tid >> 1, half = tid & 1;
  const int sj = tid >> 3, cg = tid & 7;
  const size_t rb = (size_t)b * PT;
  const bf16_t* qg = (const bf16_t*)(ws + (DIR ? O_QHB : O_QHF)) + (rb + sj) * 512 + hd * 128 + cg * 16;
  const bf16_t* kg = (const bf16_t*)(ws + (DIR ? O_KTB : O_KTF)) + (rb + sj) * 512 + hd * 128 + cg * 16;
  const bf16_t* vg = (const bf16_t*)(ws + O_VA) + ((size_t)b * 512 + hd * 128 + kc) * PT + half * 16;
  const float* eg = (const float*)(ws + O_EBL) + (size_t)DIR * (NT / 32) * 512 + hd * 128 + kc;
  bf16_t* og = (bf16_t*)(ws + (DIR ? O_QHB : O_QHF)) + rb * 512 + hd * 128 + w * 32 + ln;
  bf16_t* Qh = (bf16_t*)(smem + A_QH); bf16_t* Kt = (bf16_t*)(smem + A_KT);
  bf16_t* KtT = (bf16_t*)(smem + A_KBT);
  f32x16 S0, S1, S2, S3;
#pragma unroll
  for (int r = 0; r < 16; ++r) { S0[r] = 0.f; S1[r] = 0.f; S2[r] = 0.f; S3[r] = 0.f; }
  uint4 q0, q1, k0, k1, v0, v1;
  float pe;
#define A_PREFETCH(cc) { const int tb_ = ac_tb<DIR>(cc); \
    q0 = *(const uint4*)(qg + (size_t)tb_ * 512); q1 = *(const uint4*)(qg + (size_t)tb_ * 512 + 8); \
    k0 = *(const uint4*)(kg + (size_t)tb_ * 512); k1 = *(const uint4*)(kg + (size_t)tb_ * 512 + 8); \
    v0 = *(const uint4*)(vg + tb_); v1 = *(const uint4*)(vg + tb_ + 8); \
    pe = eg[(size_t)((rb + tb_) >> 5) * 512]; }
  A_PREFETCH(0)
#pragma unroll 1
  for (int c = 0; c < PT / 32; ++c) {
    bf16_t* Vt = (bf16_t*)(smem + ((c & 1) ? A_VT2 : A_VT));
    float* ebl = (float*)(smem + ((c & 1) ? A_EBL2 : A_EBL));
    *(uint4*)(Qh + sj * AQS + cg * 16) = q0; *(uint4*)(Qh + sj * AQS + cg * 16 + 8) = q1;
    *(uint4*)(Kt + sj * AQS + cg * 16) = k0; *(uint4*)(Kt + sj * AQS + cg * 16 + 8) = k1;
    *(uint4*)(Vt + kc * ATS + half * 16) = v0; *(uint4*)(Vt + kc * ATS + half * 16 + 8) = v1;
    if (half == 0) ebl[kc] = pe;
    __syncthreads();
    A_PREFETCH(min(c + 1, PT / 32 - 1))
    unsigned short kt16[16];
#pragma unroll
    for (int jj = 0; jj < 16; ++jj) kt16[jj] = Kt[(half * 16 + jj) * AQS + kc];
    bf16x8 fa[8], fq[8], qi[8], vi[2], vs[2];
#pragma unroll
    for (int ks = 0; ks < 8; ++ks) {
      fa[ks] = *(const bf16x8*)(Kt + ln * AQS + ks * 16 + hh * 8);
      fq[ks] = *(const bf16x8*)(Qh + ln * AQS + ks * 16 + hh * 8);
    }
    __builtin_amdgcn_sched_barrier(0);
    f32x16 at, o;
#pragma unroll
    for (int r = 0; r < 16; ++r) { at[r] = 0.f; o[r] = 0.f; }
#pragma unroll
    for (int ks = 0; ks < 8; ++ks) at = MFMA(fa[ks], fq[ks], at);
#pragma unroll
    for (int i = 0; i < 8; ++i) {
      const s16x4 lo = *(const s16x4*)(Qh + ln * AQS + (i >> 1) * 32 + 16 * (i & 1) + 4 * hh);
      const s16x4 hi = *(const s16x4*)(Qh + ln * AQS + (i >> 1) * 32 + 16 * (i & 1) + 4 * hh + 8);
      qi[i] = __builtin_shufflevector(lo, hi, 0, 1, 2, 3, 4, 5, 6, 7);
    }
#pragma unroll
    for (int st = 0; st < 2; ++st) {
      const s16x4 lo = *(const s16x4*)(Vt + (w * 32 + ln) * ATS + 16 * st + 4 * hh);
      const s16x4 hi = *(const s16x4*)(Vt + (w * 32 + ln) * ATS + 16 * st + 4 * hh + 8);
      vi[st] = __builtin_shufflevector(lo, hi, 0, 1, 2, 3, 4, 5, 6, 7);
      vs[st] = *(const bf16x8*)(Vt + (w * 32 + ln) * ATS + st * 16 + hh * 8);
    }
    __builtin_amdgcn_sched_barrier(0);
    o = MFMA(qi[0], pack8(S0, 0), o); o = MFMA(qi[1], pack8(S0, 8), o);
    o = MFMA(qi[2], pack8(S1, 0), o); o = MFMA(qi[3], pack8(S1, 8), o);
    o = MFMA(qi[4], pack8(S2, 0), o); o = MFMA(qi[5], pack8(S2, 8), o);
    o = MFMA(qi[6], pack8(S3, 0), o); o = MFMA(qi[7], pack8(S3, 8), o);
#pragma unroll
    for (int r = 0; r < 16; ++r) {
      const int s_ = (r >> 2) * 8 + hh * 4 + (r & 3);
      at[r] = (DIR == 0 ? (s_ <= ln) : (s_ >= ln)) ? at[r] : 0.f;
    }
    o = MFMA(pack8(at, 0), vi[0], o);
    o = MFMA(pack8(at, 8), vi[1], o);
    {
      unsigned kkp[8];
#pragma unroll
      for (int i = 0; i < 8; ++i) kkp[i] = (unsigned)kt16[2 * i] | ((unsigned)kt16[2 * i + 1] << 16);
      *(uint4*)(KtT + kc * ATS + half * 16) = make_uint4(kkp[0], kkp[1], kkp[2], kkp[3]);
      *(uint4*)(KtT + kc * ATS + half * 16 + 8) = make_uint4(kkp[4], kkp[5], kkp[6], kkp[7]);
    }
    {
      bf16_t* oc = og + (size_t)ac_tb<DIR>(c) * 512;
#pragma unroll
      for (int r = 0; r < 16; ++r) { const int t = (r >> 2) * 8 + hh * 4 + (r & 3); oc[t * 512] = tobf(o[r]); }
    }
    __syncthreads();
    bf16x8 ka[8];
    float4 ev[16];
#pragma unroll
    for (int i = 0; i < 8; ++i) ka[i] = *(const bf16x8*)(KtT + ((i >> 1) * 32 + ln) * ATS + (i & 1) * 16 + hh * 8);
#pragma unroll
    for (int i = 0; i < 16; ++i) ev[i] = *(const float4*)(ebl + (i >> 2) * 32 + (i & 3) * 8 + hh * 4);
    __builtin_amdgcn_sched_barrier(0);
    S0 = MFMA(ka[0], vs[0], S0); S1 = MFMA(ka[2], vs[0], S1); S2 = MFMA(ka[4], vs[0], S2); S3 = MFMA(ka[6], vs[0], S3);
    S0 = MFMA(ka[1], vs[1], S0); S1 = MFMA(ka[3], vs[1], S1); S2 = MFMA(ka[5], vs[1], S2); S3 = MFMA(ka[7], vs[1], S3);
#define A_SCALE(SK, kb) { \
      _Pragma("unroll") for (int rg = 0; rg < 4; ++rg) { \
        const float4 e = ev[(kb) * 4 + rg]; \
        SK[rg * 4 + 0] *= e.x; SK[rg * 4 + 1] *= e.y; SK[rg * 4 + 2] *= e.z; SK[rg * 4 + 3] *= e.w; } }
    A_SCALE(S0, 0) A_SCALE(S1, 1) A_SCALE(S2, 2) A_SCALE(S3, 3)
  }
  __syncthreads();
}
DI void a_chunk_item(unsigned char* ws, int it, unsigned char* smem) {
  const int dir = it & 1, hd = (it >> 1) & 3, b = it >> 3;
  __builtin_amdgcn_s_setprio(2);
  if (dir == 0) a_chunk_run<0>(ws, b, hd, smem); else a_chunk_run<1>(ws, b, hd, smem);
  __builtin_amdgcn_s_setprio(0);
}

struct AttnArgs {
  float m0;
  bf16_t* q;
  const bf16_t* k; int kstride;
  const bf16_t* vt;
  int kbase_row;
  int qrow;
  int ntiles, nwin, win_p0;
  int mode;
  int gr, r0w, cb, krow0;
  const float* bias;
};
DI void attn_run(const AttnArgs& a, unsigned char* smem) {
  const int tid = tid_(), lane = tid & 63, ln = lane & 31, h = lane >> 5;
  bf16_t* sk = (bf16_t*)smem;
  bf16_t* sv = sk + 2 * 64 * LSTR;
  bf16x8 qf[4];
  {
    const bf16_t* qp = a.q + (size_t)(a.qrow + ln) * 512 + h * 8;
#pragma unroll
    for (int ks = 0; ks < 4; ++ks) qf[ks] = *(const bf16x8*)(qp + ks * 16);
  }
  f32x16 o0, o1;
#pragma unroll
  for (int r = 0; r < 16; ++r) { o0[r] = 0.f; o1[r] = 0.f; }
  float lrun = 0.f;
  const int lrow = tid >> 3, lc = (tid & 7) * 8;
  uint4 rk0, rk1, rv0, rv1;
#define TILE_P0(i) ((i) < a.nwin ? a.win_p0 + (i) * 64 : ((i) - a.nwin) * 64)
#define GLOAD(i) { const int p0_ = TILE_P0(i); \
    rk0 = *(const uint4*)(a.k + (size_t)(a.kbase_row + p0_ + lrow) * a.kstride + lc); \
    rk1 = *(const uint4*)(a.k + (size_t)(a.kbase_row + p0_ + lrow + 32) * a.kstride + lc); \
    rv0 = *(const uint4*)(a.vt + (size_t)(lrow) * PT + p0_ + lc); \
    rv1 = *(const uint4*)(a.vt + (size_t)(lrow + 32) * PT + p0_ + lc); }
#define SSTORE(buf_) { \
    *(uint4*)(sk + (buf_) * 64 * LSTR + (lrow) * LSTR + lc) = rk0; \
    *(uint4*)(sk + (buf_) * 64 * LSTR + (lrow + 32) * LSTR + lc) = rk1; \
    *(uint4*)(sv + (buf_) * 64 * LSTR + (lrow) * LSTR + lc) = rv0; \
    *(uint4*)(sv + (buf_) * 64 * LSTR + (lrow + 32) * LSTR + lc) = rv1; }
  GLOAD(0);
  SSTORE(0);
  __syncthreads();
  for (int it = 0; it < a.ntiles; ++it) {
    const int buf = it & 1;
    GLOAD(min(it + 1, a.ntiles - 1));
    asm volatile("" ::: "memory");
    __builtin_amdgcn_sched_barrier(0);
    bool active = true;
    int krow = 0;
    const bool win = (a.mode == 1 && it < a.nwin);
    if (win) { krow = a.krow0 + it; active = (krow >= a.r0w && krow < a.r0w + 8); }
    if (active) {
      const bf16_t* ks_ = sk + buf * 64 * LSTR + ln * LSTR + h * 8;
      f32x16 s0, s1;
#pragma unroll
      for (int r = 0; r < 16; ++r) { s0[r] = -a.m0; s1[r] = -a.m0; }
#pragma unroll
      for (int ks = 0; ks < 4; ++ks) {
        bf16x8 a0 = *(const bf16x8*)(ks_ + ks * 16);
        bf16x8 a1 = *(const bf16x8*)(ks_ + 32 * LSTR + ks * 16);
        s0 = MFMA(a0, qf[ks], s0);
        s1 = MFMA(a1, qf[ks], s1);
      }
      if (win) {
        const int qc = a.cb + ln;
        const int c0 = min(max(qc - 8, 0), 48);
        const float* brow = a.bias + (krow - a.gr + 7) * 31 + 15 - qc;
#pragma unroll
        for (int r = 0; r < 16; ++r) {
          const int kc0 = (r >> 2) * 8 + h * 4 + (r & 3);
          const int kc1 = kc0 + 32;
          s0[r] = (kc0 >= c0 && kc0 < c0 + 16) ? s0[r] + brow[kc0] : -1e30f;
          s1[r] = (kc1 >= c0 && kc1 < c0 + 16) ? s1[r] + brow[kc1] : -1e30f;
        }
      }
#pragma unroll
      for (int r = 0; r < 16; ++r) { s0[r] = __builtin_amdgcn_exp2f(s0[r]); lrun += s0[r]; }
#pragma unroll
      for (int r = 0; r < 16; ++r) { s1[r] = __builtin_amdgcn_exp2f(s1[r]); lrun += s1[r]; }
      const bf16_t* vs_ = sv + buf * 64 * LSTR + ln * LSTR + h * 4;
#pragma unroll
      for (int j = 0; j < 4; ++j) {
        bf16x8 pb;
        {
          unsigned u0, u1, u2, u3;
          if (j < 2) {
            const int b8 = 8 * j;
            u0 = pack2(s0[b8 + 0], s0[b8 + 1]); u1 = pack2(s0[b8 + 2], s0[b8 + 3]);
            u2 = pack2(s0[b8 + 4], s0[b8 + 5]); u3 = pack2(s0[b8 + 6], s0[b8 + 7]);
          } else {
            const int b8 = 8 * (j - 2);
            u0 = pack2(s1[b8 + 0], s1[b8 + 1]); u1 = pack2(s1[b8 + 2], s1[b8 + 3]);
            u2 = pack2(s1[b8 + 4], s1[b8 + 5]); u3 = pack2(s1[b8 + 6], s1[b8 + 7]);
          }
          pb = __builtin_bit_cast(bf16x8, make_uint4(u0, u1, u2, u3));
        }
        const s16x4 lo0 = *(const s16x4*)(vs_ + j * 16);
        const s16x4 hi0 = *(const s16x4*)(vs_ + j * 16 + 8);
        const s16x4 lo1 = *(const s16x4*)(vs_ + 32 * LSTR + j * 16);
        const s16x4 hi1 = *(const s16x4*)(vs_ + 32 * LSTR + j * 16 + 8);
        const bf16x8 av0 = __builtin_shufflevector(lo0, hi0, 0, 1, 2, 3, 4, 5, 6, 7);
        const bf16x8 av1 = __builtin_shufflevector(lo1, hi1, 0, 1, 2, 3, 4, 5, 6, 7);
        o0 = MFMA(av0, pb, o0);
        o1 = MFMA(av1, pb, o1);
      }
    }
    SSTORE(buf ^ 1);
    __syncthreads();
  }
  lrun += shx(lrun, 32);
  const float inv = 1.f / lrun;
  bf16_t* op = a.q + (size_t)(a.qrow + ln) * 512;
#pragma unroll
  for (int rg = 0; rg < 4; ++rg) {
    const int d = rg * 8 + h * 4;
    *(uint2*)(op + d) = make_uint2(pack2(o0[rg * 4 + 0] * inv, o0[rg * 4 + 1] * inv), pack2(o0[rg * 4 + 2] * inv, o0[rg * 4 + 3] * inv));
    *(uint2*)(op + 32 + d) = make_uint2(pack2(o1[rg * 4 + 0] * inv, o1[rg * 4 + 1] * inv), pack2(o1[rg * 4 + 2] * inv, o1[rg * 4 + 3] * inv));
  }
}

DI float wave_max(float v) {
#pragma unroll
  for (int m = 32; m >= 1; m >>= 1) v = fmaxf(v, shx(v, m));
  return v;
}
DI float attn_m0(int qi, int ki, int l) {
  const int lane = tid_() & 63;
  const float* qn = ((const float*)(const __attribute__((address_space(1))) float*)karg(qi)) + l * 64;
  const float* kn = ((const float*)(const __attribute__((address_space(1))) float*)karg(ki)) + l * 64;
  return 8.f * 1.4426950408889634f * 1.02f * wave_max(fabsf(qn[lane])) * wave_max(fabsf(kn[lane]));
}
constexpr int N_A = 32, N_B = 1024, N_C = 1024, N_CTX = 128;
DI void mixer_item(const Params& p, int l, int it, unsigned char* smem) {
  const int w = tid_() >> 6;
  unsigned char* ws = ((unsigned char*)(__attribute__((address_space(1))) unsigned char*)karg(21));
  if (it < N_A) { a_chunk_item(ws, it, smem); return; }
  it -= N_A;
  AttnArgs a;
  a.bias = (const float*)(smem + 4 * 64 * LSTR * 2);
  a.mode = 0; a.gr = 0; a.r0w = 0; a.cb = 0; a.krow0 = 0;
  if (it < N_B) {
    const int hd = it & 7, qb = (it >> 3) & 31, b = it >> 8;
    a.q = (bf16_t*)(ws + O_BQ) + hd * 64;
    a.k = (const bf16_t*)(ws + O_BK) + (hd >> 2) * 64; a.kstride = 128;
    a.vt = (const bf16_t*)(ws + O_BVT) + ((size_t)b * 128 + (hd >> 2) * 64) * PT;
    a.kbase_row = b * PT; a.qrow = b * PT + CL + qb * 128 + w * 32;
    a.ntiles = 68; a.nwin = 68; a.win_p0 = 0;
    a.m0 = attn_m0(11, 12, l);
    attn_run(a, smem);
    return;
  }
  it -= N_B;
  if (it < N_C) {
    const int hd = it & 7, rp = (it >> 3) & 31, b = it >> 8;
    const int g0 = 2 * rp, g1 = 2 * rp + 1;
    const int r00 = min(max(g0 - 4, 0), 56), r01 = min(max(g1 - 4, 0), 56);
    float* bt = (float*)(smem + 4 * 64 * LSTR * 2);
    for (int i = tid_(); i < 465; i += 256) bt[i] = 1.4426950408889634f * ((const float*)(const __attribute__((address_space(1))) float*)karg(15))[((size_t)l * 8 + hd) * 465 + i];
    __syncthreads();
    a.q = (bf16_t*)(ws + O_CQ) + hd * 64;
    a.k = (const bf16_t*)(ws + O_CK) + hd * 64; a.kstride = 512;
    a.vt = (const bf16_t*)(ws + O_CVT) + ((size_t)b * 512 + hd * 64) * PT;
    a.kbase_row = b * PT;
    a.gr = g0 + (w >> 1); a.cb = (w & 1) * 32; a.r0w = (w >> 1) ? r01 : r00; a.krow0 = r00;
    a.qrow = b * PT + CL + a.gr * 64 + a.cb;
    a.nwin = r01 + 8 - r00; a.ntiles = a.nwin + 4; a.win_p0 = CL + r00 * 64;
    a.mode = 1;
    {
      const int lane = tid_() & 63;
      float bm = 0.f;
#pragma unroll
      for (int i = 0; i < 8; ++i) { const int ix = lane + 64 * i; if (ix < 465) bm = fmaxf(bm, fabsf(bt[ix])); }
      a.m0 = attn_m0(13, 14, l) + wave_max(bm);
    }
    attn_run(a, smem);
    return;
  }
  it -= N_C;
  {
    const int hd = it & 7, qb = (it >> 3) & 1, b = (it >> 4) & 3, kc = it >> 6;
    if (kc == 0) {
      a.q = (bf16_t*)(ws + O_BQ) + hd * 64;
      a.k = (const bf16_t*)(ws + O_BK) + (hd >> 2) * 64; a.kstride = 128;
      a.vt = (const bf16_t*)(ws + O_BVT) + ((size_t)b * 128 + (hd >> 2) * 64) * PT;
    } else {
      a.q = (bf16_t*)(ws + O_CQ) + hd * 64;
      a.k = (const bf16_t*)(ws + O_CK) + hd * 64; a.kstride = 512;
      a.vt = (const bf16_t*)(ws + O_CVT) + ((size_t)b * 512 + hd * 64) * PT;
    }
    a.kbase_row = b * PT; a.qrow = b * PT + qb * 128 + w * 32;
    a.ntiles = 4; a.nwin = 4; a.win_p0 = 0;
    a.m0 = (kc == 0) ? attn_m0(11, 12, l) : attn_m0(13, 14, l);
    attn_run(a, smem);
  }
}

DI void readout_row(const Params& p, int l, int row) {
  const int lane = tid_() & 63;
  unsigned char* ws = ((unsigned char*)(__attribute__((address_space(1))) unsigned char*)karg(21));
  bf16_t* og = (bf16_t*)(ws + O_OG) + (size_t)row * 512;
  const uint4 f4 = *(const uint4*)((const bf16_t*)(ws + O_QHF) + (size_t)row * 512 + lane * 8);
  const uint4 b4 = *(const uint4*)((const bf16_t*)(ws + O_QHB) + (size_t)row * 512 + lane * 8);
  const uint4 g4 = *(const uint4*)(og + lane * 8);
  const unsigned ff[4] = {f4.x, f4.y, f4.z, f4.w}, bb[4] = {b4.x, b4.y, b4.z, b4.w}, gg[4] = {g4.x, g4.y, g4.z, g4.w};
  float o[8];
  float ss = 0.f;
#pragma unroll
  for (int i = 0; i < 4; ++i) {
    o[2 * i] = bflo(ff[i]) + bflo(bb[i]);
    o[2 * i + 1] = bfhi(ff[i]) + bfhi(bb[i]);
    ss += o[2 * i] * o[2 * i] + o[2 * i + 1] * o[2 * i + 1];
  }
  ss += shx(ss, 1); ss += shx(ss, 2); ss += shx(ss, 4); ss += shx(ss, 8);
  const float rs = rsqrtf(ss * (1.f / 128.f) + EPS);
  const float* gn = ((const float*)(const __attribute__((address_space(1))) float*)karg(10)) + l * 128 + (lane & 15) * 8;
  unsigned outp[4];
#pragma unroll
  for (int i = 0; i < 4; ++i) {
    const float g0 = bflo(gg[i]), g1 = bfhi(gg[i]);
    outp[i] = pack2(o[2 * i] * rs * gn[2 * i] * siluf_(g0), o[2 * i + 1] * rs * gn[2 * i + 1] * siluf_(g1));
  }
  *(uint4*)(og + lane * 8) = make_uint4(outp[0], outp[1], outp[2], outp[3]);
}

DI bool xcd_tile(int seq, int bid, int nblk, int MX, int NX, int& mt, int& nt) {
  const int per = nblk >> 3, li = bid >> 3, x = bid & 7;
  const int u = li + seq * per;
  if (u >= MX * NX) return false;
  const int FM = MX >> 3, fullsz = 8 * NX;
  int mgi, r, gm;
  if (u < FM * fullsz) { mgi = u / fullsz; r = u - mgi * fullsz; gm = 8; }
  else { mgi = FM; r = u - FM * fullsz; gm = MX & 7; }
  const int ngi = r / (gm * 8), r2 = r - ngi * gm * 8;
  const int nj = r2 / gm, mi = r2 - nj * gm;
  mt = x * MX + mgi * 8 + mi;
  nt = ngi * 8 + nj;
  return true;
}
DI int mtile_row0(int l, int mt) { return l == 0 ? mt * 128 : ((mt >> 5) * PT + CL + (mt & 31) * 128); }

#ifndef SKIPM
#define SKIPM 0
#endif
#ifdef PROBE_REP
__device__ const unsigned char PSEQ[] = {0, 1, 2, PROBE_R(2) 3, 4, 5, PROBE_R(5) 6, 7, 8, PROBE_R(8) 9, 10, 11, PROBE_R(11) 12, 13, 14, PROBE_R(14) 15, 16, 17, PROBE_R(17) 18};
#else
__device__ const unsigned char PSEQ[] = {0, 1, 2, 3, 4, 5, 6, 7, 8, 9, 10, 11, 12, 13, 14, 15, 16, 17, 18};
#endif
constexpr int NSEQ = sizeof(PSEQ);
#define OPAQUE_S(x) asm volatile("" : "+s"(x))
__global__ void __launch_bounds__(256, 2) fwd_megakernel(Params p) {
  extern __shared__ __attribute__((aligned(16))) unsigned char smem[];
  __shared__ __attribute__((aligned(16))) unsigned sh_words[8];
#define s_item (((int*)sh_words)[4])
#define s_key (((int*)sh_words)[5])
  cg::grid_group grid = cg::this_grid();
  const int nblk = gridDim.x, bid = blockIdx.x;
  if (threadIdx.x == 0) { sh_words[0] = 0u; sh_words[1] = 0u; sh_words[2] = 0u; sh_words[3] = 0u; }
  __syncthreads();
  (void)xcd_barrier_post((unsigned*)(((unsigned char*)(__attribute__((address_space(1))) unsigned char*)karg(21)) + O_BAR), (volatile LAS unsigned*)sh_words);

  for (int pi = 0; pi < NSEQ; ++pi) {
    const int ph = PSEQ[pi];
    const int tid = tid_(), lane = tid & 63, w = tid >> 6, wm = w >> 1, wn = w & 1;
    unsigned char* ws = ((unsigned char*)(__attribute__((address_space(1))) unsigned char*)karg(21));
    const int l = (ph - 1) / 9, k = (ph == 0) ? -1 : (ph - 1) % 9;
    const int nmt = (l == 0) ? 136 : 128;
    if (k == -1 && !(SKIPM & 1)) {
      int* ctr = (int*)(ws + O_CTR);
      for (int i = bid * 256 + tid; i < 64 + 4 * 4096; i += nblk * 256) ctr[i] = 0;
      if (bid == 1 || nblk == 1) {
        float* ropet = (float*)(ws + O_ROPE);
        for (int i = tid; i < 1024; i += 256) {
          const int pos = i >> 4, j = i & 15;
          const float inv = exp2f(-(float)j * (13.287712379549449f / 16.f));
          const float ang = (float)pos * inv;
          ropet[i * 2] = __cosf(ang); ropet[i * 2 + 1] = __sinf(ang);
        }
      }
      for (int it = bid; it < 384 + CVT_ITEMS; it += nblk) {
        if (it < 384) mod_item(p, it, smem); else cvt_item(p, 0, it - 384, smem);
      }
    } else if (k == 0 && !(SKIPM & 2)) {
      if (l == 1) for (int it = bid; it < CVT_ITEMS; it += nblk) cvt_item(p, 1, it, smem);
      for (int row = bid * 4 + w; row < NT; row += nblk * 4) norm_row(p, l, 0, row, ((const float*)(const __attribute__((address_space(1))) float*)karg(6)) + l * 1024, 0, 1024);
    } else if (k == 1 && !(SKIPM & 4)) {
      for (int sq = 0;; ++sq) {
        int mt, nt;
        if (!xcd_tile(sq, bid, nblk, 17, 42, mt, nt)) break;
        f32x16 acc[2][2];
        zero_acc(acc);
        gemm_tile<false>((const bf16_t*)(ws + O_UO) + (size_t)mt * 128 * 1024, 1024, (const bf16_t*)(ws + O_WIN) + (size_t)nt * 128 * 1024, 1024, 1024, acc, smem);
        inproj_epilogue(p, l, acc, mt * 128 + wm * 64, nt * 128 + wn * 64);
      }
    } else if (k == 2 && !(SKIPM & 8)) {
      int* ctr = (int*)(ws + O_CTR);
      const int nattn = N_B + N_C + (l == 0 ? N_CTX : 0);
      if (tid == 0) {
        const unsigned hw = __builtin_amdgcn_s_getreg(4 | (31 << 11));
        const unsigned xcc = __builtin_amdgcn_s_getreg(20 | (31 << 11));
        const int key = (int)(((xcc & 15u) << 8) | ((hw >> 8) & 255u));
        int* cuflag = ctr + 64 + 2 * 4096 + l * 4096 + key;
        const int r = atomicAdd(ctr + 64 + l * 4096 + key, 1);
        int item = -1;
        if (r == 0) {
          const int it = atomicAdd(ctr + l * 2 + 0, 1);
          if (it < N_A) { item = it; atomicExch(cuflag, 1); } else atomicExch(cuflag, 2);
        } else {
          for (int spin = 0; spin < (1 << 20); ++spin) {
            const int v = atomicAdd(cuflag, 0);
            if (v >= 2) break;
            __builtin_amdgcn_s_sleep(32);
          }
        }
        s_item = item; s_key = key;
      }
      __syncthreads();
      const int myitem = s_item, mykey = s_key;
      __syncthreads();
      if (myitem >= 0) {
        mixer_item(p, l, myitem, smem);
        __syncthreads();
        if (tid == 0) atomicExch(ctr + 64 + 2 * 4096 + l * 4096 + mykey, 3);
      }
      for (int pass = 0; pass < 2; ++pass) {
        const int q = 1 ^ pass;
        const int total = (q == 0) ? N_A : nattn;
        for (;;) {
          if (tid == 0) s_item = atomicAdd(ctr + l * 2 + q, 1);
          __syncthreads();
          const int it = s_item;
          __syncthreads();
          if (it >= total) break;
          mixer_item(p, l, q == 0 ? it : N_A + it, smem);
        }
      }
    } else if (k == 3 && !(SKIPM & 16)) {
      for (int i = bid * 4 + w; i < nmt * 128; i += nblk * 4) {
        const int row = (l == 0) ? i : ((i >> 12) * PT + CL + (i & 4095));
        readout_row(p, l, row);
      }
    } else if (k == 4 && !(SKIPM & 32)) {
      float4* msc = (float4*)(ws + O_CK) + (size_t)bid * 4096 + tid;
      for (int sq = 0;; ++sq) {
        int mt, nt;
        if (!xcd_tile(sq, bid, nblk, nmt >> 3, 8, mt, nt)) break;
        const int m0 = mtile_row0(l, mt), n0 = nt * 128;
#pragma unroll 1
        for (int kb = 0; kb < 3; ++kb) {
          f32x16 acc[2][2];
          zero_acc(acc);
          gemm_tile<true>((const bf16_t*)(ws + O_UO) + (size_t)m0 * 1024, 1024, (const bf16_t*)(ws + O_WIN) + (size_t)(PW + kb * 1024 + n0) * 1024, 1024, 1024, acc, smem);
          uint4* gsc = (uint4*)(ws + O_QHF) + (size_t)bid * 2048 + tid;
#pragma unroll
          for (int i = 0; i < 2; ++i)
#pragma unroll
            for (int j = 0; j < 2; ++j) {
              unsigned g8[8];
#pragma unroll
              for (int r = 0; r < 8; ++r) g8[r] = pack2(sigmoidf_(acc[i][j][2 * r]), sigmoidf_(acc[i][j][2 * r + 1]));
              gsc[((i * 2 + j) * 2 + 0) * 256] = make_uint4(g8[0], g8[1], g8[2], g8[3]);
              gsc[((i * 2 + j) * 2 + 1) * 256] = make_uint4(g8[4], g8[5], g8[6], g8[7]);
            }
          zero_acc(acc);
          const size_t yo = (kb == 0) ? O_OG : (kb == 1 ? O_BQ : O_CQ);
          gemm_tile<true>((const bf16_t*)(ws + yo) + (size_t)m0 * 512, 512, (const bf16_t*)(ws + O_WBR) + ((size_t)kb * 1024 + n0) * 512, 512, 512, acc, smem);
          const int h = lane >> 5, ln = lane & 31;
          int mso = 0, rowb = m0 + wm * 64 + ln, colb = n0 + wn * 64 + h * 4;
          asm volatile("" : "+v"(mso), "+v"(rowb), "+v"(colb));
#pragma unroll
          for (int i = 0; i < 2; ++i)
#pragma unroll
            for (int j = 0; j < 2; ++j) {
              const uint4 ga = gsc[mso + ((i * 2 + j) * 2 + 0) * 256], gb = gsc[mso + ((i * 2 + j) * 2 + 1) * 256];
              const unsigned g8[8] = {ga.x, ga.y, ga.z, ga.w, gb.x, gb.y, gb.z, gb.w};
#pragma unroll
              for (int rg = 0; rg < 4; ++rg) {
                float4 v;
                v.x = bflo(g8[rg * 2]) * acc[i][j][rg * 4 + 0];
                v.y = bfhi(g8[rg * 2]) * acc[i][j][rg * 4 + 1];
                v.z = bflo(g8[rg * 2 + 1]) * acc[i][j][rg * 4 + 2];
                v.w = bfhi(g8[rg * 2 + 1]) * acc[i][j][rg * 4 + 3];
                float4* sp = msc + mso + ((i * 2 + j) * 4 + rg) * 256;
                if (kb > 0) { const float4 o = *sp; v.x += o.x; v.y += o.y; v.z += o.z; v.w += o.w; }
                if (kb < 2) *sp = v;
                else {
                  bf16_t* mo = (bf16_t*)(ws + O_M);
                  const int row = rowb + i * 32;
                  const int col = colb + j * 32 + rg * 8;
                  *(uint2*)(mo + (size_t)row * 1024 + col) = make_uint2(pack2(v.x, v.y), pack2(v.z, v.w));
                }
                __builtin_amdgcn_sched_barrier(0);
              }
            }
        }
      }
    } else if (k == 5 && !(SKIPM & 64)) {
      for (int sq = 0;; ++sq) {
        int mt, nt;
        if (!xcd_tile(sq, bid, nblk, nmt >> 3, 8, mt, nt)) break;
        const int m0 = mtile_row0(l, mt), n0 = nt * 128;
        f32x16 acc[2][2];
        zero_acc(acc);
        gemm_tile<true>((const bf16_t*)(ws + O_M) + (size_t)m0 * 1024, 1024, (const bf16_t*)(ws + O_WOUT) + (size_t)n0 * 1024, 1024, 1024, acc, smem);
        const int h = lane >> 5, ln = lane & 31;
#pragma unroll
        for (int i = 0; i < 2; ++i) {
          const int row = m0 + wm * 64 + i * 32 + ln;
          const int b = row / PT, q = row % PT;
          const float* xin = xrow_ptr(p, l, 0, row);
          float* xo = (q < CL) ? (float*)(ws + O_XC) + ((size_t)b * CL + q) * D : ((float*)(__attribute__((address_space(1))) float*)karg(20)) + ((size_t)b * SEQ + (q - CL)) * D;
          const float* modf = (const float*)(ws + O_MOD) + ((size_t)l * 5 + (q < CL ? 4 : b)) * 6144 + 2048;
#pragma unroll
          for (int j = 0; j < 2; ++j)
#pragma unroll
            for (int rg = 0; rg < 4; ++rg) {
              const int col = n0 + wn * 64 + j * 32 + rg * 8 + h * 4;
              const float4 xi = *(const float4*)(xin + col);
              const float4 g = *(const float4*)(modf + col);
              float4 o;
              o.x = xi.x + g.x * acc[i][j][rg * 4 + 0]; o.y = xi.y + g.y * acc[i][j][rg * 4 + 1];
              o.z = xi.z + g.z * acc[i][j][rg * 4 + 2]; o.w = xi.w + g.w * acc[i][j][rg * 4 + 3];
              *(float4*)(xo + col) = o;
            }
        }
      }
    } else if (k == 6 && !(SKIPM & 128)) {
      for (int i = bid * 4 + w; i < nmt * 128; i += nblk * 4) {
        const int row = (l == 0) ? i : ((i >> 12) * PT + CL + (i & 4095));
        norm_row(p, l, 1, row, ((const float*)(const __attribute__((address_space(1))) float*)karg(7)) + l * 1024, 3072, 4096);
      }
    } else if (k == 7 && !(SKIPM & 256)) {
      for (int sq = 0;; ++sq) {
        int mt, nt;
        if (!xcd_tile(sq, bid, nblk, nmt >> 3, 44, mt, nt)) break;
        const int m0 = mtile_row0(l, mt);
        f32x16 acc[2][2];
        zero_acc(acc);
        gemm_tile<true>((const bf16_t*)(ws + O_UO) + (size_t)m0 * 1024, 1024, (const bf16_t*)(ws + O_WGU) + (size_t)nt * 128 * 1024, 1024, 1024, acc, smem);
        bf16_t* ao = (bf16_t*)(ws + O_ACT);
        const int h = lane >> 5, ln = lane & 31;
#pragma unroll
        for (int i = 0; i < 2; ++i) {
          bf16_t* ar = ao + (size_t)(m0 + wm * 64 + i * 32 + ln) * FH + nt * 64 + wn * 32 + h * 4;
#pragma unroll
          for (int rg = 0; rg < 4; ++rg)
            *(uint2*)(ar + rg * 8) = make_uint2(pack2(siluf_(acc[i][0][rg * 4 + 0]) * acc[i][1][rg * 4 + 0], siluf_(acc[i][0][rg * 4 + 1]) * acc[i][1][rg * 4 + 1]),
                                                pack2(siluf_(acc[i][0][rg * 4 + 2]) * acc[i][1][rg * 4 + 2], siluf_(acc[i][0][rg * 4 + 3]) * acc[i][1][rg * 4 + 3]));
        }
      }
    } else if (!(SKIPM & 512)) {
      for (int sq = 0;; ++sq) {
        int mt, nt;
        if (!xcd_tile(sq, bid, nblk, nmt >> 3, 8, mt, nt)) break;
        const int m0 = mtile_row0(l, mt), n0 = nt * 128;
        f32x16 acc[2][2];
        zero_acc(acc);
        gemm_tile<true>((const bf16_t*)(ws + O_ACT) + (size_t)m0 * FH, FH, (const bf16_t*)(ws + O_WD) + (size_t)n0 * FH, FH, FH, acc, smem);
        const int h = lane >> 5, ln = lane & 31;
#pragma unroll
        for (int i = 0; i < 2; ++i) {
          const int row = m0 + wm * 64 + i * 32 + ln;
          const int b = row / PT, q = row % PT;
          float* xo = (q < CL) ? (float*)(ws + O_XC) + ((size_t)b * CL + q) * D : ((float*)(__attribute__((address_space(1))) float*)karg(20)) + ((size_t)b * SEQ + (q - CL)) * D;
          const float* modf = (const float*)(ws + O_MOD) + ((size_t)l * 5 + (q < CL ? 4 : b)) * 6144 + 5120;
#pragma unroll
          for (int j = 0; j < 2; ++j)
#pragma unroll
            for (int rg = 0; rg < 4; ++rg) {
              const int col = n0 + wn * 64 + j * 32 + rg * 8 + h * 4;
              const float4 xi = *(const float4*)(xo + col);
              const float4 g = *(const float4*)(modf + col);
              float4 o;
              o.x = xi.x + g.x * acc[i][j][rg * 4 + 0]; o.y = xi.y + g.y * acc[i][j][rg * 4 + 1];
              o.z = xi.z + g.z * acc[i][j][rg * 4 + 2]; o.w = xi.w + g.w * acc[i][j][rg * 4 + 3];
              *(float4*)(xo + col) = o;
            }
        }
      }
    }
    if (nblk > (1 << 30)) grid.sync();
    else if (pi < NSEQ - 1) {
      XcdBarrier xb; xb.bar = (unsigned*)(ws + O_BAR); xb.x = xb_xcc_id(); xb.st = (volatile LAS unsigned*)sh_words;
      xcd_barrier(xb);
    }
  }
}

extern "C" void kernel_launch(void* const* d_in, const int* in_sizes, int n_in, void* d_out, int out_size, void* d_ws, size_t ws_size,
                              hipStream_t stream) {
  static int grid_blocks = 0;
  if (grid_blocks == 0) {
    if (ws_size < WS_END) { fprintf(stderr, "kernel_launch: workspace too small: %zu < %zu\n", ws_size, (size_t)WS_END); grid_blocks = -1; return; }
    int dev = 0, cus = 0, per_cu = 0;
    hipGetDevice(&dev);
    hipDeviceGetAttribute(&cus, hipDeviceAttributeMultiprocessorCount, dev);
    hipFuncSetAttribute((const void*)fwd_megakernel, hipFuncAttributeMaxDynamicSharedMemorySize, LDS_BYTES);
    hipOccupancyMaxActiveBlocksPerMultiprocessor(&per_cu, (const void*)fwd_megakernel, 256, LDS_BYTES);
    if (per_cu < 1) { fprintf(stderr, "kernel_launch: occupancy query returned %d\n", per_cu); grid_blocks = -1; return; }
    if (per_cu > 2) per_cu = 2;
    grid_blocks = cus * per_cu;
  }
  if (grid_blocks < 0) return;
  Params p{};
  p.x = (const float*)d_in[0]; p.c = (const float*)d_in[1]; p.ctx = (const float*)d_in[2]; p.c_ctx = (const float*)d_in[3];
  p.w_mod = (const float*)d_in[4]; p.b_mod = (const float*)d_in[5]; p.norm_mix = (const float*)d_in[6]; p.norm_ffn = (const float*)d_in[7];
  p.w_in = (const float*)d_in[8]; p.lb_raw = (const float*)d_in[9]; p.gn_a = (const float*)d_in[10]; p.qn_b = (const float*)d_in[11];
  p.kn_b = (const float*)d_in[12]; p.qn_c = (const float*)d_in[13]; p.kn_c = (const float*)d_in[14]; p.rel_bias = (const float*)d_in[15];
  p.w_branch = (const float*)d_in[16]; p.w_out = (const float*)d_in[17]; p.w_gate_up = (const float*)d_in[18]; p.w_down = (const float*)d_in[19];
  p.out = (float*)d_out; p.ws = (unsigned char*)d_ws;
  if (hipMemsetAsync((unsigned char*)d_ws + O_BAR, 0, 16384, stream) != hipSuccess) { fprintf(stderr, "kernel_launch: hipMemsetAsync of the barrier words failed\n"); return; }
  void* args[] = {&p};
  hipError_t e = hipLaunchCooperativeKernel((const void*)fwd_megakernel, dim3(grid_blocks), dim3(256), args, LDS_BYTES, stream);
  if (e != hipSuccess) fprintf(stderr, "cooperative launch failed: %s (grid %d)\n", hipGetErrorString(e), grid_blocks);
}
```

```cpp
#include <hip/hip_runtime.h>
#include <hip/hip_cooperative_groups.h>
#include <cstdio>
namespace cg = cooperative_groups;

typedef short bf16x8 __attribute__((ext_vector_type(8)));
typedef short s16x4 __attribute__((ext_vector_type(4)));
typedef float f32x16 __attribute__((ext_vector_type(16)));
typedef float f32x2 __attribute__((ext_vector_type(2)));
typedef __bf16 bf16x2_t __attribute__((ext_vector_type(2)));
typedef unsigned short bf16_t;
#define DI __device__ __forceinline__
#define MFMA(a, b, c) __builtin_amdgcn_mfma_f32_32x32x16_bf16((a), (b), (c), 0, 0, 0)

constexpr int D = 1024, NB = 4, SEQ = 4096, CL = 256, PT = 4352, NT = NB * PT;
constexpr int INW = 7936, INW2 = 8448, PW = 5376, FH = 2816, GU = 5632;
constexpr float EPS = 1e-6f;

constexpr size_t SZ512 = (size_t)NT * 512 * 2;
constexpr size_t SZ128 = (size_t)NT * 128 * 2;
constexpr size_t O_WIN = 0;
constexpr size_t O_WBR = O_WIN + (size_t)INW2 * D * 2;
constexpr size_t O_WOUT = O_WBR + (size_t)3 * D * 512 * 2;
constexpr size_t O_WGU = O_WOUT + (size_t)D * D * 2;
constexpr size_t O_WD = O_WGU + (size_t)GU * D * 2;
constexpr size_t O_UO = O_WD + (size_t)D * FH * 2;
constexpr size_t O_P = O_UO + (size_t)NT * 1024 * 2;
constexpr size_t O_QHF = O_P;
constexpr size_t O_KTF = O_QHF + SZ512;
constexpr size_t O_QHB = O_KTF + SZ512;
constexpr size_t O_KTB = O_QHB + SZ512;
constexpr size_t O_VA = O_KTB + SZ512;
constexpr size_t O_OG = O_VA + SZ512;
constexpr size_t O_BQ = O_OG + SZ512;
constexpr size_t O_CQ = O_BQ + SZ512;
constexpr size_t O_CK = O_CQ + SZ512;
constexpr size_t O_CVT = O_CK + SZ512;
constexpr size_t O_BK = O_CVT + SZ512;
constexpr size_t O_BVT = O_BK + SZ128;
constexpr size_t O_EBL = O_BVT + SZ128;
constexpr size_t O_XC = O_EBL + (size_t)2 * (NT / 32) * 512 * 4;
constexpr size_t O_MOD = O_XC + (size_t)NB * CL * D * 4;
constexpr size_t O_ROPE = O_MOD + (size_t)2 * 5 * 6144 * 4;
constexpr size_t O_CTR = O_ROPE + 64 * 16 * 2 * 4;
constexpr size_t O_BAR = O_CTR + (64 + 4 * 4096) * 4;
constexpr size_t WS_END = O_BAR + 16384;
constexpr size_t O_M = O_QHB;
constexpr size_t O_ACT = O_P;

constexpr int LDS_BYTES = 73728;
constexpr int LSTR = 72;

struct Params {
  const float* x; const float* c; const float* ctx; const float* c_ctx; const float* w_mod; const float* b_mod;
  const float* norm_mix; const float* norm_ffn; const float* w_in; const float* lb_raw; const float* gn_a;
  const float* qn_b; const float* kn_b; const float* qn_c; const float* kn_c; const float* rel_bias;
  const float* w_branch; const float* w_out; const float* w_gate_up; const float* w_down;
  float* out; unsigned char* ws;
};


typedef const unsigned long long __attribute__((address_space(4))) karg_t;
DI unsigned long long karg(int i) { return *(volatile karg_t*)((karg_t*)__builtin_amdgcn_kernarg_segment_ptr() + i); }
DI int tid_() { int t = threadIdx.x; asm volatile("" : "+v"(t)); return t; }
DI unsigned pack2(float a, float b) {
  f32x2 v = {a, b};
  bf16x2_t r = __builtin_convertvector(v, bf16x2_t);
  return __builtin_bit_cast(unsigned, r);
}
DI bf16_t tobf(float a) { return (bf16_t)(pack2(a, 0.f) & 0xffffu); }
DI float bflo(unsigned u) { return __uint_as_float(u << 16); }
DI float bfhi(unsigned u) { return __uint_as_float(u & 0xffff0000u); }
DI float sigmoidf_(float x) { return __builtin_amdgcn_rcpf(1.f + __builtin_amdgcn_exp2f(-1.4426950408889634f * x)); }
DI float siluf_(float x) { return x * __builtin_amdgcn_rcpf(1.f + __builtin_amdgcn_exp2f(-1.4426950408889634f * x)); }
DI float shx(float v, int m) { return __shfl_xor(v, m); }

#define XB_TMO      128
#define XB_XCNT(j)  (256  + 64 * (j))
#define XB_XSUB(j)  (1280 + 64 * (j))
#define XB_XGEN(j)  (2304 + 64 * (j))
#define XB_TOP      3328
#define XB_TOPGEN   3392
#define XCD_BAR_WORDS 3456
#define XB_SPIN_CAP (1u << 18)
#define LAS __attribute__((address_space(3)))
DI unsigned xb_ld(unsigned* p)              { return __hip_atomic_load(p, __ATOMIC_RELAXED, __HIP_MEMORY_SCOPE_AGENT); }
DI unsigned xb_add(unsigned* p, unsigned v) { return __hip_atomic_fetch_add(p, v, __ATOMIC_RELAXED, __HIP_MEMORY_SCOPE_AGENT); }
DI unsigned xb_xcc_id() { return (unsigned)__builtin_amdgcn_s_getreg((3 << 11) | 20) & 0xFu; }
#define XB_SPIN(cond, bar) do { unsigned _sp = 0; while (cond) { __builtin_amdgcn_s_sleep(1); \
    if ((++_sp & 255u) == 0u) { if (xb_ld(&(bar)[XB_TMO])) break; if (_sp > XB_SPIN_CAP) { atomicAdd(&(bar)[XB_TMO], 1u); break; } } } } while (0)
struct XcdBarrier { unsigned* bar; unsigned x; volatile LAS unsigned* st; };
DI XcdBarrier xcd_barrier_post(unsigned* bar, volatile LAS unsigned* st) {
  XcdBarrier b; b.bar = bar; b.x = xb_xcc_id(); b.st = st;
  if (threadIdx.x == 0) (void)xb_add(&bar[XB_XCNT(b.x)], 1u);
  return b;
}
DI void xcd_barrier_complete(unsigned* bar, unsigned x, unsigned& nloc, unsigned& nx) {
  const unsigned G = gridDim.x * gridDim.y * gridDim.z;
  unsigned sum, cnt, mine, sp = 0u;
  for (;;) {
    sum = 0u; cnt = 0u; mine = 0u;
#pragma unroll
    for (unsigned j = 0; j < 16; ++j) { const unsigned c = xb_ld(&bar[XB_XCNT(j)]); sum += c; cnt += (c > 0u) ? 1u : 0u; mine = (j == x) ? c : mine; }
    if (sum == G) break;
    __builtin_amdgcn_s_sleep(1);
    if ((++sp & 255u) == 0u) { if (xb_ld(&bar[XB_TMO])) break; if (sp > XB_SPIN_CAP) { atomicAdd(&bar[XB_TMO], 1u); break; } }
  }
  nloc = mine > 0u ? mine : 1u; nx = cnt > 0u ? cnt : 1u;
}
DI void xcd_barrier(const XcdBarrier& b) {
  asm volatile("s_waitcnt vmcnt(0)" ::: "memory");
  __syncthreads();
  if (threadIdx.x == 0) {
    unsigned* bar = b.bar;
    __builtin_amdgcn_s_waitcnt(0);
    unsigned nloc = b.st[0], nx = b.st[1];
    if (nloc == 0u) { xcd_barrier_complete(bar, b.x, nloc, nx); b.st[0] = nloc; b.st[1] = nx; }
    const unsigned old = xb_add(&bar[XB_XSUB(b.x)], 1u);
    const unsigned gen = old / nloc;
    if (old + 1u == (gen + 1u) * nloc) {
      __builtin_amdgcn_fence(__ATOMIC_RELEASE, "agent");
      asm volatile("s_waitcnt vmcnt(0)" ::: "memory");
      const unsigned og = xb_add(&bar[XB_TOP], 1u);
      const unsigned tg = og / nx;
      if (og + 1u == (tg + 1u) * nx) xb_add(&bar[XB_TOPGEN], 1u);
      else XB_SPIN(xb_ld(&bar[XB_TOPGEN]) == tg, bar);
      __builtin_amdgcn_fence(__ATOMIC_ACQUIRE, "agent");
      xb_add(&bar[XB_XGEN(b.x)], 1u);
      asm volatile("s_waitcnt vmcnt(0)" ::: "memory");
    } else {
      XB_SPIN(xb_ld(&bar[XB_XGEN(b.x)]) == gen, bar);
      __builtin_amdgcn_fence(__ATOMIC_ACQUIRE, "agent");
      asm volatile("s_waitcnt vmcnt(0)" ::: "memory");
    }
  }
  __syncthreads();
}

template <bool TR> DI void gemm_tile(const bf16_t* A, int lda, const bf16_t* Bt, int ldb, int K,
                  f32x16 (&acc)[2][2], unsigned char* smem) {
  const int tid = tid_(), lane = tid & 63, w = tid >> 6, wm = w >> 1, wn = w & 1;
  bf16_t* sa = (bf16_t*)smem;
  bf16_t* sb = sa + 2 * 128 * LSTR;
  const int lrow = tid >> 3, lkc = (tid & 7) * 8;
  const bf16_t* ga = A + (size_t)lrow * lda + lkc;
  const bf16_t* gb = Bt + (size_t)lrow * ldb + lkc;
  uint4 pa0, pa1, pa2, pa3, pb0, pb1, pb2, pb3;
  uint4 qa0, qa1, qa2, qa3, qb0, qb1, qb2, qb3;
#define GT_LOAD(S, koff) { \
    S##a0 = *(const uint4*)(ga + (koff)); S##a1 = *(const uint4*)(ga + (size_t)32 * lda + (koff)); \
    S##a2 = *(const uint4*)(ga + (size_t)64 * lda + (koff)); S##a3 = *(const uint4*)(ga + (size_t)96 * lda + (koff)); \
    S##b0 = *(const uint4*)(gb + (koff)); S##b1 = *(const uint4*)(gb + (size_t)32 * ldb + (koff)); \
    S##b2 = *(const uint4*)(gb + (size_t)64 * ldb + (koff)); S##b3 = *(const uint4*)(gb + (size_t)96 * ldb + (koff)); \
    asm volatile("" ::: "memory"); __builtin_amdgcn_sched_barrier(0); }
#define GT_STORE(S, bufi) { \
    bf16_t* da_ = sa + (bufi) * 128 * LSTR + lrow * LSTR + lkc; bf16_t* db_ = sb + (bufi) * 128 * LSTR + lrow * LSTR + lkc; \
    *(uint4*)(da_) = S##a0; *(uint4*)(da_ + 32 * LSTR) = S##a1; *(uint4*)(da_ + 64 * LSTR) = S##a2; *(uint4*)(da_ + 96 * LSTR) = S##a3; \
    *(uint4*)(db_) = S##b0; *(uint4*)(db_ + 32 * LSTR) = S##b1; *(uint4*)(db_ + 64 * LSTR) = S##b2; *(uint4*)(db_ + 96 * LSTR) = S##b3; }
#define GT_FRAGS(F0, F1, G0, G1, KS) \
    F0 = *(const bf16x8*)(as + (KS) * 16); F1 = *(const bf16x8*)(as + 32 * LSTR + (KS) * 16); \
    G0 = *(const bf16x8*)(bs + (KS) * 16); G1 = *(const bf16x8*)(bs + 32 * LSTR + (KS) * 16);
#define MMA_(a_, b_, c_) (TR ? MFMA(b_, a_, c_) : MFMA(a_, b_, c_))
#define GEMM_STEP(A0, A1, B0, B1, PRE, ST0, ST1) \
    PRE \
    acc[0][0] = MMA_(A0, B0, acc[0][0]); acc[0][1] = MMA_(A0, B1, acc[0][1]); \
    ST0; ST1; \
    acc[1][0] = MMA_(A1, B0, acc[1][0]); acc[1][1] = MMA_(A1, B1, acc[1][1]); \
    __builtin_amdgcn_sched_barrier(0);
#define GT_COMPUTE(bufi, S, sbuf) { \
    const bf16_t* as = sa + (bufi) * 128 * LSTR + wm * 64 * LSTR + fo; \
    const bf16_t* bs = sb + (bufi) * 128 * LSTR + wn * 64 * LSTR + fo; \
    bf16_t* da_ = sa + (sbuf) * 128 * LSTR + lrow * LSTR + lkc; bf16_t* db_ = sb + (sbuf) * 128 * LSTR + lrow * LSTR + lkc; \
    bf16x8 a0, a1, b0, b1, c0, c1, d0, d1, e0, e1, f0, f1; \
    GT_FRAGS(a0, a1, b0, b1, 0) GT_FRAGS(c0, c1, d0, d1, 1) \
    GEMM_STEP(a0, a1, b0, b1, GT_FRAGS(e0, e1, f0, f1, 2), *(uint4*)(da_) = S##a0, *(uint4*)(db_) = S##b0) \
    GEMM_STEP(c0, c1, d0, d1, GT_FRAGS(a0, a1, b0, b1, 3), *(uint4*)(da_ + 32 * LSTR) = S##a1, *(uint4*)(db_ + 32 * LSTR) = S##b1) \
    GEMM_STEP(e0, e1, f0, f1, , *(uint4*)(da_ + 64 * LSTR) = S##a2, *(uint4*)(db_ + 64 * LSTR) = S##b2) \
    GEMM_STEP(a0, a1, b0, b1, , *(uint4*)(da_ + 96 * LSTR) = S##a3, *(uint4*)(db_ + 96 * LSTR) = S##b3) }
  const int nk = K >> 6;
  const int fo = (lane & 31) * LSTR + (lane >> 5) * 8;
  GT_LOAD(p, 0)
  GT_LOAD(q, 64)
  GT_STORE(p, 0)
  __syncthreads();
  for (int kt = 0; kt < nk; kt += 2) {
    GT_LOAD(p, min(kt + 2, nk - 1) * 64)
    GT_COMPUTE(0, q, 1)
    __syncthreads();
    GT_LOAD(q, min(kt + 3, nk - 1) * 64)
    GT_COMPUTE(1, p, 0)
    __syncthreads();
  }
}
DI void zero_acc(f32x16 (&acc)[2][2]) {
#pragma unroll
  for (int i = 0; i < 2; ++i)
#pragma unroll
    for (int j = 0; j < 2; ++j)
#pragma unroll
      for (int r = 0; r < 16; ++r) acc[i][j][r] = 0.f;
}

DI void cvt_tile(const float* __restrict__ src, int ldsrc, int k0, int scol0a, int scol0b, bf16_t* __restrict__ dst, int K, int n0,
                 unsigned char* smem) {
  float* t = (float*)smem;
  const int tid = tid_();
  {
    const int kk = tid >> 4, c4 = (tid & 15) * 4;
    const int sc = (c4 < 32) ? (scol0a + c4) : (scol0b + c4 - 32);
#pragma unroll
    for (int i = 0; i < 4; ++i) {
      const int k = kk + i * 16;
      float4 v = *(const float4*)(src + (size_t)(k0 + k) * ldsrc + sc);
      t[k * 65 + c4 + 0] = v.x; t[k * 65 + c4 + 1] = v.y; t[k * 65 + c4 + 2] = v.z; t[k * 65 + c4 + 3] = v.w;
    }
  }
  __syncthreads();
  {
    const int n = tid >> 2, kq = (tid & 3) * 16;
    unsigned o[8];
#pragma unroll
    for (int j = 0; j < 8; ++j) o[j] = pack2(t[(kq + 2 * j) * 65 + n], t[(kq + 2 * j + 1) * 65 + n]);
    bf16_t* d = dst + (size_t)(n0 + n) * K + k0 + kq;
    *(uint4*)d = make_uint4(o[0], o[1], o[2], o[3]);
    *(uint4*)(d + 8) = make_uint4(o[4], o[5], o[6], o[7]);
  }
  __syncthreads();
}
constexpr int CVT_ITEMS = 2112 + 384 + 256 + 1408 + 704;
DI void cvt_item(const Params& p, int l, int it, unsigned char* smem) {
  unsigned char* ws = ((unsigned char*)(__attribute__((address_space(1))) unsigned char*)karg(21));
  if (it < 2112) {
    const int kt = it & 15, nt = it >> 4;
    int ca, cb;
    if (nt < 16) { ca = 32 * nt; cb = 512 + 32 * nt; }
    else if (nt < 32) { ca = 32 * (nt - 16); cb = 1024 + 32 * (nt - 16); }
    else { ca = 64 * (nt - 32) + 1536; cb = ca + 32; }
    cvt_tile(((const float*)(const __attribute__((address_space(1))) float*)karg(8)) + (size_t)l * D * INW, INW, kt * 64, ca, cb, (bf16_t*)(ws + O_WIN), D, nt * 64, smem);
    return;
  }
  it -= 2112;
  if (it < 384) {
    const int kb = it / 128, r = it % 128, kt = r & 7, nt = r >> 3;
    cvt_tile(((const float*)(const __attribute__((address_space(1))) float*)karg(16)) + ((size_t)l * 3 + kb) * 512 * D, D, kt * 64, nt * 64, nt * 64 + 32, (bf16_t*)(ws + O_WBR) + (size_t)kb * D * 512, 512, nt * 64, smem);
    return;
  }
  it -= 384;
  if (it < 256) {
    const int kt = it & 15, nt = it >> 4;
    cvt_tile(((const float*)(const __attribute__((address_space(1))) float*)karg(17)) + (size_t)l * D * D, D, kt * 64, nt * 64, nt * 64 + 32, (bf16_t*)(ws + O_WOUT), D, nt * 64, smem);
    return;
  }
  it -= 256;
  if (it < 1408) {
    const int kt = it & 15, nt = it >> 4;
    const int tile = nt >> 1, wn = nt & 1;
    const int hid = tile * 64 + wn * 32;
    cvt_tile(((const float*)(const __attribute__((address_space(1))) float*)karg(18)) + (size_t)l * D * GU, GU, kt * 64, hid, FH + hid, (bf16_t*)(ws + O_WGU), D, nt * 64, smem);
    return;
  }
  it -= 1408;
  {
    const int kt = it % 44, nt = it / 44;
    cvt_tile(((const float*)(const __attribute__((address_space(1))) float*)karg(19)) + (size_t)l * FH * D, D, kt * 64, nt * 64, nt * 64 + 32, (bf16_t*)(ws + O_WD), FH, nt * 64, smem);
  }
}
DI void mod_item(const Params& p, int it, unsigned char* smem) {
  float* sc = (float*)smem;
  float* red = sc + 5 * 1024;
  const int tid = tid_();
  const int l = it / 192, cb = it % 192;
  for (int i = tid; i < 5 * 1024; i += 256) {
    const int r = i >> 10, k = i & 1023;
    const float v = (r < 4) ? ((const float*)(const __attribute__((address_space(1))) float*)karg(1))[r * 1024 + k] : ((const float*)(const __attribute__((address_space(1))) float*)karg(3))[k];
    sc[i] = siluf_(v);
  }
  __syncthreads();
  const int c = tid & 31, kg = tid >> 5;
  const int col = cb * 32 + c;
  const float* w = ((const float*)(const __attribute__((address_space(1))) float*)karg(4)) + (size_t)l * D * 6144 + col;
  float a0 = 0, a1 = 0, a2 = 0, a3 = 0, a4 = 0;
#pragma unroll 8
  for (int k = kg * 128; k < kg * 128 + 128; ++k) {
    const float wv = w[(size_t)k * 6144];
    a0 += sc[k] * wv; a1 += sc[1024 + k] * wv; a2 += sc[2048 + k] * wv; a3 += sc[3072 + k] * wv; a4 += sc[4096 + k] * wv;
  }
  red[(kg * 5 + 0) * 32 + c] = a0; red[(kg * 5 + 1) * 32 + c] = a1; red[(kg * 5 + 2) * 32 + c] = a2;
  red[(kg * 5 + 3) * 32 + c] = a3; red[(kg * 5 + 4) * 32 + c] = a4;
  __syncthreads();
  if (tid < 160) {
    const int r = tid >> 5, cc = tid & 31;
    float s = 0;
#pragma unroll
    for (int g = 0; g < 8; ++g) s += red[(g * 5 + r) * 32 + cc];
    const int colo = cb * 32 + cc;
    float* modf = (float*)(((unsigned char*)(__attribute__((address_space(1))) unsigned char*)karg(21)) + O_MOD);
    modf[((size_t)l * 5 + r) * 6144 + colo] = s + ((const float*)(const __attribute__((address_space(1))) float*)karg(5))[l * 6144 + colo];
  }
  __syncthreads();
}

DI const float* xrow_ptr(const Params& p, int l, int stage, int row) {
  const int b = row / PT, q = row % PT;
  if (q < CL) {
    const size_t o = ((size_t)b * CL + q) * D;
    return (l == 0 && stage == 0) ? ((const float*)(const __attribute__((address_space(1))) float*)karg(2)) + o : (const float*)(((unsigned char*)(__attribute__((address_space(1))) unsigned char*)karg(21)) + O_XC) + o;
  }
  const size_t o = ((size_t)b * SEQ + (q - CL)) * D;
  return (l == 0 && stage == 0) ? ((const float*)(const __attribute__((address_space(1))) float*)karg(0)) + o : ((float*)(__attribute__((address_space(1))) float*)karg(20)) + o;
}
DI void norm_row(const Params& p, int l, int stage, int row, const float* __restrict__ nw, int shoff, int scoff) {
  const int lane = tid_() & 63;
  const float* xr = xrow_ptr(p, l, stage, row);
  const int b = row / PT, q = row % PT;
  const float* modf = (const float*)(((unsigned char*)(__attribute__((address_space(1))) unsigned char*)karg(21)) + O_MOD) + ((size_t)l * 5 + (q < CL ? 4 : b)) * 6144;
  float4 v[4];
  float ss = 0.f;
#pragma unroll
  for (int i = 0; i < 4; ++i) {
    v[i] = *(const float4*)(xr + i * 256 + lane * 4);
    ss += v[i].x * v[i].x + v[i].y * v[i].y + v[i].z * v[i].z + v[i].w * v[i].w;
  }
#pragma unroll
  for (int m = 1; m < 64; m <<= 1) ss += shx(ss, m);
  const float rs = rsqrtf(ss * (1.f / 1024.f) + EPS);
  bf16_t* dst = (bf16_t*)(((unsigned char*)(__attribute__((address_space(1))) unsigned char*)karg(21)) + O_UO) + (size_t)row * 1024;
#pragma unroll
  for (int i = 0; i < 4; ++i) {
    const int k = i * 256 + lane * 4;
    const float4 wv = *(const float4*)(nw + k);
    const float4 sc = *(const float4*)(modf + scoff + k);
    const float4 sh = *(const float4*)(modf + shoff + k);
    const float y0 = v[i].x * rs * wv.x * (1.f + sc.x) + sh.x;
    const float y1 = v[i].y * rs * wv.y * (1.f + sc.y) + sh.y;
    const float y2 = v[i].z * rs * wv.z * (1.f + sc.z) + sh.z;
    const float y3 = v[i].w * rs * wv.w * (1.f + sc.w) + sh.w;
    *(uint2*)(dst + k) = make_uint2(pack2(y0, y1), pack2(y2, y3));
  }
}

DI void store4T(bf16_t* base, float a, float b, float c, float d) { *(uint2*)base = make_uint2(pack2(a, b), pack2(c, d)); }

DI void inproj_epilogue(const Params& p, int l, f32x16 (&acc)[2][2], int m0w, int n0w) {
  unsigned char* ws = ((unsigned char*)(__attribute__((address_space(1))) unsigned char*)karg(21));
  const int lane = tid_() & 63, ln = lane & 31, h = lane >> 5;
  if (n0w < 2048) {
    const int dir = n0w >> 10, ch = ((n0w & 1023) >> 6) * 32 + ln;
    float lb = 0.f;
    if (l == 1) {
      const float* lbr = ((const float*)(const __attribute__((address_space(1))) float*)karg(9));
      lb = fminf(sigmoidf_(lbr[(2 + dir) * 512 + ch] - lbr[dir * 512 + ch]), 1.f - 1e-6f);
    }
    bf16_t* qd = (bf16_t*)(ws + (dir ? O_QHB : O_QHF));
    bf16_t* kd = (bf16_t*)(ws + (dir ? O_KTB : O_KTF));
    float* ebl = (float*)(ws + O_EBL) + (size_t)dir * (NT / 32) * 512;
#pragma unroll
    for (int i = 0; i < 2; ++i) {
      const int r0 = m0w + i * 32;
      float kk[16], g2[16], gs[4], gp[4];
#pragma unroll
      for (int r = 0; r < 16; ++r) {
        kk[r] = (1.f - lb) * sigmoidf_(-acc[i][1][r]);
        g2[r] = __log2f(fmaxf(1.f - kk[r], 1e-30f));
      }
#pragma unroll
      for (int rg = 0; rg < 4; ++rg) { gs[rg] = (g2[rg * 4] + g2[rg * 4 + 1]) + (g2[rg * 4 + 2] + g2[rg * 4 + 3]); gp[rg] = shx(gs[rg], 32); }
      const float total = ((gs[0] + gp[0]) + (gs[1] + gp[1])) + ((gs[2] + gp[2]) + (gs[3] + gp[3]));
      float pre = 0.f;
#pragma unroll
      for (int rg = 0; rg < 4; ++rg) {
        float run = pre + (h ? gp[rg] : 0.f);
#pragma unroll
        for (int i4 = 0; i4 < 4; ++i4) {
          const int r = rg * 4 + i4;
          run += g2[r];
          const float bj = dir ? (total - run + g2[r]) : run;
          const size_t o = (size_t)(r0 + rg * 8 + h * 4 + i4) * 512 + ch;
          qd[o] = tobf(acc[i][0][r] * 0.08838834764831845f * __builtin_amdgcn_exp2f(bj));
          kd[o] = tobf(kk[r] * __builtin_amdgcn_exp2f(fminf(-bj, 115.f)));
        }
        pre += gs[rg] + gp[rg];
      }
      if (h == 0) ebl[(size_t)(r0 >> 5) * 512 + ch] = __builtin_amdgcn_exp2f(total);
    }
    return;
  }
  if (n0w < 2560) {
    bf16_t* vt = (bf16_t*)(ws + O_VA);
#pragma unroll
    for (int i = 0; i < 2; ++i)
#pragma unroll
      for (int rg = 0; rg < 4; ++rg) {
        const int row = m0w + i * 32 + rg * 8 + h * 4;
        const int b = row / PT, q = row % PT;
#pragma unroll
        for (int j = 0; j < 2; ++j) {
          const int ch = (n0w & 511) + j * 32 + ln;
          store4T(vt + ((size_t)b * 512 + ch) * PT + q, acc[i][j][rg * 4 + 0], acc[i][j][rg * 4 + 1], acc[i][j][rg * 4 + 2], acc[i][j][rg * 4 + 3]);
        }
      }
    return;
  }
  if (n0w < 3072) {
    bf16_t* dst = (bf16_t*)(ws + O_OG);
    const int cg0 = n0w & 511;
#pragma unroll
    for (int j = 0; j < 2; ++j)
#pragma unroll
      for (int i = 0; i < 2; ++i)
#pragma unroll
        for (int r = 0; r < 16; ++r) {
          const int row = m0w + i * 32 + (r >> 2) * 8 + h * 4 + (r & 3);
          dst[(size_t)row * 512 + cg0 + j * 32 + ln] = tobf(acc[i][j][r]);
        }
    return;
  }
  n0w -= 512;
  int kind, head;
  if (n0w < 3072) { kind = 0; head = (n0w - 2560) >> 6; }
  else if (n0w < 3200) { kind = 1; head = (n0w - 3072) >> 6; }
  else if (n0w < 3328) { kind = 2; head = (n0w - 3200) >> 6; }
  else if (n0w < 3840) { kind = 3; head = (n0w - 3328) >> 6; }
  else if (n0w < 4352) { kind = 4; head = (n0w - 3840) >> 6; }
  else { kind = 5; head = (n0w - 4352) >> 6; }
  if (kind == 2 || kind == 5) {
    bf16_t* vt = (bf16_t*)(ws + (kind == 2 ? O_BVT : O_CVT));
    const int nch = (kind == 2) ? 128 : 512;
#pragma unroll
    for (int i = 0; i < 2; ++i)
#pragma unroll
      for (int rg = 0; rg < 4; ++rg) {
        const int row = m0w + i * 32 + rg * 8 + h * 4;
        const int b = row / PT, q = row % PT;
#pragma unroll
        for (int j = 0; j < 2; ++j) {
          const int ch = head * 64 + j * 32 + ln;
          store4T(vt + ((size_t)b * nch + ch) * PT + q, acc[i][j][rg * 4 + 0], acc[i][j][rg * 4 + 1], acc[i][j][rg * 4 + 2], acc[i][j][rg * 4 + 3]);
        }
      }
    return;
  }
  const float* nwp = (kind == 0 ? ((const float*)(const __attribute__((address_space(1))) float*)karg(11)) : kind == 1 ? ((const float*)(const __attribute__((address_space(1))) float*)karg(12)) : kind == 3 ? ((const float*)(const __attribute__((address_space(1))) float*)karg(13)) : ((const float*)(const __attribute__((address_space(1))) float*)karg(14))) + l * 64;
  const float nw0 = nwp[ln], nw1 = nwp[32 + ln];
  const float qscale = (kind == 0 || kind == 3) ? 0.125f * 1.4426950408889634f : 1.f;
  const bool rope = (kind <= 1);
  const float* ropet = (const float*)(ws + O_ROPE);
  bf16_t* dst; int dstride;
  if (kind == 0) { dst = (bf16_t*)(ws + O_BQ); dstride = 512; }
  else if (kind == 1) { dst = (bf16_t*)(ws + O_BK); dstride = 128; }
  else if (kind == 3) { dst = (bf16_t*)(ws + O_CQ); dstride = 512; }
  else { dst = (bf16_t*)(ws + O_CK); dstride = 512; }
#pragma unroll
  for (int i = 0; i < 2; ++i)
#pragma unroll
    for (int r = 0; r < 16; ++r) {
      const int row = m0w + i * 32 + (r >> 2) * 8 + h * 4 + (r & 3);
      float v0 = acc[i][0][r], v1 = acc[i][1][r];
      float ss = v0 * v0 + v1 * v1;
      ss += shx(ss, 1); ss += shx(ss, 2); ss += shx(ss, 4); ss += shx(ss, 8); ss += shx(ss, 16);
      const float rs = rsqrtf(ss * (1.f / 64.f) + EPS);
      v0 = v0 * rs * nw0; v1 = v1 * rs * nw1;
      if (rope) {
        const int q = row % PT;
        const float p0 = shx(v0, 1), p1 = shx(v1, 1);
        if (q >= CL) {
          const int t = q - CL, gr = t >> 6, gc = t & 63;
          const int fj = ln >> 1;
          const float2 cs0 = *(const float2*)(ropet + (gr * 16 + fj) * 2);
          const float2 cs1 = *(const float2*)(ropet + (gc * 16 + fj) * 2);
          if (ln & 1) { v0 = p0 * cs0.y + v0 * cs0.x; v1 = p1 * cs1.y + v1 * cs1.x; }
          else { v0 = v0 * cs0.x - p0 * cs0.y; v1 = v1 * cs1.x - p1 * cs1.y; }
        }
      }
      dst[(size_t)row * dstride + head * 64 + ln] = tobf(v0 * qscale);
      dst[(size_t)row * dstride + head * 64 + 32 + ln] = tobf(v1 * qscale);
    }
}

DI void inproj_epilogue_tr(int l, f32x16 (&acc)[2][2], int m0w, int n0w) {
  unsigned char* ws = ((unsigned char*)(__attribute__((address_space(1))) unsigned char*)karg(21));
  const int lane = tid_() & 63, ln = lane & 31, h = lane >> 5;
  if (n0w < 3072) {
    bf16_t* dst = (bf16_t*)(ws + O_OG);
#pragma unroll
    for (int i = 0; i < 2; ++i) {
      bf16_t* dr = dst + (size_t)(m0w + i * 32 + ln) * 512 + (n0w & 511) + h * 4;
#pragma unroll
      for (int j = 0; j < 2; ++j)
#pragma unroll
        for (int rg = 0; rg < 4; ++rg)
          *(uint2*)(dr + j * 32 + rg * 8) = make_uint2(pack2(acc[i][j][rg * 4 + 0], acc[i][j][rg * 4 + 1]), pack2(acc[i][j][rg * 4 + 2], acc[i][j][rg * 4 + 3]));
    }
    return;
  }
  n0w -= 512;
  int kind, head;
  if (n0w < 3072) { kind = 0; head = (n0w - 2560) >> 6; }
  else if (n0w < 3200) { kind = 1; head = (n0w - 3072) >> 6; }
  else if (n0w < 3840) { kind = 3; head = (n0w - 3328) >> 6; }
  else { kind = 4; head = (n0w - 3840) >> 6; }
  const float* nwp = ((const float*)(const __attribute__((address_space(1))) float*)karg(kind == 0 ? 11 : kind == 1 ? 12 : kind == 3 ? 13 : 14)) + l * 64;
  float4 wv[2][4];
#pragma unroll
  for (int j = 0; j < 2; ++j)
#pragma unroll
    for (int rg = 0; rg < 4; ++rg) wv[j][rg] = *(const float4*)(nwp + j * 32 + rg * 8 + h * 4);
  const float qscale = (kind == 0 || kind == 3) ? 0.125f * 1.4426950408889634f : 1.f;
  const bool rope = (kind <= 1);
  const float* ropet = (const float*)(ws + O_ROPE);
  bf16_t* dst; int dstride;
  if (kind == 0) { dst = (bf16_t*)(ws + O_BQ); dstride = 512; }
  else if (kind == 1) { dst = (bf16_t*)(ws + O_BK); dstride = 128; }
  else if (kind == 3) { dst = (bf16_t*)(ws + O_CQ); dstride = 512; }
  else { dst = (bf16_t*)(ws + O_CK); dstride = 512; }
#pragma unroll
  for (int i = 0; i < 2; ++i) {
    const int row = m0w + i * 32 + ln;
    float ss = 0.f;
#pragma unroll
    for (int j = 0; j < 2; ++j)
#pragma unroll
      for (int r = 0; r < 16; ++r) ss += acc[i][j][r] * acc[i][j][r];
    ss += shx(ss, 32);
    const float rs = rsqrtf(ss * (1.f / 64.f) + EPS);
    const int q = row % PT;
    const bool lat = (q >= CL);
    const int t = q - CL, gr = t >> 6, gc = t & 63;
    bf16_t* dr = dst + (size_t)row * dstride + head * 64 + h * 4;
#pragma unroll
    for (int j = 0; j < 2; ++j)
#pragma unroll
      for (int rg = 0; rg < 4; ++rg) {
        float v0 = acc[i][j][rg * 4 + 0] * rs * wv[j][rg].x, v1 = acc[i][j][rg * 4 + 1] * rs * wv[j][rg].y;
        float v2 = acc[i][j][rg * 4 + 2] * rs * wv[j][rg].z, v3 = acc[i][j][rg * 4 + 3] * rs * wv[j][rg].w;
        if (rope && lat) {
          const int pos = (j == 0) ? gr : gc;
          const float4 cs = *(const float4*)(ropet + (pos * 16 + rg * 4 + h * 2) * 2);
          const float a0 = v0 * cs.x - v1 * cs.y, a1 = v0 * cs.y + v1 * cs.x;
          const float a2 = v2 * cs.z - v3 * cs.w, a3 = v2 * cs.w + v3 * cs.z;
          v0 = a0; v1 = a1; v2 = a2; v3 = a3;
        }
        *(uint2*)(dr + j * 32 + rg * 8) = make_uint2(pack2(v0 * qscale, v1 * qscale), pack2(v2 * qscale, v3 * qscale));
      }
  }
}

constexpr int AQS = 136, ATS = 40;
constexpr int A_QH = 0, A_KT = A_QH + 32 * AQS * 2, A_KBT = A_KT + 32 * AQS * 2, A_VT = A_KBT + 128 * ATS * 2, A_EBL = A_VT + 128 * ATS * 2;
DI bf16x8 pack8(const f32x16& x, int o) {
  return __builtin_bit_cast(bf16x8, make_uint4(pack2(x[o + 0], x[o + 1]), pack2(x[o + 2], x[o + 3]), pack2(x[o + 4], x[o + 5]), pack2(x[o + 6], x[o + 7])));
}
template <int DIR> DI int ac_tb(int c) {
  const int s = c * 32;
  return DIR == 0 ? s : (s < CL ? (CL - 32 - s) : (PT + CL - 32 - s));
}
constexpr int A_VT2 = A_EBL + 512, A_EBL2 = A_VT2 + 128 * ATS * 2;
template <int DIR> DI void a_chunk_run(unsigned char* ws, int b, int hd, unsigned char* smem) {
  const int tid = tid_(), lane = tid & 63, w = tid >> 6, ln = lane & 31, hh = lane >> 5;
  const int kc = tid >> 1, half = tid & 1;
  const int sj = tid >> 3, cg = tid & 7;
  const size_t rb = (size_t)b * PT;
  const bf16_t* qg = (const bf16_t*)(ws + (DIR ? O_QHB : O_QHF)) + (rb + sj) * 512 + hd * 128 + cg * 16;
  const bf16_t* kg = (const bf16_t*)(ws + (DIR ? O_KTB : O_KTF)) + (rb + sj) * 512 + hd * 128 + cg * 16;
  const bf16_t* vg = (const bf16_t*)(ws + O_VA) + ((size_t)b * 512 + hd * 128 + kc) * PT + half * 16;
  const float* eg = (const float*)(ws + O_EBL) + (size_t)DIR * (NT / 32) * 512 + hd * 128 + kc;
  bf16_t* og = (bf16_t*)(ws + (DIR ? O_QHB : O_QHF)) + rb * 512 + hd * 128 + w * 32 + ln;
  bf16_t* Qh = (bf16_t*)(smem + A_QH); bf16_t* Kt = (bf16_t*)(smem + A_KT);
  bf16_t* KtT = (bf16_t*)(smem + A_KBT);
  f32x16 S0, S1, S2, S3;
#pragma unroll
  for (int r = 0; r < 16; ++r) { S0[r] = 0.f; S1[r] = 0.f; S2[r] = 0.f; S3[r] = 0.f; }
  uint4 q0, q1, k0, k1, v0, v1;
  float pe;
#define A_PREFETCH(cc) { const int tb_ = ac_tb<DIR>(cc); \
    q0 = *(const uint4*)(qg + (size_t)tb_ * 512); q1 = *(const uint4*)(qg + (size_t)tb_ * 512 + 8); \
    k0 = *(const uint4*)(kg + (size_t)tb_ * 512); k1 = *(const uint4*)(kg + (size_t)tb_ * 512 + 8); \
    v0 = *(const uint4*)(vg + tb_); v1 = *(const uint4*)(vg + tb_ + 8); \
    pe = eg[(size_t)((rb + tb_) >> 5) * 512]; }
  A_PREFETCH(0)
#pragma unroll 1
  for (int c = 0; c < PT / 32; ++c) {
    bf16_t* Vt = (bf16_t*)(smem + ((c & 1) ? A_VT2 : A_VT));
    float* ebl = (float*)(smem + ((c & 1) ? A_EBL2 : A_EBL));
    *(uint4*)(Qh + sj * AQS + cg * 16) = q0; *(uint4*)(Qh + sj * AQS + cg * 16 + 8) = q1;
    *(uint4*)(Kt + sj * AQS + cg * 16) = k0; *(uint4*)(Kt + sj * AQS + cg * 16 + 8) = k1;
    *(uint4*)(Vt + kc * ATS + half * 16) = v0; *(uint4*)(Vt + kc * ATS + half * 16 + 8) = v1;
    if (half == 0) ebl[kc] = pe;
    __syncthreads();
    A_PREFETCH(min(c + 1, PT / 32 - 1))
    unsigned short kt16[16];
#pragma unroll
    for (int jj = 0; jj < 16; ++jj) kt16[jj] = Kt[(half * 16 + jj) * AQS + kc];
    bf16x8 fa[8], fq[8], qi[8], vi[2], vs[2];
#pragma unroll
    for (int ks = 0; ks < 8; ++ks) {
      fa[ks] = *(const bf16x8*)(Kt + ln * AQS + ks * 16 + hh * 8);
      fq[ks] = *(const bf16x8*)(Qh + ln * AQS + ks * 16 + hh * 8);
    }
    __builtin_amdgcn_sched_barrier(0);
    f32x16 at, o;
#pragma unroll
    for (int r = 0; r < 16; ++r) { at[r] = 0.f; o[r] = 0.f; }
#pragma unroll
    for (int ks = 0; ks < 8; ++ks) at = MFMA(fa[ks], fq[ks], at);
#pragma unroll
    for (int i = 0; i < 8; ++i) {
      const s16x4 lo = *(const s16x4*)(Qh + ln * AQS + (i >> 1) * 32 + 16 * (i & 1) + 4 * hh);
      const s16x4 hi = *(const s16x4*)(Qh + ln * AQS + (i >> 1) * 32 + 16 * (i & 1) + 4 * hh + 8);
      qi[i] = __builtin_shufflevector(lo, hi, 0, 1, 2, 3, 4, 5, 6, 7);
    }
#pragma unroll
    for (int st = 0; st < 2; ++st) {
      const s16x4 lo = *(const s16x4*)(Vt + (w * 32 + ln) * ATS + 16 * st + 4 * hh);
      const s16x4 hi = *(const s16x4*)(Vt + (w * 32 + ln) * ATS + 16 * st + 4 * hh + 8);
      vi[st] = __builtin_shufflevector(lo, hi, 0, 1, 2, 3, 4, 5, 6, 7);
      vs[st] = *(const bf16x8*)(Vt + (w * 32 + ln) * ATS + st * 16 + hh * 8);
    }
    __builtin_amdgcn_sched_barrier(0);
    o = MFMA(qi[0], pack8(S0, 0), o); o = MFMA(qi[1], pack8(S0, 8), o);
    o = MFMA(qi[2], pack8(S1, 0), o); o = MFMA(qi[3], pack8(S1, 8), o);
    o = MFMA(qi[4], pack8(S2, 0), o); o = MFMA(qi[5], pack8(S2, 8), o);
    o = MFMA(qi[6], pack8(S3, 0), o); o = MFMA(qi[7], pack8(S3, 8), o);
#pragma unroll
    for (int r = 0; r < 16; ++r) {
      const int s_ = (r >> 2) * 8 + hh * 4 + (r & 3);
      at[r] = (DIR == 0 ? (s_ <= ln) : (s_ >= ln)) ? at[r] : 0.f;
    }
    o = MFMA(pack8(at, 0), vi[0], o);
    o = MFMA(pack8(at, 8), vi[1], o);
    {
      unsigned kkp[8];
#pragma unroll
      for (int i = 0; i < 8; ++i) kkp[i] = (unsigned)kt16[2 * i] | ((unsigned)kt16[2 * i + 1] << 16);
      *(uint4*)(KtT + kc * ATS + half * 16) = make_uint4(kkp[0], kkp[1], kkp[2], kkp[3]);
      *(uint4*)(KtT + kc * ATS + half * 16 + 8) = make_uint4(kkp[4], kkp[5], kkp[6], kkp[7]);
    }
    {
      bf16_t* oc = og + (size_t)ac_tb<DIR>(c) * 512;
#pragma unroll
      for (int r = 0; r < 16; ++r) { const int t = (r >> 2) * 8 + hh * 4 + (r & 3); oc[t * 512] = tobf(o[r]); }
    }
    __syncthreads();
    bf16x8 ka[8];
    float4 ev[16];
#pragma unroll
    for (int i = 0; i < 8; ++i) ka[i] = *(const bf16x8*)(KtT + ((i >> 1) * 32 + ln) * ATS + (i & 1) * 16 + hh * 8);
#pragma unroll
    for (int i = 0; i < 16; ++i) ev[i] = *(const float4*)(ebl + (i >> 2) * 32 + (i & 3) * 8 + hh * 4);
    __builtin_amdgcn_sched_barrier(0);
    S0 = MFMA(ka[0], vs[0], S0); S1 = MFMA(ka[2], vs[0], S1); S2 = MFMA(ka[4], vs[0], S2); S3 = MFMA(ka[6], vs[0], S3);
    S0 = MFMA(ka[1], vs[1], S0); S1 = MFMA(ka[3], vs[1], S1); S2 = MFMA(ka[5], vs[1], S2); S3 = MFMA(ka[7], vs[1], S3);
#define A_SCALE(SK, kb) { \
      _Pragma("unroll") for (int rg = 0; rg < 4; ++rg) { \
        const float4 e = ev[(kb) * 4 + rg]; \
        SK[rg * 4 + 0] *= e.x; SK[rg * 4 + 1] *= e.y; SK[rg * 4 + 2] *= e.z; SK[rg * 4 + 3] *= e.w; } }
    A_SCALE(S0, 0) A_SCALE(S1, 1) A_SCALE(S2, 2) A_SCALE(S3, 3)
  }
  __syncthreads();
}
DI void a_chunk_item(unsigned char* ws, int it, unsigned char* smem) {
  const int dir = it & 1, hd = (it >> 1) & 3, b = it >> 3;
  __builtin_amdgcn_s_setprio(2);
  if (dir == 0) a_chunk_run<0>(ws, b, hd, smem); else a_chunk_run<1>(ws, b, hd, smem);
  __builtin_amdgcn_s_setprio(0);
}

struct AttnArgs {
  float m0;
  bf16_t* q;
  const bf16_t* k; int kstride;
  const bf16_t* vt;
  int kbase_row;
  int qrow;
  int ntiles, nwin, win_p0;
  int mode;
  int gr, r0w, cb, krow0;
  const float* bias;
};
DI void attn_run(const AttnArgs& a, unsigned char* smem) {
  const int tid = tid_(), lane = tid & 63, ln = lane & 31, h = lane >> 5;
  bf16_t* sk = (bf16_t*)smem;
  bf16_t* sv = sk + 2 * 64 * LSTR;
  bf16x8 qf[4];
  {
    const bf16_t* qp = a.q + (size_t)(a.qrow + ln) * 512 + h * 8;
#pragma unroll
    for (int ks = 0; ks < 4; ++ks) qf[ks] = *(const bf16x8*)(qp + ks * 16);
  }
  f32x16 o0, o1;
#pragma unroll
  for (int r = 0; r < 16; ++r) { o0[r] = 0.f; o1[r] = 0.f; }
  float lrun = 0.f;
  const int lrow = tid >> 3, lc = (tid & 7) * 8;
  uint4 rk0, rk1, rv0, rv1;
#define TILE_P0(i) ((i) < a.nwin ? a.win_p0 + (i) * 64 : ((i) - a.nwin) * 64)
#define GLOAD(i) { const int p0_ = TILE_P0(i); \
    rk0 = *(const uint4*)(a.k + (size_t)(a.kbase_row + p0_ + lrow) * a.kstride + lc); \
    rk1 = *(const uint4*)(a.k + (size_t)(a.kbase_row + p0_ + lrow + 32) * a.kstride + lc); \
    rv0 = *(const uint4*)(a.vt + (size_t)(lrow) * PT + p0_ + lc); \
    rv1 = *(const uint4*)(a.vt + (size_t)(lrow + 32) * PT + p0_ + lc); }
#define SSTORE(buf_) { \
    *(uint4*)(sk + (buf_) * 64 * LSTR + (lrow) * LSTR + lc) = rk0; \
    *(uint4*)(sk + (buf_) * 64 * LSTR + (lrow + 32) * LSTR + lc) = rk1; \
    *(uint4*)(sv + (buf_) * 64 * LSTR + (lrow) * LSTR + lc) = rv0; \
    *(uint4*)(sv + (buf_) * 64 * LSTR + (lrow + 32) * LSTR + lc) = rv1; }
  GLOAD(0);
  SSTORE(0);
  __syncthreads();
  for (int it = 0; it < a.ntiles; ++it) {
    const int buf = it & 1;
    GLOAD(min(it + 1, a.ntiles - 1));
    asm volatile("" ::: "memory");
    __builtin_amdgcn_sched_barrier(0);
    bool active = true;
    int krow = 0;
    const bool win = (a.mode == 1 && it < a.nwin);
    if (win) { krow = a.krow0 + it; active = (krow >= a.r0w && krow < a.r0w + 8); }
    if (active) {
      const bf16_t* ks_ = sk + buf * 64 * LSTR + ln * LSTR + h * 8;
      f32x16 s0, s1;
#pragma unroll
      for (int r = 0; r < 16; ++r) { s0[r] = -a.m0; s1[r] = -a.m0; }
#pragma unroll
      for (int ks = 0; ks < 4; ++ks) {
        bf16x8 a0 = *(const bf16x8*)(ks_ + ks * 16);
        bf16x8 a1 = *(const bf16x8*)(ks_ + 32 * LSTR + ks * 16);
        s0 = MFMA(a0, qf[ks], s0);
        s1 = MFMA(a1, qf[ks], s1);
      }
      if (win) {
        const int qc = a.cb + ln;
        const int c0 = min(max(qc - 8, 0), 48);
        const float* brow = a.bias + (krow - a.gr + 7) * 31 + 15 - qc;
#pragma unroll
        for (int r = 0; r < 16; ++r) {
          const int kc0 = (r >> 2) * 8 + h * 4 + (r & 3);
          const int kc1 = kc0 + 32;
          s0[r] = (kc0 >= c0 && kc0 < c0 + 16) ? s0[r] + brow[kc0] : -1e30f;
          s1[r] = (kc1 >= c0 && kc1 < c0 + 16) ? s1[r] + brow[kc1] : -1e30f;
        }
      }
#pragma unroll
      for (int r = 0; r < 16; ++r) { s0[r] = __builtin_amdgcn_exp2f(s0[r]); lrun += s0[r]; }
#pragma unroll
      for (int r = 0; r < 16; ++r) { s1[r] = __builtin_amdgcn_exp2f(s1[r]); lrun += s1[r]; }
      const bf16_t* vs_ = sv + buf * 64 * LSTR + ln * LSTR + h * 4;
#pragma unroll
      for (int j = 0; j < 4; ++j) {
        bf16x8 pb;
        {
          unsigned u0, u1, u2, u3;
          if (j < 2) {
            const int b8 = 8 * j;
            u0 = pack2(s0[b8 + 0], s0[b8 + 1]); u1 = pack2(s0[b8 + 2], s0[b8 + 3]);
            u2 = pack2(s0[b8 + 4], s0[b8 + 5]); u3 = pack2(s0[b8 + 6], s0[b8 + 7]);
          } else {
            const int b8 = 8 * (j - 2);
            u0 = pack2(s1[b8 + 0], s1[b8 + 1]); u1 = pack2(s1[b8 + 2], s1[b8 + 3]);
            u2 = pack2(s1[b8 + 4], s1[b8 + 5]); u3 = pack2(s1[b8 + 6], s1[b8 + 7]);
          }
          pb = __builtin_bit_cast(bf16x8, make_uint4(u0, u1, u2, u3));
        }
        const s16x4 lo0 = *(const s16x4*)(vs_ + j * 16);
        const s16x4 hi0 = *(const s16x4*)(vs_ + j * 16 + 8);
        const s16x4 lo1 = *(const s16x4*)(vs_ + 32 * LSTR + j * 16);
        const s16x4 hi1 = *(const s16x4*)(vs_ + 32 * LSTR + j * 16 + 8);
        const bf16x8 av0 = __builtin_shufflevector(lo0, hi0, 0, 1, 2, 3, 4, 5, 6, 7);
        const bf16x8 av1 = __builtin_shufflevector(lo1, hi1, 0, 1, 2, 3, 4, 5, 6, 7);
        o0 = MFMA(av0, pb, o0);
        o1 = MFMA(av1, pb, o1);
      }
    }
    SSTORE(buf ^ 1);
    __syncthreads();
  }
  lrun += shx(lrun, 32);
  const float inv = 1.f / lrun;
  bf16_t* op = a.q + (size_t)(a.qrow + ln) * 512;
#pragma unroll
  for (int rg = 0; rg < 4; ++rg) {
    const int d = rg * 8 + h * 4;
    *(uint2*)(op + d) = make_uint2(pack2(o0[rg * 4 + 0] * inv, o0[rg * 4 + 1] * inv), pack2(o0[rg * 4 + 2] * inv, o0[rg * 4 + 3] * inv));
    *(uint2*)(op + 32 + d) = make_uint2(pack2(o1[rg * 4 + 0] * inv, o1[rg * 4 + 1] * inv), pack2(o1[rg * 4 + 2] * inv, o1[rg * 4 + 3] * inv));
  }
}

DI float wave_max(float v) {
#pragma unroll
  for (int m = 32; m >= 1; m >>= 1) v = fmaxf(v, shx(v, m));
  return v;
}
DI float attn_m0(int qi, int ki, int l) {
  const int lane = tid_() & 63;
  const float* qn = ((const float*)(const __attribute__((address_space(1))) float*)karg(qi)) + l * 64;
  const float* kn = ((const float*)(const __attribute__((address_space(1))) float*)karg(ki)) + l * 64;
  return 8.f * 1.4426950408889634f * 1.02f * wave_max(fabsf(qn[lane])) * wave_max(fabsf(kn[lane]));
}
constexpr int N_A = 32, N_B = 1024, N_C = 1024, N_CTX = 128;
DI void mixer_item(const Params& p, int l, int it, unsigned char* smem) {
  const int w = tid_() >> 6;
  unsigned char* ws = ((unsigned char*)(__attribute__((address_space(1))) unsigned char*)karg(21));
  if (it < N_A) { a_chunk_item(ws, it, smem); return; }
  it -= N_A;
  AttnArgs a;
  a.bias = (const float*)(smem + 4 * 64 * LSTR * 2);
  a.mode = 0; a.gr = 0; a.r0w = 0; a.cb = 0; a.krow0 = 0;
  if (it < N_B) {
    const int hd = it & 7, qb = (it >> 3) & 31, b = it >> 8;
    a.q = (bf16_t*)(ws + O_BQ) + hd * 64;
    a.k = (const bf16_t*)(ws + O_BK) + (hd >> 2) * 64; a.kstride = 128;
    a.vt = (const bf16_t*)(ws + O_BVT) + ((size_t)b * 128 + (hd >> 2) * 64) * PT;
    a.kbase_row = b * PT; a.qrow = b * PT + CL + qb * 128 + w * 32;
    a.ntiles = 68; a.nwin = 68; a.win_p0 = 0;
    a.m0 = attn_m0(11, 12, l);
    attn_run(a, smem);
    return;
  }
  it -= N_B;
  if (it < N_C) {
    const int hd = it & 7, rp = (it >> 3) & 31, b = it >> 8;
    const int g0 = 2 * rp, g1 = 2 * rp + 1;
    const int r00 = min(max(g0 - 4, 0), 56), r01 = min(max(g1 - 4, 0), 56);
    float* bt = (float*)(smem + 4 * 64 * LSTR * 2);
    for (int i = tid_(); i < 465; i += 256) bt[i] = 1.4426950408889634f * ((const float*)(const __attribute__((address_space(1))) float*)karg(15))[((size_t)l * 8 + hd) * 465 + i];
    __syncthreads();
    a.q = (bf16_t*)(ws + O_CQ) + hd * 64;
    a.k = (const bf16_t*)(ws + O_CK) + hd * 64; a.kstride = 512;
    a.vt = (const bf16_t*)(ws + O_CVT) + ((size_t)b * 512 + hd * 64) * PT;
    a.kbase_row = b * PT;
    a.gr = g0 + (w >> 1); a.cb = (w & 1) * 32; a.r0w = (w >> 1) ? r01 : r00; a.krow0 = r00;
    a.qrow = b * PT + CL + a.gr * 64 + a.cb;
    a.nwin = r01 + 8 - r00; a.ntiles = a.nwin + 4; a.win_p0 = CL + r00 * 64;
    a.mode = 1;
    {
      const int lane = tid_() & 63;
      float bm = 0.f;
#pragma unroll
      for (int i = 0; i < 8; ++i) { const int ix = lane + 64 * i; if (ix < 465) bm = fmaxf(bm, fabsf(bt[ix])); }
      a.m0 = attn_m0(13, 14, l) + wave_max(bm);
    }
    attn_run(a, smem);
    return;
  }
  it -= N_C;
  {
    const int hd = it & 7, qb = (it >> 3) & 1, b = (it >> 4) & 3, kc = it >> 6;
    if (kc == 0) {
      a.q = (bf16_t*)(ws + O_BQ) + hd * 64;
      a.k = (const bf16_t*)(ws + O_BK) + (hd >> 2) * 64; a.kstride = 128;
      a.vt = (const bf16_t*)(ws + O_BVT) + ((size_t)b * 128 + (hd >> 2) * 64) * PT;
    } else {
      a.q = (bf16_t*)(ws + O_CQ) + hd * 64;
      a.k = (const bf16_t*)(ws + O_CK) + hd * 64; a.kstride = 512;
      a.vt = (const bf16_t*)(ws + O_CVT) + ((size_t)b * 512 + hd * 64) * PT;
    }
    a.kbase_row = b * PT; a.qrow = b * PT + qb * 128 + w * 32;
    a.ntiles = 4; a.nwin = 4; a.win_p0 = 0;
    a.m0 = (kc == 0) ? attn_m0(11, 12, l) : attn_m0(13, 14, l);
    attn_run(a, smem);
  }
}

DI void readout_row(const Params& p, int l, int row) {
  const int lane = tid_() & 63;
  unsigned char* ws = ((unsigned char*)(__attribute__((address_space(1))) unsigned char*)karg(21));
  bf16_t* og = (bf16_t*)(ws + O_OG) + (size_t)row * 512;
  const uint4 f4 = *(const uint4*)((const bf16_t*)(ws + O_QHF) + (size_t)row * 512 + lane * 8);
  const uint4 b4 = *(const uint4*)((const bf16_t*)(ws + O_QHB) + (size_t)row * 512 + lane * 8);
  const uint4 g4 = *(const uint4*)(og + lane * 8);
  const unsigned ff[4] = {f4.x, f4.y, f4.z, f4.w}, bb[4] = {b4.x, b4.y, b4.z, b4.w}, gg[4] = {g4.x, g4.y, g4.z, g4.w};
  float o[8];
  float ss = 0.f;
#pragma unroll
  for (int i = 0; i < 4; ++i) {
    o[2 * i] = bflo(ff[i]) + bflo(bb[i]);
    o[2 * i + 1] = bfhi(ff[i]) + bfhi(bb[i]);
    ss += o[2 * i] * o[2 * i] + o[2 * i + 1] * o[2 * i + 1];
  }
  ss += shx(ss, 1); ss += shx(ss, 2); ss += shx(ss, 4); ss += shx(ss, 8);
  const float rs = rsqrtf(ss * (1.f / 128.f) + EPS);
  const float* gn = ((const float*)(const __attribute__((address_space(1))) float*)karg(10)) + l * 128 + (lane & 15) * 8;
  unsigned outp[4];
#pragma unroll
  for (int i = 0; i < 4; ++i) {
    const float g0 = bflo(gg[i]), g1 = bfhi(gg[i]);
    outp[i] = pack2(o[2 * i] * rs * gn[2 * i] * siluf_(g0), o[2 * i + 1] * rs * gn[2 * i + 1] * siluf_(g1));
  }
  *(uint4*)(og + lane * 8) = make_uint4(outp[0], outp[1], outp[2], outp[3]);
}

DI bool xcd_tile(int seq, int bid, int nblk, int MX, int NX, int& mt, int& nt) {
  const int per = nblk >> 3, li = bid >> 3, x = bid & 7;
  const int u = li + seq * per;
  if (u >= MX * NX) return false;
  const int FM = MX >> 3, fullsz = 8 * NX;
  int mgi, r, gm;
  if (u < FM * fullsz) { mgi = u / fullsz; r = u - mgi * fullsz; gm = 8; }
  else { mgi = FM; r = u - FM * fullsz; gm = MX & 7; }
  const int ngi = r / (gm * 8), r2 = r - ngi * gm * 8;
  const int nj = r2 / gm, mi = r2 - nj * gm;
  mt = x * MX + mgi * 8 + mi;
  nt = ngi * 8 + nj;
  return true;
}
DI int mtile_row0(int l, int mt) { return l == 0 ? mt * 128 : ((mt >> 5) * PT + CL + (mt & 31) * 128); }

#ifndef SKIPM
#define SKIPM 0
#endif
#ifdef PROBE_REP
__device__ const unsigned char PSEQ[] = {0, 1, 2, PROBE_R(2) 3, 4, 5, PROBE_R(5) 6, 7, 8, PROBE_R(8) 9, 10, 11, PROBE_R(11) 12, 13, 14, PROBE_R(14) 15, 16, 17, PROBE_R(17) 18};
#else
__device__ const unsigned char PSEQ[] = {0, 1, 2, 3, 4, 5, 6, 7, 8, 9, 10, 11, 12, 13, 14, 15, 16, 17, 18};
#endif
constexpr int NSEQ = sizeof(PSEQ);
#define OPAQUE_S(x) asm volatile("" : "+s"(x))
__global__ void __launch_bounds__(256, 2) fwd_megakernel(Params p) {
  extern __shared__ __attribute__((aligned(16))) unsigned char smem[];
  __shared__ __attribute__((aligned(16))) unsigned sh_words[8];
#define s_item (((int*)sh_words)[4])
#define s_key (((int*)sh_words)[5])
  cg::grid_group grid = cg::this_grid();
  const int nblk = gridDim.x, bid = blockIdx.x;
  if (threadIdx.x == 0) { sh_words[0] = 0u; sh_words[1] = 0u; sh_words[2] = 0u; sh_words[3] = 0u; }
  __syncthreads();
  (void)xcd_barrier_post((unsigned*)(((unsigned char*)(__attribute__((address_space(1))) unsigned char*)karg(21)) + O_BAR), (volatile LAS unsigned*)sh_words);

  for (int pi = 0; pi < NSEQ; ++pi) {
    const int ph = PSEQ[pi];
    const int tid = tid_(), lane = tid & 63, w = tid >> 6, wm = w >> 1, wn = w & 1;
    unsigned char* ws = ((unsigned char*)(__attribute__((address_space(1))) unsigned char*)karg(21));
    const int l = (ph - 1) / 9, k = (ph == 0) ? -1 : (ph - 1) % 9;
    const int nmt = (l == 0) ? 136 : 128;
    if (k == -1 && !(SKIPM & 1)) {
      int* ctr = (int*)(ws + O_CTR);
      for (int i = bid * 256 + tid; i < 64 + 4 * 4096; i += nblk * 256) ctr[i] = 0;
      if (bid == 1 || nblk == 1) {
        float* ropet = (float*)(ws + O_ROPE);
        for (int i = tid; i < 1024; i += 256) {
          const int pos = i >> 4, j = i & 15;
          const float inv = exp2f(-(float)j * (13.287712379549449f / 16.f));
          const float ang = (float)pos * inv;
          ropet[i * 2] = __cosf(ang); ropet[i * 2 + 1] = __sinf(ang);
        }
      }
      for (int it = bid; it < 384 + CVT_ITEMS; it += nblk) {
        if (it < 384) mod_item(p, it, smem); else cvt_item(p, 0, it - 384, smem);
      }
    } else if (k == 0 && !(SKIPM & 2)) {
      if (l == 1) for (int it = bid; it < CVT_ITEMS; it += nblk) cvt_item(p, 1, it, smem);
      for (int row = bid * 4 + w; row < NT; row += nblk * 4) norm_row(p, l, 0, row, ((const float*)(const __attribute__((address_space(1))) float*)karg(6)) + l * 1024, 0, 1024);
    } else if (k == 1 && !(SKIPM & 4)) {
      for (int sq = 0;; ++sq) {
        int mt, nt;
        if (!xcd_tile(sq, bid, nblk, 17, 42, mt, nt)) break;
        f32x16 acc[2][2];
        zero_acc(acc);
        const bool tr = (nt >= 20 && nt <= 37 && nt != 29);
        if (tr) {
          gemm_tile<true>((const bf16_t*)(ws + O_UO) + (size_t)mt * 128 * 1024, 1024, (const bf16_t*)(ws + O_WIN) + (size_t)nt * 128 * 1024, 1024, 1024, acc, smem);
          inproj_epilogue_tr(l, acc, mt * 128 + wm * 64, nt * 128 + wn * 64);
        } else {
          gemm_tile<false>((const bf16_t*)(ws + O_UO) + (size_t)mt * 128 * 1024, 1024, (const bf16_t*)(ws + O_WIN) + (size_t)nt * 128 * 1024, 1024, 1024, acc, smem);
          inproj_epilogue(p, l, acc, mt * 128 + wm * 64, nt * 128 + wn * 64);
        }
      }
    } else if (k == 2 && !(SKIPM & 8)) {
      int* ctr = (int*)(ws + O_CTR);
      const int nattn = N_B + N_C + (l == 0 ? N_CTX : 0);
      if (tid == 0) {
        const unsigned hw = __builtin_amdgcn_s_getreg(4 | (31 << 11));
        const unsigned xcc = __builtin_amdgcn_s_getreg(20 | (31 << 11));
        const int key = (int)(((xcc & 15u) << 8) | ((hw >> 8) & 255u));
        int* cuflag = ctr + 64 + 2 * 4096 + l * 4096 + key;
        const int r = atomicAdd(ctr + 64 + l * 4096 + key, 1);
        int item = -1;
        if (r == 0) {
          const int it = atomicAdd(ctr + l * 2 + 0, 1);
          if (it < N_A) { item = it; atomicExch(cuflag, 1); } else atomicExch(cuflag, 2);
        } else {
          for (int spin = 0; spin < (1 << 20); ++spin) {
            const int v = atomicAdd(cuflag, 0);
            if (v >= 2) break;
            __builtin_amdgcn_s_sleep(32);
          }
        }
        s_item = item; s_key = key;
      }
      __syncthreads();
      const int myitem = s_item, mykey = s_key;
      __syncthreads();
      if (myitem >= 0) {
        mixer_item(p, l, myitem, smem);
        __syncthreads();
        if (tid == 0) atomicExch(ctr + 64 + 2 * 4096 + l * 4096 + mykey, 3);
      }
      for (int pass = 0; pass < 2; ++pass) {
        const int q = 1 ^ pass;
        const int total = (q == 0) ? N_A : nattn;
        for (;;) {
          if (tid == 0) s_item = atomicAdd(ctr + l * 2 + q, 1);
          __syncthreads();
          const int it = s_item;
          __syncthreads();
          if (it >= total) break;
          mixer_item(p, l, q == 0 ? it : N_A + it, smem);
        }
      }
    } else if (k == 3 && !(SKIPM & 16)) {
      for (int i = bid * 4 + w; i < nmt * 128; i += nblk * 4) {
        const int row = (l == 0) ? i : ((i >> 12) * PT + CL + (i & 4095));
        readout_row(p, l, row);
      }
    } else if (k == 4 && !(SKIPM & 32)) {
      float4* msc = (float4*)(ws + O_CK) + (size_t)bid * 4096 + tid;
      for (int sq = 0;; ++sq) {
        int mt, nt;
        if (!xcd_tile(sq, bid, nblk, nmt >> 3, 8, mt, nt)) break;
        const int m0 = mtile_row0(l, mt), n0 = nt * 128;
#pragma unroll 1
        for (int kb = 0; kb < 3; ++kb) {
          f32x16 acc[2][2];
          zero_acc(acc);
          gemm_tile<true>((const bf16_t*)(ws + O_UO) + (size_t)m0 * 1024, 1024, (const bf16_t*)(ws + O_WIN) + (size_t)(PW + kb * 1024 + n0) * 1024, 1024, 1024, acc, smem);
          uint4* gsc = (uint4*)(ws + O_QHF) + (size_t)bid * 2048 + tid;
#pragma unroll
          for (int i = 0; i < 2; ++i)
#pragma unroll
            for (int j = 0; j < 2; ++j) {
              unsigned g8[8];
#pragma unroll
              for (int r = 0; r < 8; ++r) g8[r] = pack2(sigmoidf_(acc[i][j][2 * r]), sigmoidf_(acc[i][j][2 * r + 1]));
              gsc[((i * 2 + j) * 2 + 0) * 256] = make_uint4(g8[0], g8[1], g8[2], g8[3]);
              gsc[((i * 2 + j) * 2 + 1) * 256] = make_uint4(g8[4], g8[5], g8[6], g8[7]);
            }
          zero_acc(acc);
          const size_t yo = (kb == 0) ? O_OG : (kb == 1 ? O_BQ : O_CQ);
          gemm_tile<true>((const bf16_t*)(ws + yo) + (size_t)m0 * 512, 512, (const bf16_t*)(ws + O_WBR) + ((size_t)kb * 1024 + n0) * 512, 512, 512, acc, smem);
          const int h = lane >> 5, ln = lane & 31;
          int mso = 0, rowb = m0 + wm * 64 + ln, colb = n0 + wn * 64 + h * 4;
          asm volatile("" : "+v"(mso), "+v"(rowb), "+v"(colb));
#pragma unroll
          for (int i = 0; i < 2; ++i)
#pragma unroll
            for (int j = 0; j < 2; ++j) {
              const uint4 ga = gsc[mso + ((i * 2 + j) * 2 + 0) * 256], gb = gsc[mso + ((i * 2 + j) * 2 + 1) * 256];
              const unsigned g8[8] = {ga.x, ga.y, ga.z, ga.w, gb.x, gb.y, gb.z, gb.w};
#pragma unroll
              for (int rg = 0; rg < 4; ++rg) {
                float4 v;
                v.x = bflo(g8[rg * 2]) * acc[i][j][rg * 4 + 0];
                v.y = bfhi(g8[rg * 2]) * acc[i][j][rg * 4 + 1];
                v.z = bflo(g8[rg * 2 + 1]) * acc[i][j][rg * 4 + 2];
                v.w = bfhi(g8[rg * 2 + 1]) * acc[i][j][rg * 4 + 3];
                float4* sp = msc + mso + ((i * 2 + j) * 4 + rg) * 256;
                if (kb > 0) { const float4 o = *sp; v.x += o.x; v.y += o.y; v.z += o.z; v.w += o.w; }
                if (kb < 2) *sp = v;
                else {
                  bf16_t* mo = (bf16_t*)(ws + O_M);
                  const int row = rowb + i * 32;
                  const int col = colb + j * 32 + rg * 8;
                  *(uint2*)(mo + (size_t)row * 1024 + col) = make_uint2(pack2(v.x, v.y), pack2(v.z, v.w));
                }
                __builtin_amdgcn_sched_barrier(0);
              }
            }
        }
      }
    } else if (k == 5 && !(SKIPM & 64)) {
      for (int sq = 0;; ++sq) {
        int mt, nt;
        if (!xcd_tile(sq, bid, nblk, nmt >> 3, 8, mt, nt)) break;
        const int m0 = mtile_row0(l, mt), n0 = nt * 128;
        f32x16 acc[2][2];
        zero_acc(acc);
        gemm_tile<true>((const bf16_t*)(ws + O_M) + (size_t)m0 * 1024, 1024, (const bf16_t*)(ws + O_WOUT) + (size_t)n0 * 1024, 1024, 1024, acc, smem);
        const int h = lane >> 5, ln = lane & 31;
#pragma unroll
        for (int i = 0; i < 2; ++i) {
          const int row = m0 + wm * 64 + i * 32 + ln;
          const int b = row / PT, q = row % PT;
          const float* xin = xrow_ptr(p, l, 0, row);
          float* xo = (q < CL) ? (float*)(ws + O_XC) + ((size_t)b * CL + q) * D : ((float*)(__attribute__((address_space(1))) float*)karg(20)) + ((size_t)b * SEQ + (q - CL)) * D;
          const float* modf = (const float*)(ws + O_MOD) + ((size_t)l * 5 + (q < CL ? 4 : b)) * 6144 + 2048;
#pragma unroll
          for (int j = 0; j < 2; ++j)
#pragma unroll
            for (int rg = 0; rg < 4; ++rg) {
              const int col = n0 + wn * 64 + j * 32 + rg * 8 + h * 4;
              const float4 xi = *(const float4*)(xin + col);
              const float4 g = *(const float4*)(modf + col);
              float4 o;
              o.x = xi.x + g.x * acc[i][j][rg * 4 + 0]; o.y = xi.y + g.y * acc[i][j][rg * 4 + 1];
              o.z = xi.z + g.z * acc[i][j][rg * 4 + 2]; o.w = xi.w + g.w * acc[i][j][rg * 4 + 3];
              *(float4*)(xo + col) = o;
            }
        }
      }
    } else if (k == 6 && !(SKIPM & 128)) {
      for (int i = bid * 4 + w; i < nmt * 128; i += nblk * 4) {
        const int row = (l == 0) ? i : ((i >> 12) * PT + CL + (i & 4095));
        norm_row(p, l, 1, row, ((const float*)(const __attribute__((address_space(1))) float*)karg(7)) + l * 1024, 3072, 4096);
      }
    } else if (k == 7 && !(SKIPM & 256)) {
      for (int sq = 0;; ++sq) {
        int mt, nt;
        if (!xcd_tile(sq, bid, nblk, nmt >> 3, 44, mt, nt)) break;
        const int m0 = mtile_row0(l, mt);
        f32x16 acc[2][2];
        zero_acc(acc);
        gemm_tile<true>((const bf16_t*)(ws + O_UO) + (size_t)m0 * 1024, 1024, (const bf16_t*)(ws + O_WGU) + (size_t)nt * 128 * 1024, 1024, 1024, acc, smem);
        bf16_t* ao = (bf16_t*)(ws + O_ACT);
        const int h = lane >> 5, ln = lane & 31;
#pragma unroll
        for (int i = 0; i < 2; ++i) {
          bf16_t* ar = ao + (size_t)(m0 + wm * 64 + i * 32 + ln) * FH + nt * 64 + wn * 32 + h * 4;
#pragma unroll
          for (int rg = 0; rg < 4; ++rg)
            *(uint2*)(ar + rg * 8) = make_uint2(pack2(siluf_(acc[i][0][rg * 4 + 0]) * acc[i][1][rg * 4 + 0], siluf_(acc[i][0][rg * 4 + 1]) * acc[i][1][rg * 4 + 1]),
                                                pack2(siluf_(acc[i][0][rg * 4 + 2]) * acc[i][1][rg * 4 + 2], siluf_(acc[i][0][rg * 4 + 3]) * acc[i][1][rg * 4 + 3]));
        }
      }
    } else if (!(SKIPM & 512)) {
      for (int sq = 0;; ++sq) {
        int mt, nt;
        if (!xcd_tile(sq, bid, nblk, nmt >> 3, 8, mt, nt)) break;
        const int m0 = mtile_row0(l, mt), n0 = nt * 128;
        f32x16 acc[2][2];
        zero_acc(acc);
        gemm_tile<true>((const bf16_t*)(ws + O_ACT) + (size_t)m0 * FH, FH, (const bf16_t*)(ws + O_WD) + (size_t)n0 * FH, FH, FH, acc, smem);
        const int h = lane >> 5, ln = lane & 31;
#pragma unroll
        for (int i = 0; i < 2; ++i) {
          const int row = m0 + wm * 64 + i * 32 + ln;
          const int b = row / PT, q = row % PT;
          float* xo = (q < CL) ? (float*)(ws + O_XC) + ((size_t)b * CL + q) * D : ((float*)(__attribute__((address_space(1))) float*)karg(20)) + ((size_t)b * SEQ + (q - CL)) * D;
          const float* modf = (const float*)(ws + O_MOD) + ((size_t)l * 5 + (q < CL ? 4 : b)) * 6144 + 5120;
#pragma unroll
          for (int j = 0; j < 2; ++j)
#pragma unroll
            for (int rg = 0; rg < 4; ++rg) {
              const int col = n0 + wn * 64 + j * 32 + rg * 8 + h * 4;
              const float4 xi = *(const float4*)(xo + col);
              const float4 g = *(const float4*)(modf + col);
              float4 o;
              o.x = xi.x + g.x * acc[i][j][rg * 4 + 0]; o.y = xi.y + g.y * acc[i][j][rg * 4 + 1];
              o.z = xi.z + g.z * acc[i][j][rg * 4 + 2]; o.w = xi.w + g.w * acc[i][j][rg * 4 + 3];
              *(float4*)(xo + col) = o;
            }
        }
      }
    }
    if (nblk > (1 << 30)) grid.sync();
    else if (pi < NSEQ - 1) {
      XcdBarrier xb; xb.bar = (unsigned*)(ws + O_BAR); xb.x = xb_xcc_id(); xb.st = (volatile LAS unsigned*)sh_words;
      xcd_barrier(xb);
    }
  }
}

extern "C" void kernel_launch(void* const* d_in, const int* in_sizes, int n_in, void* d_out, int out_size, void* d_ws, size_t ws_size,
                              hipStream_t stream) {
  static int grid_blocks = 0;
  if (grid_blocks == 0) {
    if (ws_size < WS_END) { fprintf(stderr, "kernel_launch: workspace too small: %zu < %zu\n", ws_size, (size_t)WS_END); grid_blocks = -1; return; }
    int dev = 0, cus = 0, per_cu = 0;
    hipGetDevice(&dev);
    hipDeviceGetAttribute(&cus, hipDeviceAttributeMultiprocessorCount, dev);
    hipFuncSetAttribute((const void*)fwd_megakernel, hipFuncAttributeMaxDynamicSharedMemorySize, LDS_BYTES);
    hipOccupancyMaxActiveBlocksPerMultiprocessor(&per_cu, (const void*)fwd_megakernel, 256, LDS_BYTES);
    if (per_cu < 1) { fprintf(stderr, "kernel_launch: occupancy query returned %d\n", per_cu); grid_blocks = -1; return; }
    if (per_cu > 2) per_cu = 2;
    grid_blocks = cus * per_cu;
  }
  if (grid_blocks < 0) return;
  Params p{};
  p.x = (const float*)d_in[0]; p.c = (const float*)d_in[1]; p.ctx = (const float*)d_in[2]; p.c_ctx = (const float*)d_in[3];
  p.w_mod = (const float*)d_in[4]; p.b_mod = (const float*)d_in[5]; p.norm_mix = (const float*)d_in[6]; p.norm_ffn = (const float*)d_in[7];
  p.w_in = (const float*)d_in[8]; p.lb_raw = (const float*)d_in[9]; p.gn_a = (const float*)d_in[10]; p.qn_b = (const float*)d_in[11];
  p.kn_b = (const float*)d_in[12]; p.qn_c = (const float*)d_in[13]; p.kn_c = (const float*)d_in[14]; p.rel_bias = (const float*)d_in[15];
  p.w_branch = (const float*)d_in[16]; p.w_out = (const float*)d_in[17]; p.w_gate_up = (const float*)d_in[18]; p.w_down = (const float*)d_in[19];
  p.out = (float*)d_out; p.ws = (unsigned char*)d_ws;
  if (hipMemsetAsync((unsigned char*)d_ws + O_BAR, 0, 16384, stream) != hipSuccess) { fprintf(stderr, "kernel_launch: hipMemsetAsync of the barrier words failed\n"); return; }
  void* args[] = {&p};
  hipError_t e = hipLaunchCooperativeKernel((const void*)fwd_megakernel, dim3(grid_blocks), dim3(256), args, LDS_BYTES, stream);
  if (e != hipSuccess) fprintf(stderr, "cooperative launch failed: %s (grid %d)\n", hipGetErrorString(e), grid_blocks);
}
```

```cpp
#include <hip/hip_runtime.h>
#include <hip/hip_cooperative_groups.h>
#include <cstdio>
namespace cg = cooperative_groups;

typedef short bf16x8 __attribute__((ext_vector_type(8)));
typedef short s16x4 __attribute__((ext_vector_type(4)));
typedef float f32x16 __attribute__((ext_vector_type(16)));
typedef float f32x2 __attribute__((ext_vector_type(2)));
typedef __bf16 bf16x2_t __attribute__((ext_vector_type(2)));
typedef unsigned short bf16_t;
#define DI __device__ __forceinline__
#define MFMA(a, b, c) __builtin_amdgcn_mfma_f32_32x32x16_bf16((a), (b), (c), 0, 0, 0)

constexpr int D = 1024, NB = 4, SEQ = 4096, CL = 256, PT = 4352, NT = NB * PT;
constexpr int INW = 7936, INW2 = 7936, PW = 4864, FH = 2816, GU = 5632;
constexpr float EPS = 1e-6f;

constexpr size_t SZ512 = (size_t)NT * 512 * 2;
constexpr size_t SZ128 = (size_t)NT * 128 * 2;
constexpr size_t O_WIN = 0;
constexpr size_t O_WBR = O_WIN + (size_t)INW2 * D * 2;
constexpr size_t O_WOUT = O_WBR + (size_t)3 * D * 512 * 2;
constexpr size_t O_WGU = O_WOUT + (size_t)D * D * 2;
constexpr size_t O_WD = O_WGU + (size_t)GU * D * 2;
constexpr size_t O_UO = O_WD + (size_t)D * FH * 2;
constexpr size_t O_P = O_UO + (size_t)NT * 1024 * 2;
constexpr size_t O_QHF = O_P;
constexpr size_t O_KTF = O_QHF + SZ512;
constexpr size_t O_QHB = O_KTF + SZ512;
constexpr size_t O_KTB = O_QHB + SZ512;
constexpr size_t O_VA = O_KTB + SZ512;
constexpr size_t O_OG = O_VA + SZ512;
constexpr size_t O_BQ = O_OG + SZ512;
constexpr size_t O_CQ = O_BQ + SZ512;
constexpr size_t O_CK = O_CQ + SZ512;
constexpr size_t O_CVT = O_CK + SZ512;
constexpr size_t O_BK = O_CVT + SZ512;
constexpr size_t O_BVT = O_BK + SZ128;
constexpr size_t O_EBL = O_BVT + SZ128;
constexpr size_t O_XC = O_EBL + (size_t)2 * (NT / 32) * 512 * 4;
constexpr size_t O_MOD = O_XC + (size_t)NB * CL * D * 4;
constexpr size_t O_ROPE = O_MOD + (size_t)2 * 5 * 6144 * 4;
constexpr size_t O_CTR = O_ROPE + 64 * 16 * 2 * 4;
constexpr size_t O_BAR = O_CTR + (64 + 4 * 4096) * 4;
constexpr size_t WS_END = O_BAR + 16384;
constexpr size_t O_M = O_QHB;
constexpr size_t O_ACT = O_P;

constexpr int LDS_BYTES = 73728;
constexpr int LSTR = 72;

struct Params {
  const float* x; const float* c; const float* ctx; const float* c_ctx; const float* w_mod; const float* b_mod;
  const float* norm_mix; const float* norm_ffn; const float* w_in; const float* lb_raw; const float* gn_a;
  const float* qn_b; const float* kn_b; const float* qn_c; const float* kn_c; const float* rel_bias;
  const float* w_branch; const float* w_out; const float* w_gate_up; const float* w_down;
  float* out; unsigned char* ws;
};


typedef const unsigned long long __attribute__((address_space(4))) karg_t;
DI unsigned long long karg(int i) { return *(volatile karg_t*)((karg_t*)__builtin_amdgcn_kernarg_segment_ptr() + i); }
DI int tid_() { int t = threadIdx.x; asm volatile("" : "+v"(t)); return t; }
DI unsigned pack2(float a, float b) {
  f32x2 v = {a, b};
  bf16x2_t r = __builtin_convertvector(v, bf16x2_t);
  return __builtin_bit_cast(unsigned, r);
}
DI bf16_t tobf(float a) { return (bf16_t)(pack2(a, 0.f) & 0xffffu); }
DI float bflo(unsigned u) { return __uint_as_float(u << 16); }
DI float bfhi(unsigned u) { return __uint_as_float(u & 0xffff0000u); }
DI float sigmoidf_(float x) { return __builtin_amdgcn_rcpf(1.f + __builtin_amdgcn_exp2f(-1.4426950408889634f * x)); }
DI float siluf_(float x) { return x * __builtin_amdgcn_rcpf(1.f + __builtin_amdgcn_exp2f(-1.4426950408889634f * x)); }
DI float shx(float v, int m) { return __shfl_xor(v, m); }

#define XB_TMO      128
#define XB_XCNT(j)  (256  + 64 * (j))
#define XB_XSUB(j)  (1280 + 64 * (j))
#define XB_XGEN(j)  (2304 + 64 * (j))
#define XB_TOP      3328
#define XB_TOPGEN   3392
#define XCD_BAR_WORDS 3456
#define XB_SPIN_CAP (1u << 18)
#define LAS __attribute__((address_space(3)))
DI unsigned xb_ld(unsigned* p)              { return __hip_atomic_load(p, __ATOMIC_RELAXED, __HIP_MEMORY_SCOPE_AGENT); }
DI unsigned xb_add(unsigned* p, unsigned v) { return __hip_atomic_fetch_add(p, v, __ATOMIC_RELAXED, __HIP_MEMORY_SCOPE_AGENT); }
DI unsigned xb_xcc_id() { return (unsigned)__builtin_amdgcn_s_getreg((3 << 11) | 20) & 0xFu; }
#define XB_SPIN(cond, bar) do { unsigned _sp = 0; while (cond) { __builtin_amdgcn_s_sleep(1); \
    if ((++_sp & 255u) == 0u) { if (xb_ld(&(bar)[XB_TMO])) break; if (_sp > XB_SPIN_CAP) { atomicAdd(&(bar)[XB_TMO], 1u); break; } } } } while (0)
struct XcdBarrier { unsigned* bar; unsigned x; volatile LAS unsigned* st; };
DI XcdBarrier xcd_barrier_post(unsigned* bar, volatile LAS unsigned* st) {
  XcdBarrier b; b.bar = bar; b.x = xb_xcc_id(); b.st = st;
  if (threadIdx.x == 0) (void)xb_add(&bar[XB_XCNT(b.x)], 1u);
  return b;
}
DI void xcd_barrier_complete(unsigned* bar, unsigned x, unsigned& nloc, unsigned& nx) {
  const unsigned G = gridDim.x * gridDim.y * gridDim.z;
  unsigned sum, cnt, mine, sp = 0u;
  for (;;) {
    sum = 0u; cnt = 0u; mine = 0u;
#pragma unroll
    for (unsigned j = 0; j < 16; ++j) { const unsigned c = xb_ld(&bar[XB_XCNT(j)]); sum += c; cnt += (c > 0u) ? 1u : 0u; mine = (j == x) ? c : mine; }
    if (sum == G) break;
    __builtin_amdgcn_s_sleep(1);
    if ((++sp & 255u) == 0u) { if (xb_ld(&bar[XB_TMO])) break; if (sp > XB_SPIN_CAP) { atomicAdd(&bar[XB_TMO], 1u); break; } }
  }
  nloc = mine > 0u ? mine : 1u; nx = cnt > 0u ? cnt : 1u;
}
DI void xcd_barrier(const XcdBarrier& b) {
  asm volatile("s_waitcnt vmcnt(0)" ::: "memory");
  __syncthreads();
  if (threadIdx.x == 0) {
    unsigned* bar = b.bar;
    __builtin_amdgcn_s_waitcnt(0);
    unsigned nloc = b.st[0], nx = b.st[1];
    if (nloc == 0u) { xcd_barrier_complete(bar, b.x, nloc, nx); b.st[0] = nloc; b.st[1] = nx; }
    const unsigned old = xb_add(&bar[XB_XSUB(b.x)], 1u);
    const unsigned gen = old / nloc;
    if (old + 1u == (gen + 1u) * nloc) {
      __builtin_amdgcn_fence(__ATOMIC_RELEASE, "agent");
      asm volatile("s_waitcnt vmcnt(0)" ::: "memory");
      const unsigned og = xb_add(&bar[XB_TOP], 1u);
      const unsigned tg = og / nx;
      if (og + 1u == (tg + 1u) * nx) xb_add(&bar[XB_TOPGEN], 1u);
      else XB_SPIN(xb_ld(&bar[XB_TOPGEN]) == tg, bar);
      __builtin_amdgcn_fence(__ATOMIC_ACQUIRE, "agent");
      xb_add(&bar[XB_XGEN(b.x)], 1u);
      asm volatile("s_waitcnt vmcnt(0)" ::: "memory");
    } else {
      XB_SPIN(xb_ld(&bar[XB_XGEN(b.x)]) == gen, bar);
      __builtin_amdgcn_fence(__ATOMIC_ACQUIRE, "agent");
      asm volatile("s_waitcnt vmcnt(0)" ::: "memory");
    }
  }
  __syncthreads();
}

template <bool TR> DI void gemm_tile(const bf16_t* A, int lda, const bf16_t* Bt, int ldb, int K,
                  f32x16 (&acc)[2][2], unsigned char* smem) {
  const int tid = tid_(), lane = tid & 63, w = tid >> 6, wm = w >> 1, wn = w & 1;
  bf16_t* sa = (bf16_t*)smem;
  bf16_t* sb = sa + 2 * 128 * LSTR;
  const int lrow = tid >> 3, lkc = (tid & 7) * 8;
  const bf16_t* ga = A + (size_t)lrow * lda + lkc;
  const bf16_t* gb = Bt + (size_t)lrow * ldb + lkc;
  uint4 pa0, pa1, pa2, pa3, pb0, pb1, pb2, pb3;
  uint4 qa0, qa1, qa2, qa3, qb0, qb1, qb2, qb3;
#define GT_LOAD(S, koff) { \
    S##a0 = *(const uint4*)(ga + (koff)); S##a1 = *(const uint4*)(ga + (size_t)32 * lda + (koff)); \
    S##a2 = *(const uint4*)(ga + (size_t)64 * lda + (koff)); S##a3 = *(const uint4*)(ga + (size_t)96 * lda + (koff)); \
    S##b0 = *(const uint4*)(gb + (koff)); S##b1 = *(const uint4*)(gb + (size_t)32 * ldb + (koff)); \
    S##b2 = *(const uint4*)(gb + (size_t)64 * ldb + (koff)); S##b3 = *(const uint4*)(gb + (size_t)96 * ldb + (koff)); \
    asm volatile("" ::: "memory"); __builtin_amdgcn_sched_barrier(0); }
#define GT_STORE(S, bufi) { \
    bf16_t* da_ = sa + (bufi) * 128 * LSTR + lrow * LSTR + lkc; bf16_t* db_ = sb + (bufi) * 128 * LSTR + lrow * LSTR + lkc; \
    *(uint4*)(da_) = S##a0; *(uint4*)(da_ + 32 * LSTR) = S##a1; *(uint4*)(da_ + 64 * LSTR) = S##a2; *(uint4*)(da_ + 96 * LSTR) = S##a3; \
    *(uint4*)(db_) = S##b0; *(uint4*)(db_ + 32 * LSTR) = S##b1; *(uint4*)(db_ + 64 * LSTR) = S##b2; *(uint4*)(db_ + 96 * LSTR) = S##b3; }
#define GT_FRAGS(F0, F1, G0, G1, KS) \
    F0 = *(const bf16x8*)(as + (KS) * 16); F1 = *(const bf16x8*)(as + 32 * LSTR + (KS) * 16); \
    G0 = *(const bf16x8*)(bs + (KS) * 16); G1 = *(const bf16x8*)(bs + 32 * LSTR + (KS) * 16);
#define MMA_(a_, b_, c_) (TR ? MFMA(b_, a_, c_) : MFMA(a_, b_, c_))
#define GEMM_STEP(A0, A1, B0, B1, PRE, ST0, ST1) \
    PRE \
    acc[0][0] = MMA_(A0, B0, acc[0][0]); acc[0][1] = MMA_(A0, B1, acc[0][1]); \
    ST0; ST1; \
    acc[1][0] = MMA_(A1, B0, acc[1][0]); acc[1][1] = MMA_(A1, B1, acc[1][1]); \
    __builtin_amdgcn_sched_barrier(0);
#define GT_COMPUTE(bufi, S, sbuf) { \
    const bf16_t* as = sa + (bufi) * 128 * LSTR + wm * 64 * LSTR + fo; \
    const bf16_t* bs = sb + (bufi) * 128 * LSTR + wn * 64 * LSTR + fo; \
    bf16_t* da_ = sa + (sbuf) * 128 * LSTR + lrow * LSTR + lkc; bf16_t* db_ = sb + (sbuf) * 128 * LSTR + lrow * LSTR + lkc; \
    bf16x8 a0, a1, b0, b1, c0, c1, d0, d1, e0, e1, f0, f1; \
    GT_FRAGS(a0, a1, b0, b1, 0) GT_FRAGS(c0, c1, d0, d1, 1) \
    GEMM_STEP(a0, a1, b0, b1, GT_FRAGS(e0, e1, f0, f1, 2), *(uint4*)(da_) = S##a0, *(uint4*)(db_) = S##b0) \
    GEMM_STEP(c0, c1, d0, d1, GT_FRAGS(a0, a1, b0, b1, 3), *(uint4*)(da_ + 32 * LSTR) = S##a1, *(uint4*)(db_ + 32 * LSTR) = S##b1) \
    GEMM_STEP(e0, e1, f0, f1, , *(uint4*)(da_ + 64 * LSTR) = S##a2, *(uint4*)(db_ + 64 * LSTR) = S##b2) \
    GEMM_STEP(a0, a1, b0, b1, , *(uint4*)(da_ + 96 * LSTR) = S##a3, *(uint4*)(db_ + 96 * LSTR) = S##b3) }
  const int nk = K >> 6;
  const int fo = (lane & 31) * LSTR + (lane >> 5) * 8;
  GT_LOAD(p, 0)
  GT_LOAD(q, 64)
  GT_STORE(p, 0)
  __syncthreads();
  for (int kt = 0; kt < nk; kt += 2) {
    GT_LOAD(p, min(kt + 2, nk - 1) * 64)
    GT_COMPUTE(0, q, 1)
    __syncthreads();
    GT_LOAD(q, min(kt + 3, nk - 1) * 64)
    GT_COMPUTE(1, p, 0)
    __syncthreads();
  }
}
DI void zero_acc(f32x16 (&acc)[2][2]) {
#pragma unroll
  for (int i = 0; i < 2; ++i)
#pragma unroll
    for (int j = 0; j < 2; ++j)
#pragma unroll
      for (int r = 0; r < 16; ++r) acc[i][j][r] = 0.f;
}

DI void cvt_tile(const float* __restrict__ src, int ldsrc, int k0, int scol0a, int scol0b, bf16_t* __restrict__ dst, int K, int n0,
                 unsigned char* smem) {
  float* t = (float*)smem;
  const int tid = tid_();
  {
    const int kk = tid >> 4, c4 = (tid & 15) * 4;
    const int sc = (c4 < 32) ? (scol0a + c4) : (scol0b + c4 - 32);
#pragma unroll
    for (int i = 0; i < 4; ++i) {
      const int k = kk + i * 16;
      float4 v = *(const float4*)(src + (size_t)(k0 + k) * ldsrc + sc);
      t[k * 65 + c4 + 0] = v.x; t[k * 65 + c4 + 1] = v.y; t[k * 65 + c4 + 2] = v.z; t[k * 65 + c4 + 3] = v.w;
    }
  }
  __syncthreads();
  {
    const int n = tid >> 2, kq = (tid & 3) * 16;
    unsigned o[8];
#pragma unroll
    for (int j = 0; j < 8; ++j) o[j] = pack2(t[(kq + 2 * j) * 65 + n], t[(kq + 2 * j + 1) * 65 + n]);
    bf16_t* d = dst + (size_t)(n0 + n) * K + k0 + kq;
    *(uint4*)d = make_uint4(o[0], o[1], o[2], o[3]);
    *(uint4*)(d + 8) = make_uint4(o[4], o[5], o[6], o[7]);
  }
  __syncthreads();
}
constexpr int CVT_ITEMS = 1984 + 384 + 256 + 1408 + 704;
DI void cvt_item(const Params& p, int l, int it, unsigned char* smem) {
  unsigned char* ws = ((unsigned char*)(__attribute__((address_space(1))) unsigned char*)karg(21));
  if (it < 1984) {
    const int kt = it & 15, nt = it >> 4;
    int ca, cb;
    if (nt < 32) { const int T = nt >> 1; if (nt & 1) { ca = 1024 + 32 * T; cb = 1536 + 32 * T; } else { ca = 32 * T; cb = 512 + 32 * T; } }
    else { ca = 64 * nt; cb = ca + 32; }
    cvt_tile(((const float*)(const __attribute__((address_space(1))) float*)karg(8)) + (size_t)l * D * INW, INW, kt * 64, ca, cb, (bf16_t*)(ws + O_WIN), D, nt * 64, smem);
    return;
  }
  it -= 1984;
  if (it < 384) {
    const int kb = it / 128, r = it % 128, kt = r & 7, nt = r >> 3;
    cvt_tile(((const float*)(const __attribute__((address_space(1))) float*)karg(16)) + ((size_t)l * 3 + kb) * 512 * D, D, kt * 64, nt * 64, nt * 64 + 32, (bf16_t*)(ws + O_WBR) + (size_t)kb * D * 512, 512, nt * 64, smem);
    return;
  }
  it -= 384;
  if (it < 256) {
    const int kt = it & 15, nt = it >> 4;
    cvt_tile(((const float*)(const __attribute__((address_space(1))) float*)karg(17)) + (size_t)l * D * D, D, kt * 64, nt * 64, nt * 64 + 32, (bf16_t*)(ws + O_WOUT), D, nt * 64, smem);
    return;
  }
  it -= 256;
  if (it < 1408) {
    const int kt = it & 15, nt = it >> 4;
    const int tile = nt >> 1, wn = nt & 1;
    const int hid = tile * 64 + wn * 32;
    cvt_tile(((const float*)(const __attribute__((address_space(1))) float*)karg(18)) + (size_t)l * D * GU, GU, kt * 64, hid, FH + hid, (bf16_t*)(ws + O_WGU), D, nt * 64, smem);
    return;
  }
  it -= 1408;
  {
    const int kt = it % 44, nt = it / 44;
    cvt_tile(((const float*)(const __attribute__((address_space(1))) float*)karg(19)) + (size_t)l * FH * D, D, kt * 64, nt * 64, nt * 64 + 32, (bf16_t*)(ws + O_WD), FH, nt * 64, smem);
  }
}
DI void mod_item(const Params& p, int it, unsigned char* smem) {
  float* sc = (float*)smem;
  float* red = sc + 5 * 1024;
  const int tid = tid_();
  const int l = it / 192, cb = it % 192;
  for (int i = tid; i < 5 * 1024; i += 256) {
    const int r = i >> 10, k = i & 1023;
    const float v = (r < 4) ? ((const float*)(const __attribute__((address_space(1))) float*)karg(1))[r * 1024 + k] : ((const float*)(const __attribute__((address_space(1))) float*)karg(3))[k];
    sc[i] = siluf_(v);
  }
  __syncthreads();
  const int c = tid & 31, kg = tid >> 5;
  const int col = cb * 32 + c;
  const float* w = ((const float*)(const __attribute__((address_space(1))) float*)karg(4)) + (size_t)l * D * 6144 + col;
  float a0 = 0, a1 = 0, a2 = 0, a3 = 0, a4 = 0;
#pragma unroll 8
  for (int k = kg * 128; k < kg * 128 + 128; ++k) {
    const float wv = w[(size_t)k * 6144];
    a0 += sc[k] * wv; a1 += sc[1024 + k] * wv; a2 += sc[2048 + k] * wv; a3 += sc[3072 + k] * wv; a4 += sc[4096 + k] * wv;
  }
  red[(kg * 5 + 0) * 32 + c] = a0; red[(kg * 5 + 1) * 32 + c] = a1; red[(kg * 5 + 2) * 32 + c] = a2;
  red[(kg * 5 + 3) * 32 + c] = a3; red[(kg * 5 + 4) * 32 + c] = a4;
  __syncthreads();
  if (tid < 160) {
    const int r = tid >> 5, cc = tid & 31;
    float s = 0;
#pragma unroll
    for (int g = 0; g < 8; ++g) s += red[(g * 5 + r) * 32 + cc];
    const int colo = cb * 32 + cc;
    float* modf = (float*)(((unsigned char*)(__attribute__((address_space(1))) unsigned char*)karg(21)) + O_MOD);
    modf[((size_t)l * 5 + r) * 6144 + colo] = s + ((const float*)(const __attribute__((address_space(1))) float*)karg(5))[l * 6144 + colo];
  }
  __syncthreads();
}

DI const float* xrow_ptr(const Params& p, int l, int stage, int row) {
  const int b = row / PT, q = row % PT;
  if (q < CL) {
    const size_t o = ((size_t)b * CL + q) * D;
    return (l == 0 && stage == 0) ? ((const float*)(const __attribute__((address_space(1))) float*)karg(2)) + o : (const float*)(((unsigned char*)(__attribute__((address_space(1))) unsigned char*)karg(21)) + O_XC) + o;
  }
  const size_t o = ((size_t)b * SEQ + (q - CL)) * D;
  return (l == 0 && stage == 0) ? ((const float*)(const __attribute__((address_space(1))) float*)karg(0)) + o : ((float*)(__attribute__((address_space(1))) float*)karg(20)) + o;
}
DI void norm_row(const Params& p, int l, int stage, int row, const float* __restrict__ nw, int shoff, int scoff) {
  const int lane = tid_() & 63;
  const float* xr = xrow_ptr(p, l, stage, row);
  const int b = row / PT, q = row % PT;
  const float* modf = (const float*)(((unsigned char*)(__attribute__((address_space(1))) unsigned char*)karg(21)) + O_MOD) + ((size_t)l * 5 + (q < CL ? 4 : b)) * 6144;
  float4 v[4];
  float ss = 0.f;
#pragma unroll
  for (int i = 0; i < 4; ++i) {
    v[i] = *(const float4*)(xr + i * 256 + lane * 4);
    ss += v[i].x * v[i].x + v[i].y * v[i].y + v[i].z * v[i].z + v[i].w * v[i].w;
  }
#pragma unroll
  for (int m = 1; m < 64; m <<= 1) ss += shx(ss, m);
  const float rs = rsqrtf(ss * (1.f / 1024.f) + EPS);
  bf16_t* dst = (bf16_t*)(((unsigned char*)(__attribute__((address_space(1))) unsigned char*)karg(21)) + O_UO) + (size_t)row * 1024;
#pragma unroll
  for (int i = 0; i < 4; ++i) {
    const int k = i * 256 + lane * 4;
    const float4 wv = *(const float4*)(nw + k);
    const float4 sc = *(const float4*)(modf + scoff + k);
    const float4 sh = *(const float4*)(modf + shoff + k);
    const float y0 = v[i].x * rs * wv.x * (1.f + sc.x) + sh.x;
    const float y1 = v[i].y * rs * wv.y * (1.f + sc.y) + sh.y;
    const float y2 = v[i].z * rs * wv.z * (1.f + sc.z) + sh.z;
    const float y3 = v[i].w * rs * wv.w * (1.f + sc.w) + sh.w;
    *(uint2*)(dst + k) = make_uint2(pack2(y0, y1), pack2(y2, y3));
  }
}

DI void store4T(bf16_t* base, float a, float b, float c, float d) { *(uint2*)base = make_uint2(pack2(a, b), pack2(c, d)); }

DI void inproj_epilogue(const Params& p, int l, f32x16 (&acc)[2][2], int m0w, int n0w, unsigned char* smem) {
  unsigned char* ws = ((unsigned char*)(__attribute__((address_space(1))) unsigned char*)karg(21));
  const int lane = tid_() & 63, ln = lane & 31, h = lane >> 5;
  if (n0w < 2048) {
    const int wn = (n0w >> 6) & 1, wm = (m0w >> 6) & 1, dir = wn, ch = (n0w >> 7) * 32 + ln;
    float* qx = (float*)(smem + 18432) + (size_t)wm * 32 * 64 + lane;
    if (wn == 0) {
#pragma unroll
      for (int i = 0; i < 2; ++i)
#pragma unroll
        for (int r = 0; r < 16; ++r) qx[(i * 16 + r) * 64] = acc[i][0][r] * 0.08838834764831845f;
    }
    __syncthreads();
    float lb = 0.f;
    if (l == 1) {
      const float* lbr = ((const float*)(const __attribute__((address_space(1))) float*)karg(9));
      lb = fminf(sigmoidf_(lbr[(2 + dir) * 512 + ch] - lbr[dir * 512 + ch]), 1.f - 1e-6f);
    }
    bf16_t* qd = (bf16_t*)(ws + (dir ? O_QHB : O_QHF));
    bf16_t* kd = (bf16_t*)(ws + (dir ? O_KTB : O_KTF));
    float* ebl = (float*)(ws + O_EBL) + (size_t)dir * (NT / 32) * 512;
#pragma unroll
    for (int i = 0; i < 2; ++i) {
      const int r0 = m0w + i * 32;
      float kk[16], g2[16], gs[4], gp[4];
#pragma unroll
      for (int r = 0; r < 16; ++r) {
        kk[r] = (1.f - lb) * sigmoidf_(-(wn ? acc[i][0][r] : acc[i][1][r]));
        g2[r] = __log2f(fmaxf(1.f - kk[r], 1e-30f));
      }
#pragma unroll
      for (int rg = 0; rg < 4; ++rg) { gs[rg] = (g2[rg * 4] + g2[rg * 4 + 1]) + (g2[rg * 4 + 2] + g2[rg * 4 + 3]); gp[rg] = shx(gs[rg], 32); }
      const float total = ((gs[0] + gp[0]) + (gs[1] + gp[1])) + ((gs[2] + gp[2]) + (gs[3] + gp[3]));
      float pre = 0.f;
#pragma unroll
      for (int rg = 0; rg < 4; ++rg) {
        float run = pre + (h ? gp[rg] : 0.f);
#pragma unroll
        for (int i4 = 0; i4 < 4; ++i4) {
          const int r = rg * 4 + i4;
          run += g2[r];
          const float bj = dir ? (total - run + g2[r]) : run;
          const size_t o = (size_t)(r0 + rg * 8 + h * 4 + i4) * 512 + ch;
          qd[o] = tobf(qx[(i * 16 + r) * 64] * __builtin_amdgcn_exp2f(bj));
          kd[o] = tobf(kk[r] * __builtin_amdgcn_exp2f(fminf(-bj, 115.f)));
        }
        pre += gs[rg] + gp[rg];
      }
      if (h == 0) ebl[(size_t)(r0 >> 5) * 512 + ch] = __builtin_amdgcn_exp2f(total);
    }
    if (wn == 1) {
      bf16_t* vt = (bf16_t*)(ws + O_VA);
#pragma unroll
      for (int i = 0; i < 2; ++i)
#pragma unroll
        for (int rg = 0; rg < 4; ++rg) {
          const int row = m0w + i * 32 + rg * 8 + h * 4;
          const int b = row / PT, q = row % PT;
          store4T(vt + ((size_t)b * 512 + ch) * PT + q, acc[i][1][rg * 4 + 0], acc[i][1][rg * 4 + 1], acc[i][1][rg * 4 + 2], acc[i][1][rg * 4 + 3]);
        }
    }
    return;
  }
  int kind, head;
  if (n0w < 3072) { kind = 0; head = (n0w - 2560) >> 6; }
  else if (n0w < 3200) { kind = 1; head = (n0w - 3072) >> 6; }
  else if (n0w < 3328) { kind = 2; head = (n0w - 3200) >> 6; }
  else if (n0w < 3840) { kind = 3; head = (n0w - 3328) >> 6; }
  else if (n0w < 4352) { kind = 4; head = (n0w - 3840) >> 6; }
  else { kind = 5; head = (n0w - 4352) >> 6; }
  if (kind == 2 || kind == 5) {
    bf16_t* vt = (bf16_t*)(ws + (kind == 2 ? O_BVT : O_CVT));
    const int nch = (kind == 2) ? 128 : 512;
#pragma unroll
    for (int i = 0; i < 2; ++i)
#pragma unroll
      for (int rg = 0; rg < 4; ++rg) {
        const int row = m0w + i * 32 + rg * 8 + h * 4;
        const int b = row / PT, q = row % PT;
#pragma unroll
        for (int j = 0; j < 2; ++j) {
          const int ch = head * 64 + j * 32 + ln;
          store4T(vt + ((size_t)b * nch + ch) * PT + q, acc[i][j][rg * 4 + 0], acc[i][j][rg * 4 + 1], acc[i][j][rg * 4 + 2], acc[i][j][rg * 4 + 3]);
        }
      }
    return;
  }
  const float* nwp = (kind == 0 ? ((const float*)(const __attribute__((address_space(1))) float*)karg(11)) : kind == 1 ? ((const float*)(const __attribute__((address_space(1))) float*)karg(12)) : kind == 3 ? ((const float*)(const __attribute__((address_space(1))) float*)karg(13)) : ((const float*)(const __attribute__((address_space(1))) float*)karg(14))) + l * 64;
  const float nw0 = nwp[ln], nw1 = nwp[32 + ln];
  const float qscale = (kind == 0 || kind == 3) ? 0.125f * 1.4426950408889634f : 1.f;
  const bool rope = (kind <= 1);
  const float* ropet = (const float*)(ws + O_ROPE);
  bf16_t* dst; int dstride;
  if (kind == 0) { dst = (bf16_t*)(ws + O_BQ); dstride = 512; }
  else if (kind == 1) { dst = (bf16_t*)(ws + O_BK); dstride = 128; }
  else if (kind == 3) { dst = (bf16_t*)(ws + O_CQ); dstride = 512; }
  else { dst = (bf16_t*)(ws + O_CK); dstride = 512; }
#pragma unroll
  for (int i = 0; i < 2; ++i)
#pragma unroll
    for (int r = 0; r < 16; ++r) {
      const int row = m0w + i * 32 + (r >> 2) * 8 + h * 4 + (r & 3);
      float v0 = acc[i][0][r], v1 = acc[i][1][r];
      float ss = v0 * v0 + v1 * v1;
      ss += shx(ss, 1); ss += shx(ss, 2); ss += shx(ss, 4); ss += shx(ss, 8); ss += shx(ss, 16);
      const float rs = rsqrtf(ss * (1.f / 64.f) + EPS);
      v0 = v0 * rs * nw0; v1 = v1 * rs * nw1;
      if (rope) {
        const int q = row % PT;
        const float p0 = shx(v0, 1), p1 = shx(v1, 1);
        if (q >= CL) {
          const int t = q - CL, gr = t >> 6, gc = t & 63;
          const int fj = ln >> 1;
          const float2 cs0 = *(const float2*)(ropet + (gr * 16 + fj) * 2);
          const float2 cs1 = *(const float2*)(ropet + (gc * 16 + fj) * 2);
          if (ln & 1) { v0 = p0 * cs0.y + v0 * cs0.x; v1 = p1 * cs1.y + v1 * cs1.x; }
          else { v0 = v0 * cs0.x - p0 * cs0.y; v1 = v1 * cs1.x - p1 * cs1.y; }
        }
      }
      dst[(size_t)row * dstride + head * 64 + ln] = tobf(v0 * qscale);
      dst[(size_t)row * dstride + head * 64 + 32 + ln] = tobf(v1 * qscale);
    }
}

DI void inproj_epilogue_tr(int l, f32x16 (&acc)[2][2], int m0w, int n0w) {
  unsigned char* ws = ((unsigned char*)(__attribute__((address_space(1))) unsigned char*)karg(21));
  const int lane = tid_() & 63, ln = lane & 31, h = lane >> 5;
  if (n0w < 2560) {
    bf16_t* dst = (bf16_t*)(ws + O_OG);
#pragma unroll
    for (int i = 0; i < 2; ++i) {
      bf16_t* dr = dst + (size_t)(m0w + i * 32 + ln) * 512 + (n0w & 511) + h * 4;
#pragma unroll
      for (int j = 0; j < 2; ++j)
#pragma unroll
        for (int rg = 0; rg < 4; ++rg)
          *(uint2*)(dr + j * 32 + rg * 8) = make_uint2(pack2(acc[i][j][rg * 4 + 0], acc[i][j][rg * 4 + 1]), pack2(acc[i][j][rg * 4 + 2], acc[i][j][rg * 4 + 3]));
    }
    return;
  }
  int kind, head;
  if (n0w < 3072) { kind = 0; head = (n0w - 2560) >> 6; }
  else if (n0w < 3200) { kind = 1; head = (n0w - 3072) >> 6; }
  else if (n0w < 3840) { kind = 3; head = (n0w - 3328) >> 6; }
  else { kind = 4; head = (n0w - 3840) >> 6; }
  const float* nwp = ((const float*)(const __attribute__((address_space(1))) float*)karg(kind == 0 ? 11 : kind == 1 ? 12 : kind == 3 ? 13 : 14)) + l * 64;
  float4 wv[2][4];
#pragma unroll
  for (int j = 0; j < 2; ++j)
#pragma unroll
    for (int rg = 0; rg < 4; ++rg) wv[j][rg] = *(const float4*)(nwp + j * 32 + rg * 8 + h * 4);
  const float qscale = (kind == 0 || kind == 3) ? 0.125f * 1.4426950408889634f : 1.f;
  const bool rope = (kind <= 1);
  const float* ropet = (const float*)(ws + O_ROPE);
  bf16_t* dst; int dstride;
  if (kind == 0) { dst = (bf16_t*)(ws + O_BQ); dstride = 512; }
  else if (kind == 1) { dst = (bf16_t*)(ws + O_BK); dstride = 128; }
  else if (kind == 3) { dst = (bf16_t*)(ws + O_CQ); dstride = 512; }
  else { dst = (bf16_t*)(ws + O_CK); dstride = 512; }
#pragma unroll
  for (int i = 0; i < 2; ++i) {
    const int row = m0w + i * 32 + ln;
    float ss = 0.f;
#pragma unroll
    for (int j = 0; j < 2; ++j)
#pragma unroll
      for (int r = 0; r < 16; ++r) ss += acc[i][j][r] * acc[i][j][r];
    ss += shx(ss, 32);
    const float rs = rsqrtf(ss * (1.f / 64.f) + EPS);
    const int q = row % PT;
    const bool lat = (q >= CL);
    const int t = q - CL, gr = t >> 6, gc = t & 63;
    bf16_t* dr = dst + (size_t)row * dstride + head * 64 + h * 4;
#pragma unroll
    for (int j = 0; j < 2; ++j)
#pragma unroll
      for (int rg = 0; rg < 4; ++rg) {
        float v0 = acc[i][j][rg * 4 + 0] * rs * wv[j][rg].x, v1 = acc[i][j][rg * 4 + 1] * rs * wv[j][rg].y;
        float v2 = acc[i][j][rg * 4 + 2] * rs * wv[j][rg].z, v3 = acc[i][j][rg * 4 + 3] * rs * wv[j][rg].w;
        if (rope && lat) {
          const int pos = (j == 0) ? gr : gc;
          const float4 cs = *(const float4*)(ropet + (pos * 16 + rg * 4 + h * 2) * 2);
          const float a0 = v0 * cs.x - v1 * cs.y, a1 = v0 * cs.y + v1 * cs.x;
          const float a2 = v2 * cs.z - v3 * cs.w, a3 = v2 * cs.w + v3 * cs.z;
          v0 = a0; v1 = a1; v2 = a2; v3 = a3;
        }
        *(uint2*)(dr + j * 32 + rg * 8) = make_uint2(pack2(v0 * qscale, v1 * qscale), pack2(v2 * qscale, v3 * qscale));
      }
  }
}

constexpr int AQS = 136, ATS = 40;
constexpr int A_QH = 0, A_KT = A_QH + 32 * AQS * 2, A_KBT = A_KT + 32 * AQS * 2, A_VT = A_KBT + 128 * ATS * 2, A_EBL = A_VT + 128 * ATS * 2;
DI bf16x8 pack8(const f32x16& x, int o) {
  return __builtin_bit_cast(bf16x8, make_uint4(pack2(x[o + 0], x[o + 1]), pack2(x[o + 2], x[o + 3]), pack2(x[o + 4], x[o + 5]), pack2(x[o + 6], x[o + 7])));
}
template <int DIR> DI int ac_tb(int c) {
  const int s = c * 32;
  return DIR == 0 ? s : (s < CL ? (CL - 32 - s) : (PT + CL - 32 - s));
}
constexpr int A_VT2 = A_EBL + 512, A_EBL2 = A_VT2 + 128 * ATS * 2;
template <int DIR> DI void a_chunk_run(unsigned char* ws, int b, int hd, unsigned char* smem) {
  const int tid = tid_(), lane = tid & 63, w = tid >> 6, ln = lane & 31, hh = lane >> 5;
  const int kc = tid >> 1, half = tid & 1;
  const int sj = tid >> 3, cg = tid & 7;
  const size_t rb = (size_t)b * PT;
  const bf16_t* qg = (const bf16_t*)(ws + (DIR ? O_QHB : O_QHF)) + (rb + sj) * 512 + hd * 128 + cg * 16;
  const bf16_t* kg = (const bf16_t*)(ws + (DIR ? O_KTB : O_KTF)) + (rb + sj) * 512 + hd * 128 + cg * 16;
  const bf16_t* vg = (const bf16_t*)(ws + O_VA) + ((size_t)b * 512 + hd * 128 + kc) * PT + half * 16;
  const float* eg = (const float*)(ws + O_EBL) + (size_t)DIR * (NT / 32) * 512 + hd * 128 + kc;
  bf16_t* og = (bf16_t*)(ws + (DIR ? O_QHB : O_QHF)) + rb * 512 + hd * 128 + w * 32 + ln;
  bf16_t* Qh = (bf16_t*)(smem + A_QH); bf16_t* Kt = (bf16_t*)(smem + A_KT);
  bf16_t* KtT = (bf16_t*)(smem + A_KBT);
  f32x16 S0, S1, S2, S3;
#pragma unroll
  for (int r = 0; r < 16; ++r) { S0[r] = 0.f; S1[r] = 0.f; S2[r] = 0.f; S3[r] = 0.f; }
  uint4 q0, q1, k0, k1, v0, v1;
  float pe;
#define A_PREFETCH(cc) { const int tb_ = ac_tb<DIR>(cc); \
    q0 = *(const uint4*)(qg + (size_t)tb_ * 512); q1 = *(const uint4*)(qg + (size_t)tb_ * 512 + 8); \
    k0 = *(const uint4*)(kg + (size_t)tb_ * 512); k1 = *(const uint4*)(kg + (size_t)tb_ * 512 + 8); \
    v0 = *(const uint4*)(vg + tb_); v1 = *(const uint4*)(vg + tb_ + 8); \
    pe = eg[(size_t)((rb + tb_) >> 5) * 512]; }
  A_PREFETCH(0)
#pragma unroll 1
  for (int c = 0; c < PT / 32; ++c) {
    bf16_t* Vt = (bf16_t*)(smem + ((c & 1) ? A_VT2 : A_VT));
    float* ebl = (float*)(smem + ((c & 1) ? A_EBL2 : A_EBL));
    *(uint4*)(Qh + sj * AQS + cg * 16) = q0; *(uint4*)(Qh + sj * AQS + cg * 16 + 8) = q1;
    *(uint4*)(Kt + sj * AQS + cg * 16) = k0; *(uint4*)(Kt + sj * AQS + cg * 16 + 8) = k1;
    *(uint4*)(Vt + kc * ATS + half * 16) = v0; *(uint4*)(Vt + kc * ATS + half * 16 + 8) = v1;
    if (half == 0) ebl[kc] = pe;
    __syncthreads();
    A_PREFETCH(min(c + 1, PT / 32 - 1))
    unsigned short kt16[16];
#pragma unroll
    for (int jj = 0; jj < 16; ++jj) kt16[jj] = Kt[(half * 16 + jj) * AQS + kc];
    bf16x8 fa[8], fq[8], qi[8], vi[2], vs[2];
#pragma unroll
    for (int ks = 0; ks < 8; ++ks) {
      fa[ks] = *(const bf16x8*)(Kt + ln * AQS + ks * 16 + hh * 8);
      fq[ks] = *(const bf16x8*)(Qh + ln * AQS + ks * 16 + hh * 8);
    }
    __builtin_amdgcn_sched_barrier(0);
    f32x16 at, o;
#pragma unroll
    for (int r = 0; r < 16; ++r) { at[r] = 0.f; o[r] = 0.f; }
#pragma unroll
    for (int ks = 0; ks < 8; ++ks) at = MFMA(fa[ks], fq[ks], at);
#pragma unroll
    for (int i = 0; i < 8; ++i) {
      const s16x4 lo = *(const s16x4*)(Qh + ln * AQS + (i >> 1) * 32 + 16 * (i & 1) + 4 * hh);
      const s16x4 hi = *(const s16x4*)(Qh + ln * AQS + (i >> 1) * 32 + 16 * (i & 1) + 4 * hh + 8);
      qi[i] = __builtin_shufflevector(lo, hi, 0, 1, 2, 3, 4, 5, 6, 7);
    }
#pragma unroll
    for (int st = 0; st < 2; ++st) {
      const s16x4 lo = *(const s16x4*)(Vt + (w * 32 + ln) * ATS + 16 * st + 4 * hh);
      const s16x4 hi = *(const s16x4*)(Vt + (w * 32 + ln) * ATS + 16 * st + 4 * hh + 8);
      vi[st] = __builtin_shufflevector(lo, hi, 0, 1, 2, 3, 4, 5, 6, 7);
      vs[st] = *(const bf16x8*)(Vt + (w * 32 + ln) * ATS + st * 16 + hh * 8);
    }
    __builtin_amdgcn_sched_barrier(0);
    o = MFMA(qi[0], pack8(S0, 0), o); o = MFMA(qi[1], pack8(S0, 8), o);
    o = MFMA(qi[2], pack8(S1, 0), o); o = MFMA(qi[3], pack8(S1, 8), o);
    o = MFMA(qi[4], pack8(S2, 0), o); o = MFMA(qi[5], pack8(S2, 8), o);
    o = MFMA(qi[6], pack8(S3, 0), o); o = MFMA(qi[7], pack8(S3, 8), o);
#pragma unroll
    for (int r = 0; r < 16; ++r) {
      const int s_ = (r >> 2) * 8 + hh * 4 + (r & 3);
      at[r] = (DIR == 0 ? (s_ <= ln) : (s_ >= ln)) ? at[r] : 0.f;
    }
    o = MFMA(pack8(at, 0), vi[0], o);
    o = MFMA(pack8(at, 8), vi[1], o);
    {
      unsigned kkp[8];
#pragma unroll
      for (int i = 0; i < 8; ++i) kkp[i] = (unsigned)kt16[2 * i] | ((unsigned)kt16[2 * i + 1] << 16);
      *(uint4*)(KtT + kc * ATS + half * 16) = make_uint4(kkp[0], kkp[1], kkp[2], kkp[3]);
      *(uint4*)(KtT + kc * ATS + half * 16 + 8) = make_uint4(kkp[4], kkp[5], kkp[6], kkp[7]);
    }
    {
      bf16_t* oc = og + (size_t)ac_tb<DIR>(c) * 512;
#pragma unroll
      for (int r = 0; r < 16; ++r) { const int t = (r >> 2) * 8 + hh * 4 + (r & 3); oc[t * 512] = tobf(o[r]); }
    }
    __syncthreads();
    bf16x8 ka[8];
    float4 ev[16];
#pragma unroll
    for (int i = 0; i < 8; ++i) ka[i] = *(const bf16x8*)(KtT + ((i >> 1) * 32 + ln) * ATS + (i & 1) * 16 + hh * 8);
#pragma unroll
    for (int i = 0; i < 16; ++i) ev[i] = *(const float4*)(ebl + (i >> 2) * 32 + (i & 3) * 8 + hh * 4);
    __builtin_amdgcn_sched_barrier(0);
    S0 = MFMA(ka[0], vs[0], S0); S1 = MFMA(ka[2], vs[0], S1); S2 = MFMA(ka[4], vs[0], S2); S3 = MFMA(ka[6], vs[0], S3);
    S0 = MFMA(ka[1], vs[1], S0); S1 = MFMA(ka[3], vs[1], S1); S2 = MFMA(ka[5], vs[1], S2); S3 = MFMA(ka[7], vs[1], S3);
#define A_SCALE(SK, kb) { \
      _Pragma("unroll") for (int rg = 0; rg < 4; ++rg) { \
        const float4 e = ev[(kb) * 4 + rg]; \
        SK[rg * 4 + 0] *= e.x; SK[rg * 4 + 1] *= e.y; SK[rg * 4 + 2] *= e.z; SK[rg * 4 + 3] *= e.w; } }
    A_SCALE(S0, 0) A_SCALE(S1, 1) A_SCALE(S2, 2) A_SCALE(S3, 3)
  }
  __syncthreads();
}
DI void a_chunk_item(unsigned char* ws, int it, unsigned char* smem) {
  const int dir = it & 1, hd = (it >> 1) & 3, b = it >> 3;
  __builtin_amdgcn_s_setprio(2);
  if (dir == 0) a_chunk_run<0>(ws, b, hd, smem); else a_chunk_run<1>(ws, b, hd, smem);
  __builtin_amdgcn_s_setprio(0);
}

struct AttnArgs {
  float m0;
  bf16_t* q;
  const bf16_t* k; int kstride;
  const bf16_t* vt;
  int kbase_row;
  int qrow;
  int ntiles, nwin, win_p0;
  int mode;
  int gr, r0w, cb, krow0;
  const float* bias;
};
DI void attn_run(const AttnArgs& a, unsigned char* smem) {
  const int tid = tid_(), lane = tid & 63, ln = lane & 31, h = lane >> 5;
  bf16_t* sk = (bf16_t*)smem;
  bf16_t* sv = sk + 2 * 64 * LSTR;
  bf16x8 qf[4];
  {
    const bf16_t* qp = a.q + (size_t)(a.qrow + ln) * 512 + h * 8;
#pragma unroll
    for (int ks = 0; ks < 4; ++ks) qf[ks] = *(const bf16x8*)(qp + ks * 16);
  }
  f32x16 o0, o1;
#pragma unroll
  for (int r = 0; r < 16; ++r) { o0[r] = 0.f; o1[r] = 0.f; }
  float lrun = 0.f;
  const int lrow = tid >> 3, lc = (tid & 7) * 8;
  uint4 rk0, rk1, rv0, rv1;
#define TILE_P0(i) ((i) < a.nwin ? a.win_p0 + (i) * 64 : ((i) - a.nwin) * 64)
#define GLOAD(i) { const int p0_ = TILE_P0(i); \
    rk0 = *(const uint4*)(a.k + (size_t)(a.kbase_row + p0_ + lrow) * a.kstride + lc); \
    rk1 = *(const uint4*)(a.k + (size_t)(a.kbase_row + p0_ + lrow + 32) * a.kstride + lc); \
    rv0 = *(const uint4*)(a.vt + (size_t)(lrow) * PT + p0_ + lc); \
    rv1 = *(const uint4*)(a.vt + (size_t)(lrow + 32) * PT + p0_ + lc); }
#define SSTORE(buf_) { \
    *(uint4*)(sk + (buf_) * 64 * LSTR + (lrow) * LSTR + lc) = rk0; \
    *(uint4*)(sk + (buf_) * 64 * LSTR + (lrow + 32) * LSTR + lc) = rk1; \
    *(uint4*)(sv + (buf_) * 64 * LSTR + (lrow) * LSTR + lc) = rv0; \
    *(uint4*)(sv + (buf_) * 64 * LSTR + (lrow + 32) * LSTR + lc) = rv1; }
  GLOAD(0);
  SSTORE(0);
  __syncthreads();
  for (int it = 0; it < a.ntiles; ++it) {
    const int buf = it & 1;
    GLOAD(min(it + 1, a.ntiles - 1));
    asm volatile("" ::: "memory");
    __builtin_amdgcn_sched_barrier(0);
    bool active = true;
    int krow = 0;
    const bool win = (a.mode == 1 && it < a.nwin);
    if (win) { krow = a.krow0 + it; active = (krow >= a.r0w && krow < a.r0w + 8); }
    if (active) {
      const bf16_t* ks_ = sk + buf * 64 * LSTR + ln * LSTR + h * 8;
      f32x16 s0, s1;
#pragma unroll
      for (int r = 0; r < 16; ++r) { s0[r] = -a.m0; s1[r] = -a.m0; }
#pragma unroll
      for (int ks = 0; ks < 4; ++ks) {
        bf16x8 a0 = *(const bf16x8*)(ks_ + ks * 16);
        bf16x8 a1 = *(const bf16x8*)(ks_ + 32 * LSTR + ks * 16);
        s0 = MFMA(a0, qf[ks], s0);
        s1 = MFMA(a1, qf[ks], s1);
      }
      if (win) {
        const int qc = a.cb + ln;
        const int c0 = min(max(qc - 8, 0), 48);
        const float* brow = a.bias + (krow - a.gr + 7) * 31 + 15 - qc;
#pragma unroll
        for (int r = 0; r < 16; ++r) {
          const int kc0 = (r >> 2) * 8 + h * 4 + (r & 3);
          const int kc1 = kc0 + 32;
          s0[r] = (kc0 >= c0 && kc0 < c0 + 16) ? s0[r] + brow[kc0] : -1e30f;
          s1[r] = (kc1 >= c0 && kc1 < c0 + 16) ? s1[r] + brow[kc1] : -1e30f;
        }
      }
#pragma unroll
      for (int r = 0; r < 16; ++r) { s0[r] = __builtin_amdgcn_exp2f(s0[r]); lrun += s0[r]; }
#pragma unroll
      for (int r = 0; r < 16; ++r) { s1[r] = __builtin_amdgcn_exp2f(s1[r]); lrun += s1[r]; }
      const bf16_t* vs_ = sv + buf * 64 * LSTR + ln * LSTR + h * 4;
#pragma unroll
      for (int j = 0; j < 4; ++j) {
        bf16x8 pb;
        {
          unsigned u0, u1, u2, u3;
          if (j < 2) {
            const int b8 = 8 * j;
            u0 = pack2(s0[b8 + 0], s0[b8 + 1]); u1 = pack2(s0[b8 + 2], s0[b8 + 3]);
            u2 = pack2(s0[b8 + 4], s0[b8 + 5]); u3 = pack2(s0[b8 + 6], s0[b8 + 7]);
          } else {
            const int b8 = 8 * (j - 2);
            u0 = pack2(s1[b8 + 0], s1[b8 + 1]); u1 = pack2(s1[b8 + 2], s1[b8 + 3]);
            u2 = pack2(s1[b8 + 4], s1[b8 + 5]); u3 = pack2(s1[b8 + 6], s1[b8 + 7]);
          }
          pb = __builtin_bit_cast(bf16x8, make_uint4(u0, u1, u2, u3));
        }
        const s16x4 lo0 = *(const s16x4*)(vs_ + j * 16);
        const s16x4 hi0 = *(const s16x4*)(vs_ + j * 16 + 8);
        const s16x4 lo1 = *(const s16x4*)(vs_ + 32 * LSTR + j * 16);
        const s16x4 hi1 = *(const s16x4*)(vs_ + 32 * LSTR + j * 16 + 8);
        const bf16x8 av0 = __builtin_shufflevector(lo0, hi0, 0, 1, 2, 3, 4, 5, 6, 7);
        const bf16x8 av1 = __builtin_shufflevector(lo1, hi1, 0, 1, 2, 3, 4, 5, 6, 7);
        o0 = MFMA(av0, pb, o0);
        o1 = MFMA(av1, pb, o1);
      }
    }
    SSTORE(buf ^ 1);
    __syncthreads();
  }
  lrun += shx(lrun, 32);
  const float inv = 1.f / lrun;
  bf16_t* op = a.q + (size_t)(a.qrow + ln) * 512;
#pragma unroll
  for (int rg = 0; rg < 4; ++rg) {
    const int d = rg * 8 + h * 4;
    *(uint2*)(op + d) = make_uint2(pack2(o0[rg * 4 + 0] * inv, o0[rg * 4 + 1] * inv), pack2(o0[rg * 4 + 2] * inv, o0[rg * 4 + 3] * inv));
    *(uint2*)(op + 32 + d) = make_uint2(pack2(o1[rg * 4 + 0] * inv, o1[rg * 4 + 1] * inv), pack2(o1[rg * 4 + 2] * inv, o1[rg * 4 + 3] * inv));
  }
}

DI float wave_max(float v) {
#pragma unroll
  for (int m = 32; m >= 1; m >>= 1) v = fmaxf(v, shx(v, m));
  return v;
}
DI float attn_m0(int qi, int ki, int l) {
  const int lane = tid_() & 63;
  const float* qn = ((const float*)(const __attribute__((address_space(1))) float*)karg(qi)) + l * 64;
  const float* kn = ((const float*)(const __attribute__((address_space(1))) float*)karg(ki)) + l * 64;
  return 8.f * 1.4426950408889634f * 1.02f * wave_max(fabsf(qn[lane])) * wave_max(fabsf(kn[lane]));
}
constexpr int N_A = 32, N_B = 1024, N_C = 1024, N_CTX = 128;
DI void mixer_item(const Params& p, int l, int it, unsigned char* smem) {
  const int w = tid_() >> 6;
  unsigned char* ws = ((unsigned char*)(__attribute__((address_space(1))) unsigned char*)karg(21));
  if (it < N_A) { a_chunk_item(ws, it, smem); return; }
  it -= N_A;
  AttnArgs a;
  a.bias = (const float*)(smem + 4 * 64 * LSTR * 2);
  a.mode = 0; a.gr = 0; a.r0w = 0; a.cb = 0; a.krow0 = 0;
  if (it < N_B) {
    const int hd = it & 7, qb = (it >> 3) & 31, b = it >> 8;
    a.q = (bf16_t*)(ws + O_BQ) + hd * 64;
    a.k = (const bf16_t*)(ws + O_BK) + (hd >> 2) * 64; a.kstride = 128;
    a.vt = (const bf16_t*)(ws + O_BVT) + ((size_t)b * 128 + (hd >> 2) * 64) * PT;
    a.kbase_row = b * PT; a.qrow = b * PT + CL + qb * 128 + w * 32;
    a.ntiles = 68; a.nwin = 68; a.win_p0 = 0;
    a.m0 = attn_m0(11, 12, l);
    attn_run(a, smem);
    return;
  }
  it -= N_B;
  if (it < N_C) {
    const int hd = it & 7, rp = (it >> 3) & 31, b = it >> 8;
    const int g0 = 2 * rp, g1 = 2 * rp + 1;
    const int r00 = min(max(g0 - 4, 0), 56), r01 = min(max(g1 - 4, 0), 56);
    float* bt = (float*)(smem + 4 * 64 * LSTR * 2);
    for (int i = tid_(); i < 465; i += 256) bt[i] = 1.4426950408889634f * ((const float*)(const __attribute__((address_space(1))) float*)karg(15))[((size_t)l * 8 + hd) * 465 + i];
    __syncthreads();
    a.q = (bf16_t*)(ws + O_CQ) + hd * 64;
    a.k = (const bf16_t*)(ws + O_CK) + hd * 64; a.kstride = 512;
    a.vt = (const bf16_t*)(ws + O_CVT) + ((size_t)b * 512 + hd * 64) * PT;
    a.kbase_row = b * PT;
    a.gr = g0 + (w >> 1); a.cb = (w & 1) * 32; a.r0w = (w >> 1) ? r01 : r00; a.krow0 = r00;
    a.qrow = b * PT + CL + a.gr * 64 + a.cb;
    a.nwin = r01 + 8 - r00; a.ntiles = a.nwin + 4; a.win_p0 = CL + r00 * 64;
    a.mode = 1;
    {
      const int lane = tid_() & 63;
      float bm = 0.f;
#pragma unroll
      for (int i = 0; i < 8; ++i) { const int ix = lane + 64 * i; if (ix < 465) bm = fmaxf(bm, fabsf(bt[ix])); }
      a.m0 = attn_m0(13, 14, l) + wave_max(bm);
    }
    attn_run(a, smem);
    return;
  }
  it -= N_C;
  {
    const int hd = it & 7, qb = (it >> 3) & 1, b = (it >> 4) & 3, kc = it >> 6;
    if (kc == 0) {
      a.q = (bf16_t*)(ws + O_BQ) + hd * 64;
      a.k = (const bf16_t*)(ws + O_BK) + (hd >> 2) * 64; a.kstride = 128;
      a.vt = (const bf16_t*)(ws + O_BVT) + ((size_t)b * 128 + (hd >> 2) * 64) * PT;
    } else {
      a.q = (bf16_t*)(ws + O_CQ) + hd * 64;
      a.k = (const bf16_t*)(ws + O_CK) + hd * 64; a.kstride = 512;
      a.vt = (const bf16_t*)(ws + O_CVT) + ((size_t)b * 512 + hd * 64) * PT;
    }
    a.kbase_row = b * PT; a.qrow = b * PT + qb * 128 + w * 32;
    a.ntiles = 4; a.nwin = 4; a.win_p0 = 0;
    a.m0 = (kc == 0) ? attn_m0(11, 12, l) : attn_m0(13, 14, l);
    attn_run(a, smem);
  }
}

DI void readout_row(const Params& p, int l, int row) {
  const int lane = tid_() & 63;
  unsigned char* ws = ((unsigned char*)(__attribute__((address_space(1))) unsigned char*)karg(21));
  bf16_t* og = (bf16_t*)(ws + O_OG) + (size_t)row * 512;
  const uint4 f4 = *(const uint4*)((const bf16_t*)(ws + O_QHF) + (size_t)row * 512 + lane * 8);
  const uint4 b4 = *(const uint4*)((const bf16_t*)(ws + O_QHB) + (size_t)row * 512 + lane * 8);
  const uint4 g4 = *(const uint4*)(og + lane * 8);
  const unsigned ff[4] = {f4.x, f4.y, f4.z, f4.w}, bb[4] = {b4.x, b4.y, b4.z, b4.w}, gg[4] = {g4.x, g4.y, g4.z, g4.w};
  float o[8];
  float ss = 0.f;
#pragma unroll
  for (int i = 0; i < 4; ++i) {
    o[2 * i] = bflo(ff[i]) + bflo(bb[i]);
    o[2 * i + 1] = bfhi(ff[i]) + bfhi(bb[i]);
    ss += o[2 * i] * o[2 * i] + o[2 * i + 1] * o[2 * i + 1];
  }
  ss += shx(ss, 1); ss += shx(ss, 2); ss += shx(ss, 4); ss += shx(ss, 8);
  const float rs = rsqrtf(ss * (1.f / 128.f) + EPS);
  const float* gn = ((const float*)(const __attribute__((address_space(1))) float*)karg(10)) + l * 128 + (lane & 15) * 8;
  unsigned outp[4];
#pragma unroll
  for (int i = 0; i < 4; ++i) {
    const float g0 = bflo(gg[i]), g1 = bfhi(gg[i]);
    outp[i] = pack2(o[2 * i] * rs * gn[2 * i] * siluf_(g0), o[2 * i + 1] * rs * gn[2 * i + 1] * siluf_(g1));
  }
  *(uint4*)(og + lane * 8) = make_uint4(outp[0], outp[1], outp[2], outp[3]);
}

DI bool xcd_tile(int seq, int bid, int nblk, int MX, int NX, int& mt, int& nt) {
  const int per = nblk >> 3, li = bid >> 3, x = bid & 7;
  const int u = li + seq * per;
  if (u >= MX * NX) return false;
  const int FM = MX >> 3, fullsz = 8 * NX;
  int mgi, r, gm;
  if (u < FM * fullsz) { mgi = u / fullsz; r = u - mgi * fullsz; gm = 8; }
  else { mgi = FM; r = u - FM * fullsz; gm = MX & 7; }
  const int ngi = r / (gm * 8), r2 = r - ngi * gm * 8;
  const int nj = r2 / gm, mi = r2 - nj * gm;
  mt = x * MX + mgi * 8 + mi;
  nt = ngi * 8 + nj;
  return true;
}
DI bool xcd_tile_l1(int seq, int bid, int nblk, int& mt, int& nt) {
  const int per = nblk >> 3, li = bid >> 3, x = bid & 7;
  const int u = li + seq * per;
  if (u >= 634) return false;
  if (u < 608) {
    const int fullsz = 8 * 38;
    const int mgi = u / fullsz, r = u - mgi * fullsz;
    const int ngi = r / 64, r2 = r - ngi * 64;
    const int nj = r2 >> 3, mi = r2 & 7;
    const int lat = x * 16 + mgi * 8 + mi;
    mt = (lat >> 5) * 34 + 2 + (lat & 31);
    nt = ngi * 8 + nj;
  } else {
    const int j = u - 608;
    mt = (x >> 1) * 34 + (x & 1);
    nt = (j < 16) ? j : (j < 18 ? 24 + (j - 16) : 30 + (j - 18));
  }
  return true;
}
DI int mtile_row0(int l, int mt) { return l == 0 ? mt * 128 : ((mt >> 5) * PT + CL + (mt & 31) * 128); }

#ifndef SKIPM
#define SKIPM 0
#endif
#ifdef PROBE_REP
__device__ const unsigned char PSEQ[] = {0, 1, 2, PROBE_R(2) 3, 4, 5, PROBE_R(5) 6, 7, 8, PROBE_R(8) 9, 10, 11, PROBE_R(11) 12, 13, 14, PROBE_R(14) 15, 16, 17, PROBE_R(17) 18};
#else
__device__ const unsigned char PSEQ[] = {0, 1, 2, 3, 4, 5, 6, 7, 8, 9, 10, 11, 12, 13, 14, 15, 16, 17, 18};
#endif
constexpr int NSEQ = sizeof(PSEQ);
#define OPAQUE_S(x) asm volatile("" : "+s"(x))
__global__ void __launch_bounds__(256, 2) fwd_megakernel(Params p) {
  extern __shared__ __attribute__((aligned(16))) unsigned char smem[];
  __shared__ __attribute__((aligned(16))) unsigned sh_words[8];
#define s_item (((int*)sh_words)[4])
#define s_key (((int*)sh_words)[5])
  cg::grid_group grid = cg::this_grid();
  const int nblk = gridDim.x, bid = blockIdx.x;
  if (threadIdx.x == 0) { sh_words[0] = 0u; sh_words[1] = 0u; sh_words[2] = 0u; sh_words[3] = 0u; }
  __syncthreads();
  (void)xcd_barrier_post((unsigned*)(((unsigned char*)(__attribute__((address_space(1))) unsigned char*)karg(21)) + O_BAR), (volatile LAS unsigned*)sh_words);

  for (int pi = 0; pi < NSEQ; ++pi) {
    const int ph = PSEQ[pi];
    const int tid = tid_(), lane = tid & 63, w = tid >> 6, wm = w >> 1, wn = w & 1;
    unsigned char* ws = ((unsigned char*)(__attribute__((address_space(1))) unsigned char*)karg(21));
    const int l = (ph - 1) / 9, k = (ph == 0) ? -1 : (ph - 1) % 9;
    const int nmt = (l == 0) ? 136 : 128;
    if (k == -1 && !(SKIPM & 1)) {
      int* ctr = (int*)(ws + O_CTR);
      for (int i = bid * 256 + tid; i < 64 + 4 * 4096; i += nblk * 256) ctr[i] = 0;
      if (bid == 1 || nblk == 1) {
        float* ropet = (float*)(ws + O_ROPE);
        for (int i = tid; i < 1024; i += 256) {
          const int pos = i >> 4, j = i & 15;
          const float inv = exp2f(-(float)j * (13.287712379549449f / 16.f));
          const float ang = (float)pos * inv;
          ropet[i * 2] = __cosf(ang); ropet[i * 2 + 1] = __sinf(ang);
        }
      }
      for (int it = bid; it < 384 + CVT_ITEMS; it += nblk) {
        if (it < 384) mod_item(p, it, smem); else cvt_item(p, 0, it - 384, smem);
      }
    } else if (k == 0 && !(SKIPM & 2)) {
      if (l == 1) for (int it = bid; it < CVT_ITEMS; it += nblk) cvt_item(p, 1, it, smem);
      for (int row = bid * 4 + w; row < NT; row += nblk * 4) norm_row(p, l, 0, row, ((const float*)(const __attribute__((address_space(1))) float*)karg(6)) + l * 1024, 0, 1024);
    } else if (k == 1 && !(SKIPM & 4)) {
      for (int sq = 0;; ++sq) {
        int mt, nt;
        if (l == 0 ? !xcd_tile(sq, bid, nblk, 17, 38, mt, nt) : !xcd_tile_l1(sq, bid, nblk, mt, nt)) break;
        f32x16 acc[2][2];
        zero_acc(acc);
        const bool tr = (nt >= 16 && nt <= 33 && nt != 25);
        if (tr) {
          gemm_tile<true>((const bf16_t*)(ws + O_UO) + (size_t)mt * 128 * 1024, 1024, (const bf16_t*)(ws + O_WIN) + (size_t)nt * 128 * 1024, 1024, 1024, acc, smem);
          inproj_epilogue_tr(l, acc, mt * 128 + wm * 64, nt * 128 + wn * 64);
        } else {
          gemm_tile<false>((const bf16_t*)(ws + O_UO) + (size_t)mt * 128 * 1024, 1024, (const bf16_t*)(ws + O_WIN) + (size_t)nt * 128 * 1024, 1024, 1024, acc, smem);
          inproj_epilogue(p, l, acc, mt * 128 + wm * 64, nt * 128 + wn * 64, smem);
        }
      }
    } else if (k == 2 && !(SKIPM & 8)) {
      int* ctr = (int*)(ws + O_CTR);
      const int nattn = N_B + N_C + (l == 0 ? N_CTX : 0);
      if (tid == 0) {
        const unsigned hw = __builtin_amdgcn_s_getreg(4 | (31 << 11));
        const unsigned xcc = __builtin_amdgcn_s_getreg(20 | (31 << 11));
        const int key = (int)(((xcc & 15u) << 8) | ((hw >> 8) & 255u));
        int* cuflag = ctr + 64 + 2 * 4096 + l * 4096 + key;
        const int r = atomicAdd(ctr + 64 + l * 4096 + key, 1);
        int item = -1;
        if (r == 0) {
          const int it = atomicAdd(ctr + l * 2 + 0, 1);
          if (it < N_A) { item = it; atomicExch(cuflag, 1); } else atomicExch(cuflag, 2);
        } else {
          for (int spin = 0; spin < (1 << 20); ++spin) {
            const int v = atomicAdd(cuflag, 0);
            if (v >= 2) break;
            __builtin_amdgcn_s_sleep(32);
          }
        }
        s_item = item; s_key = key;
      }
      __syncthreads();
      const int myitem = s_item, mykey = s_key;
      __syncthreads();
      if (myitem >= 0) {
        mixer_item(p, l, myitem, smem);
        __syncthreads();
        if (tid == 0) atomicExch(ctr + 64 + 2 * 4096 + l * 4096 + mykey, 3);
      }
      for (int pass = 0; pass < 2; ++pass) {
        const int q = 1 ^ pass;
        const int total = (q == 0) ? N_A : nattn;
        for (;;) {
          if (tid == 0) s_item = atomicAdd(ctr + l * 2 + q, 1);
          __syncthreads();
          const int it = s_item;
          __syncthreads();
          if (it >= total) break;
          mixer_item(p, l, q == 0 ? it : N_A + it, smem);
        }
      }
    } else if (k == 3 && !(SKIPM & 16)) {
      for (int i = bid * 4 + w; i < nmt * 128; i += nblk * 4) {
        const int row = (l == 0) ? i : ((i >> 12) * PT + CL + (i & 4095));
        readout_row(p, l, row);
      }
    } else if (k == 4 && !(SKIPM & 32)) {
      float4* msc = (float4*)(ws + O_CK) + (size_t)bid * 4096 + tid;
      for (int sq = 0;; ++sq) {
        int mt, nt;
        if (!xcd_tile(sq, bid, nblk, nmt >> 3, 8, mt, nt)) break;
        const int m0 = mtile_row0(l, mt), n0 = nt * 128;
#pragma unroll 1
        for (int kb = 0; kb < 3; ++kb) {
          f32x16 acc[2][2];
          zero_acc(acc);
          gemm_tile<true>((const bf16_t*)(ws + O_UO) + (size_t)m0 * 1024, 1024, (const bf16_t*)(ws + O_WIN) + (size_t)(PW + kb * 1024 + n0) * 1024, 1024, 1024, acc, smem);
          uint4* gsc = (uint4*)(ws + O_QHF) + (size_t)bid * 2048 + tid;
#pragma unroll
          for (int i = 0; i < 2; ++i)
#pragma unroll
            for (int j = 0; j < 2; ++j) {
              unsigned g8[8];
#pragma unroll
              for (int r = 0; r < 8; ++r) g8[r] = pack2(sigmoidf_(acc[i][j][2 * r]), sigmoidf_(acc[i][j][2 * r + 1]));
              gsc[((i * 2 + j) * 2 + 0) * 256] = make_uint4(g8[0], g8[1], g8[2], g8[3]);
              gsc[((i * 2 + j) * 2 + 1) * 256] = make_uint4(g8[4], g8[5], g8[6], g8[7]);
            }
          zero_acc(acc);
          const size_t yo = (kb == 0) ? O_OG : (kb == 1 ? O_BQ : O_CQ);
          gemm_tile<true>((const bf16_t*)(ws + yo) + (size_t)m0 * 512, 512, (const bf16_t*)(ws + O_WBR) + ((size_t)kb * 1024 + n0) * 512, 512, 512, acc, smem);
          const int h = lane >> 5, ln = lane & 31;
          int mso = 0, rowb = m0 + wm * 64 + ln, colb = n0 + wn * 64 + h * 4;
          asm volatile("" : "+v"(mso), "+v"(rowb), "+v"(colb));
#pragma unroll
          for (int i = 0; i < 2; ++i)
#pragma unroll
            for (int j = 0; j < 2; ++j) {
              const uint4 ga = gsc[mso + ((i * 2 + j) * 2 + 0) * 256], gb = gsc[mso + ((i * 2 + j) * 2 + 1) * 256];
              const unsigned g8[8] = {ga.x, ga.y, ga.z, ga.w, gb.x, gb.y, gb.z, gb.w};
#pragma unroll
              for (int rg = 0; rg < 4; ++rg) {
                float4 v;
                v.x = bflo(g8[rg * 2]) * acc[i][j][rg * 4 + 0];
                v.y = bfhi(g8[rg * 2]) * acc[i][j][rg * 4 + 1];
                v.z = bflo(g8[rg * 2 + 1]) * acc[i][j][rg * 4 + 2];
                v.w = bfhi(g8[rg * 2 + 1]) * acc[i][j][rg * 4 + 3];
                float4* sp = msc + mso + ((i * 2 + j) * 4 + rg) * 256;
                if (kb > 0) { const float4 o = *sp; v.x += o.x; v.y += o.y; v.z += o.z; v.w += o.w; }
                if (kb < 2) *sp = v;
                else {
                  bf16_t* mo = (bf16_t*)(ws + O_M);
                  const int row = rowb + i * 32;
                  const int col = colb + j * 32 + rg * 8;
                  *(uint2*)(mo + (size_t)row * 1024 + col) = make_uint2(pack2(v.x, v.y), pack2(v.z, v.w));
                }
                __builtin_amdgcn_sched_barrier(0);
              }
            }
        }
      }
    } else if (k == 5 && !(SKIPM & 64)) {
      for (int sq = 0;; ++sq) {
        int mt, nt;
        if (!xcd_tile(sq, bid, nblk, nmt >> 3, 8, mt, nt)) break;
        const int m0 = mtile_row0(l, mt), n0 = nt * 128;
        f32x16 acc[2][2];
        zero_acc(acc);
        gemm_tile<true>((const bf16_t*)(ws + O_M) + (size_t)m0 * 1024, 1024, (const bf16_t*)(ws + O_WOUT) + (size_t)n0 * 1024, 1024, 1024, acc, smem);
        const int h = lane >> 5, ln = lane & 31;
#pragma unroll
        for (int i = 0; i < 2; ++i) {
          const int row = m0 + wm * 64 + i * 32 + ln;
          const int b = row / PT, q = row % PT;
          const float* xin = xrow_ptr(p, l, 0, row);
          float* xo = (q < CL) ? (float*)(ws + O_XC) + ((size_t)b * CL + q) * D : ((float*)(__attribute__((address_space(1))) float*)karg(20)) + ((size_t)b * SEQ + (q - CL)) * D;
          const float* modf = (const float*)(ws + O_MOD) + ((size_t)l * 5 + (q < CL ? 4 : b)) * 6144 + 2048;
#pragma unroll
          for (int j = 0; j < 2; ++j)
#pragma unroll
            for (int rg = 0; rg < 4; ++rg) {
              const int col = n0 + wn * 64 + j * 32 + rg * 8 + h * 4;
              const float4 xi = *(const float4*)(xin + col);
              const float4 g = *(const float4*)(modf + col);
              float4 o;
              o.x = xi.x + g.x * acc[i][j][rg * 4 + 0]; o.y = xi.y + g.y * acc[i][j][rg * 4 + 1];
              o.z = xi.z + g.z * acc[i][j][rg * 4 + 2]; o.w = xi.w + g.w * acc[i][j][rg * 4 + 3];
              *(float4*)(xo + col) = o;
            }
        }
      }
    } else if (k == 6 && !(SKIPM & 128)) {
      for (int i = bid * 4 + w; i < nmt * 128; i += nblk * 4) {
        const int row = (l == 0) ? i : ((i >> 12) * PT + CL + (i & 4095));
        norm_row(p, l, 1, row, ((const float*)(const __attribute__((address_space(1))) float*)karg(7)) + l * 1024, 3072, 4096);
      }
    } else if (k == 7 && !(SKIPM & 256)) {
      for (int sq = 0;; ++sq) {
        int mt, nt;
        if (!xcd_tile(sq, bid, nblk, nmt >> 3, 44, mt, nt)) break;
        const int m0 = mtile_row0(l, mt);
        f32x16 acc[2][2];
        zero_acc(acc);
        gemm_tile<true>((const bf16_t*)(ws + O_UO) + (size_t)m0 * 1024, 1024, (const bf16_t*)(ws + O_WGU) + (size_t)nt * 128 * 1024, 1024, 1024, acc, smem);
        bf16_t* ao = (bf16_t*)(ws + O_ACT);
        const int h = lane >> 5, ln = lane & 31;
#pragma unroll
        for (int i = 0; i < 2; ++i) {
          bf16_t* ar = ao + (size_t)(m0 + wm * 64 + i * 32 + ln) * FH + nt * 64 + wn * 32 + h * 4;
#pragma unroll
          for (int rg = 0; rg < 4; ++rg)
            *(uint2*)(ar + rg * 8) = make_uint2(pack2(siluf_(acc[i][0][rg * 4 + 0]) * acc[i][1][rg * 4 + 0], siluf_(acc[i][0][rg * 4 + 1]) * acc[i][1][rg * 4 + 1]),
                                                pack2(siluf_(acc[i][0][rg * 4 + 2]) * acc[i][1][rg * 4 + 2], siluf_(acc[i][0][rg * 4 + 3]) * acc[i][1][rg * 4 + 3]));
        }
      }
    } else if (!(SKIPM & 512)) {
      for (int sq = 0;; ++sq) {
        int mt, nt;
        if (!xcd_tile(sq, bid, nblk, nmt >> 3, 8, mt, nt)) break;
        const int m0 = mtile_row0(l, mt), n0 = nt * 128;
        f32x16 acc[2][2];
        zero_acc(acc);
        gemm_tile<true>((const bf16_t*)(ws + O_ACT) + (size_t)m0 * FH, FH, (const bf16_t*)(ws + O_WD) + (size_t)n0 * FH, FH, FH, acc, smem);
        const int h = lane >> 5, ln = lane & 31;
#pragma unroll
        for (int i = 0; i < 2; ++i) {
          const int row = m0 + wm * 64 + i * 32 + ln;
          const int b = row / PT, q = row % PT;
          float* xo = (q < CL) ? (float*)(ws + O_XC) + ((size_t)b * CL + q) * D : ((float*)(__attribute__((address_space(1))) float*)karg(20)) + ((size_t)b * SEQ + (q - CL)) * D;
          const float* modf = (const float*)(ws + O_MOD) + ((size_t)l * 5 + (q < CL ? 4 : b)) * 6144 + 5120;
#pragma unroll
          for (int j = 0; j < 2; ++j)
#pragma unroll
            for (int rg = 0; rg < 4; ++rg) {
              const int col = n0 + wn * 64 + j * 32 + rg * 8 + h * 4;
              const float4 xi = *(const float4*)(xo + col);
              const float4 g = *(const float4*)(modf + col);
              float4 o;
              o.x = xi.x + g.x * acc[i][j][rg * 4 + 0]; o.y = xi.y + g.y * acc[i][j][rg * 4 + 1];
              o.z = xi.z + g.z * acc[i][j][rg * 4 + 2]; o.w = xi.w + g.w * acc[i][j][rg * 4 + 3];
              *(float4*)(xo + col) = o;
            }
        }
      }
    }
    if (nblk > (1 << 30)) grid.sync();
    else if (pi < NSEQ - 1) {
      XcdBarrier xb; xb.bar = (unsigned*)(ws + O_BAR); xb.x = xb_xcc_id(); xb.st = (volatile LAS unsigned*)sh_words;
      xcd_barrier(xb);
    }
  }
}

extern "C" void kernel_launch(void* const* d_in, const int* in_sizes, int n_in, void* d_out, int out_size, void* d_ws, size_t ws_size,
                              hipStream_t stream) {
  static int grid_blocks = 0;
  if (grid_blocks == 0) {
    if (ws_size < WS_END) { fprintf(stderr, "kernel_launch: workspace too small: %zu < %zu\n", ws_size, (size_t)WS_END); grid_blocks = -1; return; }
    int dev = 0, cus = 0, per_cu = 0;
    hipGetDevice(&dev);
    hipDeviceGetAttribute(&cus, hipDeviceAttributeMultiprocessorCount, dev);
    hipFuncSetAttribute((const void*)fwd_megakernel, hipFuncAttributeMaxDynamicSharedMemorySize, LDS_BYTES);
    hipOccupancyMaxActiveBlocksPerMultiprocessor(&per_cu, (const void*)fwd_megakernel, 256, LDS_BYTES);
    if (per_cu < 1) { fprintf(stderr, "kernel_launch: occupancy query returned %d\n", per_cu); grid_blocks = -1; return; }
    if (per_cu > 2) per_cu = 2;
    grid_blocks = cus * per_cu;
  }
  if (grid_blocks < 0) return;
  Params p{};
  p.x = (const float*)d_in[0]; p.c = (const float*)d_in[1]; p.ctx = (const float*)d_in[2]; p.c_ctx = (const float*)d_in[3];
  p.w_mod = (const float*)d_in[4]; p.b_mod = (const float*)d_in[5]; p.norm_mix = (const float*)d_in[6]; p.norm_ffn = (const float*)d_in[7];
  p.w_in = (const float*)d_in[8]; p.lb_raw = (const float*)d_in[9]; p.gn_a = (const float*)d_in[10]; p.qn_b = (const float*)d_in[11];
  p.kn_b = (const float*)d_in[12]; p.qn_c = (const float*)d_in[13]; p.kn_c = (const float*)d_in[14]; p.rel_bias = (const float*)d_in[15];
  p.w_branch = (const float*)d_in[16]; p.w_out = (const float*)d_in[17]; p.w_gate_up = (const float*)d_in[18]; p.w_down = (const float*)d_in[19];
  p.out = (float*)d_out; p.ws = (unsigned char*)d_ws;
  if (hipMemsetAsync((unsigned char*)d_ws + O_BAR, 0, 16384, stream) != hipSuccess) { fprintf(stderr, "kernel_launch: hipMemsetAsync of the barrier words failed\n"); return; }
  void* args[] = {&p};
  hipError_t e = hipLaunchCooperativeKernel((const void*)fwd_megakernel, dim3(grid_blocks), dim3(256), args, LDS_BYTES, stream);
  if (e != hipSuccess) fprintf(stderr, "cooperative launch failed: %s (grid %d)\n", hipGetErrorString(e), grid_blocks);
}
```
